# Optimizing an MI355X kernel written in HIP

```python
import jax, jax.numpy as jnp
from jax import lax
import numpy as np

D_MODEL = 2048
BATCH = 1
SEQ = 8192
DEPTH = 4

GRID_W = 64
CTX_LEN = 256
EPS = 1e-6
N_MOD = 6
N_BRANCH = 4
BRANCH_W = D_MODEL // 4
A_HEADS = 8
A_KV_HEADS = 2
A_HEAD_DIM = BRANCH_W // A_HEADS
A_WINDOW = 128
A_BLOCK = 128
ROPE_THETA = 10000.0
B_HEADS = 8
B_HEAD_DIM = BRANCH_W // B_HEADS
NB_ROWS = 8
NB_COLS = 16
C_WIDTH = BRANCH_W
C_BLOCKS = 4
C_BLOCK_W = C_WIDTH // C_BLOCKS
C_CONV = 4
C_POW = 8.0
D_WIDTH = BRANCH_W
D_CONV = 3
FFN_HIDDEN = -(-(8 * D_MODEL) // (3 * 256)) * 256
COL_SIZES = (A_HEADS * A_HEAD_DIM, A_KV_HEADS * A_HEAD_DIM, A_KV_HEADS * A_HEAD_DIM,
             BRANCH_W, BRANCH_W, BRANCH_W,
             C_WIDTH, C_WIDTH,
             D_WIDTH, D_WIDTH, D_WIDTH,
             N_BRANCH * D_MODEL)
IN_COLS = sum(COL_SIZES)

kernel_name = "hybrid_parallel_dit_block"

F32 = jnp.float32


def _rmsnorm(x, g):
    x32 = x.astype(F32)
    y = x32 * lax.rsqrt(jnp.mean(x32 * x32, axis=-1, keepdims=True) + EPS)
    return y.astype(x.dtype) * g


def _modulate(xn, shift, scale):
    return xn * (1 + scale) + shift


def _split_cols(z):
    return jnp.split(z, np.cumsum(COL_SIZES)[:-1].tolist(), axis=-1)


def _heads(z, n, d):
    return z.reshape(z.shape[0], z.shape[1], n, d)


def _rope_1d(x, pos):
    half = x.shape[-1] // 2
    freqs = ROPE_THETA ** (-jnp.arange(half, dtype=F32) / half)
    ang = pos.astype(F32)[:, None] * freqs[None, :]
    cos = jnp.cos(ang)[None, :, None, :]
    sin = jnp.sin(ang)[None, :, None, :]
    x32 = x.astype(F32)
    x1, x2 = x32[..., :half], x32[..., half:]
    return jnp.concatenate([x1 * cos - x2 * sin, x1 * sin + x2 * cos], axis=-1).astype(x.dtype)


def _rope_2d(x, row, col):
    d = x.shape[-1] // 2
    return jnp.concatenate([_rope_1d(x[..., :d], row), _rope_1d(x[..., d:], col)], axis=-1)


def _dwconv(x, w, left):
    K, T = w.shape[0], x.shape[1]
    xp = jnp.pad(x, ((0, 0), (left, K - 1 - left), (0, 0)))
    out = xp[:, 0:T] * w[0]
    for j in range(1, K):
        out = out + xp[:, j:j + T] * w[j]
    return out


def _window_gqa(q, k, v, qc, kc, vc, sink, with_ctx):
    bsz, seq = q.shape[0], q.shape[1]
    nb = seq // A_BLOCK
    grp = A_HEADS // A_KV_HEADS
    scale = A_HEAD_DIM ** -0.5
    qb = q.reshape(bsz, nb, A_BLOCK, A_KV_HEADS, grp, A_HEAD_DIM)

    def band(t):
        tp = jnp.pad(t, ((0, 0), (A_BLOCK, A_BLOCK), (0, 0), (0, 0)))
        tp = tp.reshape(bsz, nb + 2, A_BLOCK, A_KV_HEADS, A_HEAD_DIM)
        return jnp.concatenate([tp[:, :-2], tp[:, 1:-1], tp[:, 2:]], axis=2)

    kb, vb = band(k), band(v)
    qpos = jnp.arange(seq).reshape(nb, A_BLOCK)
    kpos = (jnp.arange(nb) * A_BLOCK - A_BLOCK)[:, None] + jnp.arange(3 * A_BLOCK)[None, :]
    mask = ((jnp.abs(qpos[:, :, None] - kpos[:, None, :]) <= A_WINDOW)
            & (kpos >= 0)[:, None, :] & (kpos < seq)[:, None, :])
    s_loc = jnp.einsum('bnqhgd,bnkhd->bnhgqk', qb, kb).astype(F32) * scale
    s_loc = jnp.where(mask[None, :, None, None], s_loc, -jnp.inf)
    s_ctx = jnp.einsum('bnqhgd,blhd->bnhgql', qb, kc).astype(F32) * scale
    sink_g = sink.astype(F32).reshape(A_KV_HEADS, grp)
    s_sink = jnp.broadcast_to(sink_g[None, None, :, :, None, None], s_loc.shape[:-1] + (1,))
    p = jax.nn.softmax(jnp.concatenate([s_loc, s_ctx, s_sink], axis=-1), axis=-1).astype(v.dtype)
    nk, nc = 3 * A_BLOCK, kc.shape[1]
    o = (jnp.einsum('bnhgqk,bnkhd->bnqhgd', p[..., :nk], vb)
         + jnp.einsum('bnhgql,blhd->bnqhgd', p[..., nk:nk + nc], vc))
    o = o.reshape(bsz, seq, A_HEADS * A_HEAD_DIM)
    if not with_ctx:
        return o, None
    L = qc.shape[1]
    qcg = qc.reshape(bsz, L, A_KV_HEADS, grp, A_HEAD_DIM)
    sc = jnp.einsum('blhgd,bmhd->bhglm', qcg, kc).astype(F32) * scale
    sc_sink = jnp.broadcast_to(sink_g[None, :, :, None, None], sc.shape[:-1] + (1,))
    pc = jax.nn.softmax(jnp.concatenate([sc, sc_sink], axis=-1), axis=-1).astype(vc.dtype)
    oc = jnp.einsum('bhglm,bmhd->blhgd', pc[..., :L], vc).reshape(bsz, L, A_HEADS * A_HEAD_DIM)
    return o, oc


def _neighbourhood_attn(q, k, v, qc, kc, vc, rel_bias, with_ctx):
    bsz, seq = q.shape[0], q.shape[1]
    rows = seq // GRID_W
    wr = min(NB_ROWS, rows)
    scale = B_HEAD_DIM ** -0.5
    r = jnp.arange(rows)
    row_idx = jnp.clip(r - wr // 2, 0, rows - wr)[:, None] + jnp.arange(wr)[None, :]
    cq = jnp.arange(GRID_W)
    cstart = jnp.clip(cq - NB_COLS // 2, 0, GRID_W - NB_COLS)
    col_ok = (cq[None, :] >= cstart[:, None]) & (cq[None, :] < cstart[:, None] + NB_COLS)
    dr = row_idx - r[:, None] + NB_ROWS - 1
    dc = jnp.clip(cq[None, :] - cq[:, None] + NB_COLS - 1, 0, 2 * NB_COLS - 2)
    bias = rel_bias.astype(F32)[:, dr[:, None, :, None], dc[None, :, None, :]]
    q5 = q.reshape(bsz, rows, GRID_W, B_HEADS, B_HEAD_DIM)

    def gather_rows(t):
        return t.reshape(bsz, rows, GRID_W, B_HEADS, B_HEAD_DIM)[:, row_idx]

    k6, v6 = gather_rows(k), gather_rows(v)
    s_loc = jnp.einsum('brqhd,brikhd->bhrqik', q5, k6).astype(F32) * scale + bias[None]
    s_loc = jnp.where(col_ok[:, None, :], s_loc, -jnp.inf).reshape(bsz, B_HEADS, rows, GRID_W, wr * GRID_W)
    s_ctx = jnp.einsum('brqhd,blhd->bhrql', q5, kc).astype(F32) * scale
    p = jax.nn.softmax(jnp.concatenate([s_loc, s_ctx], axis=-1), axis=-1).astype(v.dtype)
    nk = wr * GRID_W
    p_loc = p[..., :nk].reshape(bsz, B_HEADS, rows, GRID_W, wr, GRID_W)
    o = (jnp.einsum('bhrqik,brikhd->brqhd', p_loc, v6)
         + jnp.einsum('bhrql,blhd->brqhd', p[..., nk:], vc))
    o = o.reshape(bsz, seq, B_HEADS * B_HEAD_DIM)
    if not with_ctx:
        return o, None
    L = qc.shape[1]
    sc = jnp.einsum('blhd,bmhd->bhlm', qc, kc).astype(F32) * scale
    pc = jax.nn.softmax(sc, axis=-1).astype(vc.dtype)
    oc = jnp.einsum('bhlm,bmhd->blhd', pc, vc).reshape(bsz, L, B_HEADS * B_HEAD_DIM)
    return o, oc


def _rglru_gates(u, w_a, b_a, w_x, b_x, lam):
    bsz, T, _ = u.shape
    u32 = u.astype(F32)
    ub = u32.reshape(bsz, T, C_BLOCKS, C_BLOCK_W)
    r = jax.nn.sigmoid(jnp.einsum('btnc,ncd->btnd', ub, w_a.astype(F32)).reshape(bsz, T, C_WIDTH) + b_a.astype(F32))
    i = jax.nn.sigmoid(jnp.einsum('btnc,ncd->btnd', ub, w_x.astype(F32)).reshape(bsz, T, C_WIDTH) + b_x.astype(F32))
    log_a = -C_POW * r * jax.nn.softplus(-lam.astype(F32))
    return jnp.exp(log_a), jnp.sqrt(-jnp.expm1(2.0 * log_a)) * (i * u32)


def _linear_scan(a, b, h0, reverse):
    def combine(e1, e2):
        return e1[0] * e2[0], e2[0] * e1[1] + e2[1]
    acum, bcum = lax.associative_scan(combine, (a, b), axis=1, reverse=reverse)
    return acum * h0[:, None, :] + bcum


def _rglru_bidir(xr, xrc, conv_w, conv_b, w_a, b_a, w_x, b_x, lam, with_ctx):
    u = _dwconv(xr, conv_w, C_CONV // 2) + conv_b
    uc = _dwconv(xrc, conv_w, C_CONV // 2) + conv_b
    lat, ctxs = [], []
    for d in range(2):
        rev = d == 1
        ac, bc = _rglru_gates(uc, w_a[d], b_a[d], w_x[d], b_x[d], lam[d])
        sc = _linear_scan(ac, bc, jnp.zeros_like(bc[:, 0]), rev)
        h0 = sc[:, 0] if rev else sc[:, -1]
        a, b = _rglru_gates(u, w_a[d], b_a[d], w_x[d], b_x[d], lam[d])
        lat.append(_linear_scan(a, b, h0, rev))
        ctxs.append(sc)
    h_lat = (lat[0] + lat[1]).astype(xr.dtype)
    h_ctx = (ctxs[0] + ctxs[1]).astype(xrc.dtype) if with_ctx else None
    return h_lat, h_ctx


def _merge(branches, gate_logits, b_gate, w_branch, w_out):
    g = jax.nn.sigmoid(gate_logits.reshape(gate_logits.shape[:-1] + (N_BRANCH, D_MODEL)) + b_gate)
    merged = g[..., 0, :] * (branches[0] @ w_branch[0])
    for k in range(1, N_BRANCH):
        merged = merged + g[..., k, :] * (branches[k] @ w_branch[k])
    return merged @ w_out


def _token_mixers(h, hc, row, col, w_in, b_gate, a_sink, nb_bias, c_conv_w, c_conv_b,
                  c_w_a, c_b_a, c_w_x, c_b_x, c_lam, d_conv_w, w_branch, w_out, with_ctx):
    qa, ka, va, qb, kb, vb, xr, gr, xd, bd, cd, gt = _split_cols(h @ w_in)
    qac, kac, vac, qbc, kbc, vbc, xrc, grc, xdc, bdc, cdc, gtc = _split_cols(hc @ w_in)
    ya, yac = _window_gqa(_rope_2d(_heads(qa, A_HEADS, A_HEAD_DIM), row, col),
                          _rope_2d(_heads(ka, A_KV_HEADS, A_HEAD_DIM), row, col),
                          _heads(va, A_KV_HEADS, A_HEAD_DIM),
                          _heads(qac, A_HEADS, A_HEAD_DIM), _heads(kac, A_KV_HEADS, A_HEAD_DIM),
                          _heads(vac, A_KV_HEADS, A_HEAD_DIM), a_sink, with_ctx)
    yb, ybc = _neighbourhood_attn(_heads(qb, B_HEADS, B_HEAD_DIM), _heads(kb, B_HEADS, B_HEAD_DIM),
                                  _heads(vb, B_HEADS, B_HEAD_DIM), _heads(qbc, B_HEADS, B_HEAD_DIM),
                                  _heads(kbc, B_HEADS, B_HEAD_DIM), _heads(vbc, B_HEADS, B_HEAD_DIM),
                                  nb_bias, with_ctx)
    hr, hrc = _rglru_bidir(xr, xrc, c_conv_w, c_conv_b, c_w_a, c_b_a, c_w_x, c_b_x, c_lam, with_ctx)
    yr = hr * jax.nn.gelu(gr)
    yd = bd * _dwconv(cd * xd, d_conv_w, D_CONV // 2)
    y = _merge([ya, yb, yr, yd], gt, b_gate, w_branch, w_out)
    if not with_ctx:
        return y, None
    yrc = hrc * jax.nn.gelu(grc)
    ydc = bdc * _dwconv(cdc * xdc, d_conv_w, D_CONV // 2)
    yc = _merge([yac, ybc, yrc, ydc], gtc, b_gate, w_branch, w_out)
    return y, yc


def _swiglu(h, w_ffn_in, w_ffn_out):
    g, u = jnp.split(h @ w_ffn_in, 2, axis=-1)
    return (jax.nn.silu(g) * u) @ w_ffn_out


def setup_inputs(seed: int = 0) -> dict:
    key = jax.random.key(seed)
    ks = jax.random.split(key, 26)
    n = jax.random.normal
    D = D_MODEL
    lam_u = jax.random.uniform(ks[16], (DEPTH, 2, C_WIDTH), F32, 0.9, 0.999)
    lam_s = lam_u ** (1.0 / C_POW)
    return {
        "x": n(ks[0], (BATCH, SEQ, D), F32),
        "c": n(ks[1], (BATCH, D), F32),
        "ctx": n(ks[2], (BATCH, CTX_LEN, D), F32),
        "c_ctx": n(ks[3], (D,), F32),
        "w_mod": n(ks[4], (DEPTH, D, N_MOD * D), F32) * (0.5 * D ** -0.5),
        "b_mod": n(ks[5], (DEPTH, N_MOD * D), F32) * 0.01,
        "norm1": 1.0 + 0.02 * n(ks[6], (DEPTH, D), F32),
        "norm2": 1.0 + 0.02 * n(ks[7], (DEPTH, D), F32),
        "w_in": n(ks[8], (DEPTH, D, IN_COLS), F32) * D ** -0.5,
        "b_gate": n(ks[9], (DEPTH, N_BRANCH, D), F32) * 0.1,
        "a_sink": n(ks[10], (DEPTH, A_HEADS), F32) * 0.5,
        "nb_bias": n(ks[11], (DEPTH, B_HEADS, 2 * NB_ROWS - 1, 2 * NB_COLS - 1), F32) * 0.2,
        "c_conv_w": n(ks[12], (DEPTH, C_CONV, C_WIDTH), F32) * C_CONV ** -0.5,
        "c_conv_b": n(ks[13], (DEPTH, C_WIDTH), F32) * 0.01,
        "c_w_a": n(ks[14], (DEPTH, 2, C_BLOCKS, C_BLOCK_W, C_BLOCK_W), F32) * C_BLOCK_W ** -0.5,
        "c_b_a": n(ks[15], (DEPTH, 2, C_WIDTH), F32) * 0.1,
        "c_w_x": n(ks[17], (DEPTH, 2, C_BLOCKS, C_BLOCK_W, C_BLOCK_W), F32) * C_BLOCK_W ** -0.5,
        "c_b_x": n(ks[18], (DEPTH, 2, C_WIDTH), F32) * 0.1,
        "c_lam": jnp.log(lam_s) - jnp.log1p(-lam_s),
        "d_conv_w": n(ks[19], (DEPTH, D_CONV, D_WIDTH), F32) * D_CONV ** -0.5,
        "w_branch": n(ks[20], (DEPTH, N_BRANCH, BRANCH_W, D), F32) * BRANCH_W ** -0.5,
        "w_out": n(ks[21], (DEPTH, D, D), F32) * D ** -0.5,
        "w_ffn_in": n(ks[22], (DEPTH, D, 2 * FFN_HIDDEN), F32) * D ** -0.5,
        "w_ffn_out": n(ks[23], (DEPTH, FFN_HIDDEN, D), F32) * FFN_HIDDEN ** -0.5,
        "final_norm": 1.0 + 0.02 * n(ks[24], (D,), F32),
    }


def reference(x, c, ctx, c_ctx, w_mod, b_mod, norm1, norm2, w_in, b_gate, a_sink, nb_bias,
              c_conv_w, c_conv_b, c_w_a, c_b_a, c_w_x, c_b_x, c_lam, d_conv_w, w_branch, w_out,
              w_ffn_in, w_ffn_out, final_norm):
    seq = x.shape[1]
    t = jnp.arange(seq)
    row, col = t // GRID_W, t % GRID_W
    xc = ctx
    s_lat = jax.nn.silu(c)
    s_ctx = jax.nn.silu(c_ctx)
    for l in range(DEPTH):
        with_ctx = l < DEPTH - 1
        mod = jnp.split((s_lat @ w_mod[l] + b_mod[l])[:, None, :], N_MOD, axis=-1)
        modc = jnp.split((s_ctx @ w_mod[l] + b_mod[l])[None, None, :], N_MOD, axis=-1)
        h = _modulate(_rmsnorm(x, norm1[l]), mod[0], mod[1])
        hc = _modulate(_rmsnorm(xc, norm1[l]), modc[0], modc[1])
        y, yc = _token_mixers(h, hc, row, col, w_in[l], b_gate[l], a_sink[l], nb_bias[l],
                              c_conv_w[l], c_conv_b[l], c_w_a[l], c_b_a[l], c_w_x[l], c_b_x[l],
                              c_lam[l], d_conv_w[l], w_branch[l], w_out[l], with_ctx)
        x = x + mod[2] * y
        x = x + mod[5] * _swiglu(_modulate(_rmsnorm(x, norm2[l]), mod[3], mod[4]), w_ffn_in[l], w_ffn_out[l])
        if with_ctx:
            xc = xc + modc[2] * yc
            xc = xc + modc[5] * _swiglu(_modulate(_rmsnorm(xc, norm2[l]), modc[3], modc[4]),
                                        w_ffn_in[l], w_ffn_out[l])
    return _rmsnorm(x, final_norm)
```

```cpp
#include <hip/hip_runtime.h>
#include <cstdio>
#include <cstdint>
namespace pg8 {
#define PG8_LAS __attribute__((address_space(3)))
typedef unsigned short bf16_t;
typedef short bf16x8 __attribute__((ext_vector_type(8)));
typedef float f32x4 __attribute__((ext_vector_type(4)));
typedef unsigned u32x4 __attribute__((ext_vector_type(4)));
constexpr int BM = 256, BK = 64, HALF = 128, HTB = HALF * BK * 2  , STAGE_BYTES = 8 * HTB, NXCD = 8, WGM = 8;

__host__ __device__ __forceinline__ int lds_byte(int r, int c) { const int st = (r >> 4) * 2 + (c >> 5), rr = r & 15, cc = c & 31, ob = rr * 64 + cc * 2; return st * 1024 + (ob ^ (((ob >> 9) & 1) << 5)); }
__host__ __device__ __forceinline__ void stage_rc(int b, int& R, int& C) { const int st = b / 1024, sb = b % 1024, swz = sb ^ (((sb >> 9) & 1) << 5); R = (st >> 1) * 16 + swz / 64; C = (st & 1) * 32 + (swz % 64) / 2; }
__host__ __device__ __forceinline__ int perm32(int rho) { const int n = rho >> 4, i = rho & 15; return 8 * (i >> 2) + 4 * n + (i & 3); }

struct Unit { int pm, pn; };
struct Gemm { const bf16_t* A; const bf16_t* Bt; int M, N, K; };

struct StaticOrder {
    int nM, nN, nwg, G, c;
    __host__ __device__ void init(int M, int N, int G_, int c_) { nM = M / BM; nN = N / BM; nwg = nM * nN; G = G_; c = c_; }
    __host__ __device__ bool next(int i, Unit& u) const {
        const long L = (long)i * G + c; if (L >= nwg) return false;
        int wgid = (int)L; { const int q = nwg / NXCD, r = nwg % NXCD, xcd = wgid % NXCD, off = wgid / NXCD; wgid = (xcd < r ? xcd * (q + 1) : r * (q + 1) + (xcd - r) * q) + off; }
        const int nig = WGM * nN, gid = wgid / nig, fm = gid * WGM, gsz = (nM - fm) < WGM ? (nM - fm) : WGM;
        u.pm = fm + ((wgid % nig) % gsz); u.pn = (wgid % nig) / gsz; return true;
    }
    __device__ __forceinline__ void a_ready(const Unit&) const {}
    __device__ __forceinline__ void done(const Unit&) const {}
};
typedef float f32x2 __attribute__((ext_vector_type(2)));
typedef __bf16 bf16x2_t __attribute__((ext_vector_type(2)));
__device__ __forceinline__ unsigned cvt_pk_bf16(float lo, float hi) { f32x2 v = {lo, hi}; bf16x2_t b = __builtin_convertvector(v, bf16x2_t); return __builtin_bit_cast(unsigned, b); }
__device__ __forceinline__ float sigmoidf_fast(float x) { return __builtin_amdgcn_rcpf(1.0f + __expf(-x)); }
__device__ __forceinline__ float bf2f(unsigned short b) { return __uint_as_float(((unsigned)b) << 16); }

struct EpiIn {
    static constexpr bool PERM = true, AFTER_DRAIN = false, HAS_MID = false;
    bf16_t* Z; bf16_t* G; const float* bgate; const float* ropec; const float* ropes;
    __device__ __forceinline__ void operator()(const f32x4 (&acc)[2][2][4][2], const Unit& u, int wr, int wc, int fr, int fq) const {
        const int row0 = u.pm * BM + wr * 64 + fr;
        if (u.pn >= 19) {
            const int col0 = (u.pn - 19) * BM + wc * 32 + 8 * fq;
            f32x4 bv[2][2];
#pragma unroll
            for (int bj = 0; bj < 2; ++bj)
#pragma unroll
                for (int n = 0; n < 2; ++n) bv[bj][n] = *(const f32x4*)(bgate + col0 + bj * HALF + 4 * n);
#pragma unroll
            for (int ai = 0; ai < 2; ++ai)
#pragma unroll
                for (int m = 0; m < 4; ++m) { bf16_t* rowp = G + (size_t)(row0 + ai * HALF + m * 16) * 8192 + col0;
#pragma unroll
                    for (int bj = 0; bj < 2; ++bj) { const f32x4 v0 = acc[ai][bj][m][0] + bv[bj][0], v1 = acc[ai][bj][m][1] + bv[bj][1];
                        u32x4 w; w.x = cvt_pk_bf16(sigmoidf_fast(v0[0]), sigmoidf_fast(v0[1])); w.y = cvt_pk_bf16(sigmoidf_fast(v0[2]), sigmoidf_fast(v0[3]));
                        w.z = cvt_pk_bf16(sigmoidf_fast(v1[0]), sigmoidf_fast(v1[1])); w.w = cvt_pk_bf16(sigmoidf_fast(v1[2]), sigmoidf_fast(v1[3]));
                        *(u32x4*)(rowp + bj * HALF) = w; } }
        } else {
            const int colt = u.pn * BM, col0 = colt + wc * 32 + 8 * fq;
            const bool rope_tile = (u.pn <= 2) && (u.pm < 32);
#pragma unroll
            for (int ai = 0; ai < 2; ++ai)
#pragma unroll
                for (int m = 0; m < 4; ++m) { const int t = row0 + ai * HALF + m * 16; bf16_t* rowp = Z + (size_t)t * 4864 + col0;
#pragma unroll
                    for (int bj = 0; bj < 2; ++bj) { f32x4 v0 = acc[ai][bj][m][0], v1 = acc[ai][bj][m][1];
                        if (rope_tile && (colt + bj * HALF < 640)) {
                            const int pos = (wc & 1) ? (t & 63) : (t >> 6);
                            const float* cp = ropec + pos * 16 + 8 * (fq & 1); const float* sp = ropes + pos * 16 + 8 * (fq & 1);
                            const f32x4 c0 = *(const f32x4*)cp, c1 = *(const f32x4*)(cp + 4), s0 = *(const f32x4*)sp, s1 = *(const f32x4*)(sp + 4);
                            f32x4 p0, p1;
#pragma unroll
                            for (int e = 0; e < 4; ++e) { p0[e] = __shfl_xor(v0[e], 32); p1[e] = __shfl_xor(v1[e], 32); }
                            if (fq < 2) { v0 = v0 * c0 - p0 * s0; v1 = v1 * c1 - p1 * s1; }
                            else        { v0 = p0 * s0 + v0 * c0; v1 = p1 * s1 + v1 * c1; }
                        }
                        u32x4 w; w.x = cvt_pk_bf16(v0[0], v0[1]); w.y = cvt_pk_bf16(v0[2], v0[3]); w.z = cvt_pk_bf16(v1[0], v1[1]); w.w = cvt_pk_bf16(v1[2], v1[3]);
                        *(u32x4*)(rowp + bj * HALF) = w; } }
        }
    }
};

struct EpiMerge {
    static constexpr bool PERM = true, AFTER_DRAIN = false, HAS_MID = true;
    const bf16_t* G; bf16_t* O;
    __device__ __forceinline__ void mid(f32x4 (&acc)[2][2][4][2], const Unit& u, int seg, int wr, int wc, int fr, int fq) const {
        int row0 = u.pm * BM + wr * 64 + fr; asm volatile("" : "+v"(row0));
        const int col0 = u.pn * BM + wc * 32 + 8 * fq;
#pragma unroll
        for (int ai = 0; ai < 2; ++ai)
#pragma unroll
            for (int m = 0; m < 4; ++m) { const bf16_t* rowp = G + (size_t)(row0 + ai * HALF + m * 16) * 8192 + col0 + seg * 2048;
#pragma unroll
                for (int bj = 0; bj < 2; ++bj) { const u32x4 ga = *(const u32x4*)(rowp + bj * HALF), gb = *(const u32x4*)(rowp + 2048 + bj * HALF);
#pragma unroll
                    for (int e = 0; e < 4; ++e) { const unsigned a = ga[e], b = gb[e];
                        const float a0 = fmaxf(__uint_as_float(a << 16), 1e-30f), a1 = fmaxf(__uint_as_float(a & 0xffff0000u), 1e-30f);
                        const float b0 = fmaxf(__uint_as_float(b << 16), 1e-30f), b1 = fmaxf(__uint_as_float(b & 0xffff0000u), 1e-30f);
                        acc[ai][bj][m][e >> 1][(e & 1) * 2]     *= a0 * __builtin_amdgcn_rcpf(b0);
                        acc[ai][bj][m][e >> 1][(e & 1) * 2 + 1] *= a1 * __builtin_amdgcn_rcpf(b1); } }
                asm volatile("" ::: "memory"); }
    }
    __device__ __forceinline__ void operator()(const f32x4 (&acc)[2][2][4][2], const Unit& u, int wr, int wc, int fr, int fq) const {
        const int row0 = u.pm * BM + wr * 64 + fr, col0 = u.pn * BM + wc * 32 + 8 * fq;
#pragma unroll
        for (int ai = 0; ai < 2; ++ai)
#pragma unroll
            for (int m = 0; m < 4; ++m) { const size_t r = (size_t)(row0 + ai * HALF + m * 16); const bf16_t* gp = G + r * 8192 + col0 + 3 * 2048; bf16_t* op = O + r * 2048 + col0;
#pragma unroll
                for (int bj = 0; bj < 2; ++bj) { const u32x4 g = *(const u32x4*)(gp + bj * HALF); float gv[8];
#pragma unroll
                    for (int e = 0; e < 4; ++e) { gv[2 * e] = fmaxf(__uint_as_float(g[e] << 16), 1e-30f); gv[2 * e + 1] = fmaxf(__uint_as_float(g[e] & 0xffff0000u), 1e-30f); }
                    const f32x4 v0 = acc[ai][bj][m][0], v1 = acc[ai][bj][m][1];
                    u32x4 w; w.x = cvt_pk_bf16(v0[0] * gv[0], v0[1] * gv[1]); w.y = cvt_pk_bf16(v0[2] * gv[2], v0[3] * gv[3]); w.z = cvt_pk_bf16(v1[0] * gv[4], v1[1] * gv[5]); w.w = cvt_pk_bf16(v1[2] * gv[6], v1[3] * gv[7]);
                    *(u32x4*)(op + bj * HALF) = w; }
                asm volatile("" ::: "memory"); }
    }
};

struct EpiResid {
    static constexpr bool PERM = false, AFTER_DRAIN = false, HAS_MID = false;
    float* xl; float* xc; const float* gate_l; const float* gate_c;
    __device__ __forceinline__ void operator()(const f32x4 (&acc)[2][2][4][2], const Unit& u, int wr, int wc, int fr, int fq) const {
        const int row0 = u.pm * BM + wr * 64 + fr, col0 = u.pn * BM + wc * 32 + 4 * fq;
        const bool lat = u.pm < 32;
        float* X = lat ? xl : (xc - (size_t)8192 * 2048); const float* gate = lat ? gate_l : gate_c;
        f32x4 gv[2][2];
#pragma unroll
        for (int bj = 0; bj < 2; ++bj)
#pragma unroll
            for (int n = 0; n < 2; ++n) gv[bj][n] = *(const f32x4*)(gate + col0 + bj * HALF + n * 16);
#pragma unroll
        for (int ai = 0; ai < 2; ++ai)
#pragma unroll
            for (int m = 0; m < 4; ++m) { float* rowp = X + (size_t)(row0 + ai * HALF + m * 16) * 2048 + col0;
#pragma unroll
                for (int bj = 0; bj < 2; ++bj)
#pragma unroll
                    for (int n = 0; n < 2; ++n) { f32x4* q = (f32x4*)(rowp + bj * HALF + n * 16); *q = *q + gv[bj][n] * acc[ai][bj][m][n]; }
                if (m & 1) asm volatile("" ::: "memory"); }
    }
};

struct EpiSwiglu {
    static constexpr bool PERM = true, AFTER_DRAIN = false, HAS_MID = false;
    bf16_t* O;
    __device__ __forceinline__ void operator()(const f32x4 (&acc)[2][2][4][2], const Unit& u, int wr, int wc, int fr, int fq) const {
        const int row0 = u.pm * BM + wr * 64 + fr, col0 = u.pn * HALF + wc * 32 + 8 * fq;
#pragma unroll
        for (int ai = 0; ai < 2; ++ai)
#pragma unroll
            for (int m = 0; m < 4; ++m) { bf16_t* op = O + (size_t)(row0 + ai * HALF + m * 16) * 5632 + col0; float o[8];
#pragma unroll
                for (int n = 0; n < 2; ++n)
#pragma unroll
                    for (int e = 0; e < 4; ++e) { const float g = acc[ai][0][m][n][e], uu = acc[ai][1][m][n][e]; o[4 * n + e] = g * sigmoidf_fast(g) * uu; }
                u32x4 w; w.x = cvt_pk_bf16(o[0], o[1]); w.y = cvt_pk_bf16(o[2], o[3]); w.z = cvt_pk_bf16(o[4], o[5]); w.w = cvt_pk_bf16(o[6], o[7]);
                *(u32x4*)op = w; }
    }
};

template <class Epi, class Sched, bool ALIGN_EPI = false, bool SP2 = false>
__device__ __forceinline__ void gemm_phase(PG8_LAS unsigned char* lds, const Gemm g, const Sched& S, const Epi& E) {
    int tid_ = threadIdx.x; asm volatile("" : "+v"(tid_));
    const int tid = tid_, wid = __builtin_amdgcn_readfirstlane(tid >> 6), lane = tid & 63, wr = wid >> 2, wc = wid & 3, fr = lane & 15, fq = lane >> 4;
    const int K = g.K, nt = K / BK;
    unsigned voffA[2], voffB[2];
#pragma unroll
    for (int i = 0; i < 2; ++i) { int R, C; stage_rc(tid * 16 + i * 8192, R, C); const int Rb = Epi::PERM ? ((R & ~31) + perm32(R & 31)) : R;
        voffA[i] = (unsigned)(R * K + C) * 2u; voffB[i] = (unsigned)(Rb * K + C) * 2u; }
    const size_t kstep = (size_t)(BK * 2);
    const size_t hstep = (size_t)HALF * K * 2;
    const size_t tstep = 2 * hstep;
    const unsigned ldsw = (unsigned)wid * 1024u;
    const int aoff = lds_byte(wr * 64 + fr, fq * 8), boff = lds_byte(wc * 32 + fr, fq * 8);
#define PG8_SA(b, h) (((b) * 2 + (h)) * HTB)
#define PG8_SB(b, h) ((4 + (b) * 2 + (h)) * HTB)
#define PG8_STAGE(bufoff, gbase, voff) do { _Pragma("unroll") for (int _i = 0; _i < 2; ++_i) \
        __builtin_amdgcn_global_load_lds((const unsigned*)((const char*)(gbase) + (voff)[_i]), (PG8_LAS unsigned*)(lds + (bufoff) + ldsw + _i * 8192), 16, 0, 0); } while (0)
#define PG8_LDA(dst, b, h) do { _Pragma("unroll") for (int m = 0; m < 4; ++m) _Pragma("unroll") for (int k = 0; k < 2; ++k) dst[m][k] = *(const PG8_LAS bf16x8*)(lds + PG8_SA(b, h) + aoff + m * 2048 + k * 1024); } while (0)
#define PG8_LDB(dst, b, h) do { _Pragma("unroll") for (int n = 0; n < 2; ++n) _Pragma("unroll") for (int k = 0; k < 2; ++k) dst[n][k] = *(const PG8_LAS bf16x8*)(lds + PG8_SB(b, h) + boff + n * 2048 + k * 1024); } while (0)
#define PG8_MMA(ai, bj, At, Bt) do { __builtin_amdgcn_s_setprio(1); _Pragma("unroll") for (int m = 0; m < 4; ++m) _Pragma("unroll") for (int n = 0; n < 2; ++n) _Pragma("unroll") for (int k = 0; k < 2; ++k) \
        acc[ai][bj][m][n] = __builtin_amdgcn_mfma_f32_16x16x32_bf16(Bt[n][k], At[m][k], acc[ai][bj][m][n], 0, 0, 0); __builtin_amdgcn_s_setprio(0); } while (0)
#define PG8_WAIT_V(n) asm volatile("s_waitcnt vmcnt(" #n ")" ::: "memory")
#define PG8_WAIT_L(n) asm volatile("s_waitcnt lgkmcnt(" #n ")" ::: "memory")
#define PG8_BAR __builtin_amdgcn_s_barrier()
#define PG8_SCHED __builtin_amdgcn_sched_barrier(0)
    Unit cur, nxt; int ui = 0;
    if (!S.next(0, cur)) return;
    f32x4 acc[2][2][4][2];
#pragma unroll
    for (int a = 0; a < 2; ++a)
#pragma unroll
        for (int b = 0; b < 2; ++b)
#pragma unroll
            for (int m = 0; m < 4; ++m)
#pragma unroll
                for (int n = 0; n < 2; ++n) acc[a][b][m][n] = (f32x4){0.f, 0.f, 0.f, 0.f};
    bf16x8 At[4][2], B0[2][2], B1[2][2];
    const char* cA = (const char*)g.A + (size_t)cur.pm * tstep; const char* cB = (const char*)g.Bt + (size_t)cur.pn * tstep;
    S.a_ready(cur);
    if constexpr (SP2) {
        PG8_STAGE(PG8_SB(0, 0), cB, voffB); PG8_STAGE(PG8_SB(0, 1), cB + hstep, voffB); PG8_STAGE(PG8_SA(0, 0), cA, voffA); PG8_STAGE(PG8_SA(0, 1), cA + hstep, voffA);
        if (wr == 1) PG8_BAR;
        PG8_WAIT_V(2); PG8_BAR;
        PG8_STAGE(PG8_SB(1, 0), cB + kstep, voffB); PG8_STAGE(PG8_SA(1, 0), cA + kstep, voffA); PG8_STAGE(PG8_SB(1, 1), cB + hstep + kstep, voffB);
        PG8_WAIT_V(6); PG8_BAR;
    } else {
        PG8_STAGE(PG8_SB(0, 0), cB, voffB); PG8_STAGE(PG8_SA(0, 0), cA, voffA); PG8_STAGE(PG8_SB(0, 1), cB + hstep, voffB); PG8_STAGE(PG8_SA(0, 1), cA + hstep, voffA);
        if (wr == 1) PG8_BAR;
        PG8_WAIT_V(4); PG8_BAR;
        PG8_STAGE(PG8_SB(1, 0), cB + kstep, voffB); PG8_STAGE(PG8_SA(1, 0), cA + kstep, voffA); PG8_STAGE(PG8_SB(1, 1), cB + hstep + kstep, voffB);
        PG8_WAIT_V(6); PG8_BAR;
    }
    for (;;) {
        const bool has_next = S.next(ui + 1, nxt);
        const char* nA = has_next ? (const char*)g.A + (size_t)nxt.pm * tstep : cA; const char* nB = has_next ? (const char*)g.Bt + (size_t)nxt.pn * tstep : cB;
        for (int t = 0; t < nt; t += 2) {
            const bool last = (t == nt - 2);
            const char* a1 = cA + (size_t)(t + 1) * kstep;
            const char* a2 = last ? nA : cA + (size_t)(t + 2) * kstep; const char* b2 = last ? nB : cB + (size_t)(t + 2) * kstep;
            const char* a3 = a2 + kstep; const char* b3 = b2 + kstep;
            if (last && has_next) S.a_ready(nxt);
            if constexpr (SP2) {
            PG8_LDB(B0, 0, 0); PG8_LDB(B1, 0, 1); PG8_SCHED; PG8_LDA(At, 0, 0); PG8_STAGE(PG8_SA(1, 1), a1 + hstep, voffA);
            PG8_WAIT_V(8); PG8_WAIT_L(0); PG8_BAR; PG8_MMA(0, 0, At, B0); PG8_MMA(0, 1, At, B1); PG8_BAR; PG8_SCHED;
            PG8_LDA(At, 0, 1); PG8_STAGE(PG8_SB(0, 0), b2, voffB); PG8_STAGE(PG8_SB(0, 1), b2 + hstep, voffB); PG8_STAGE(PG8_SA(0, 0), a2, voffA);
            PG8_WAIT_V(8); PG8_WAIT_L(0); PG8_BAR; PG8_MMA(1, 0, At, B0); PG8_MMA(1, 1, At, B1); PG8_BAR; PG8_SCHED;
            PG8_LDB(B0, 1, 0); PG8_LDB(B1, 1, 1); PG8_SCHED; PG8_LDA(At, 1, 0); PG8_STAGE(PG8_SA(0, 1), a2 + hstep, voffA);
            PG8_WAIT_V(8); PG8_WAIT_L(0); PG8_BAR; PG8_MMA(0, 0, At, B0); PG8_MMA(0, 1, At, B1); PG8_BAR; PG8_SCHED;
            PG8_LDA(At, 1, 1); PG8_STAGE(PG8_SB(1, 0), b3, voffB); PG8_STAGE(PG8_SB(1, 1), b3 + hstep, voffB); PG8_STAGE(PG8_SA(1, 0), a3, voffA);
            PG8_WAIT_V(8); PG8_WAIT_L(0); PG8_BAR; PG8_MMA(1, 0, At, B0); PG8_MMA(1, 1, At, B1); PG8_BAR; PG8_SCHED;
            } else {
            PG8_LDB(B0, 0, 0); PG8_SCHED; PG8_LDA(At, 0, 0); PG8_STAGE(PG8_SA(1, 1), a1 + hstep, voffA);
            PG8_WAIT_L(8); PG8_BAR; PG8_WAIT_L(0); PG8_MMA(0, 0, At, B0); PG8_BAR; PG8_SCHED;
            PG8_LDB(B1, 0, 1); PG8_STAGE(PG8_SB(0, 0), b2, voffB);
            PG8_BAR; PG8_WAIT_L(0); PG8_MMA(0, 1, At, B1); PG8_BAR;
            PG8_LDA(At, 0, 1); PG8_STAGE(PG8_SA(0, 0), a2, voffA);
            PG8_BAR; PG8_WAIT_L(0); PG8_MMA(1, 0, At, B0); PG8_BAR; PG8_SCHED;
            PG8_STAGE(PG8_SB(0, 1), b2 + hstep, voffB);
            PG8_WAIT_V(6); PG8_BAR; PG8_MMA(1, 1, At, B1); PG8_BAR;
            PG8_LDB(B0, 1, 0); PG8_SCHED; PG8_LDA(At, 1, 0); PG8_STAGE(PG8_SA(0, 1), a2 + hstep, voffA);
            PG8_WAIT_L(8); PG8_BAR; PG8_WAIT_L(0); PG8_MMA(0, 0, At, B0); PG8_BAR; PG8_SCHED;
            PG8_LDB(B1, 1, 1); PG8_STAGE(PG8_SB(1, 0), b3, voffB);
            PG8_BAR; PG8_WAIT_L(0); PG8_MMA(0, 1, At, B1); PG8_BAR;
            PG8_LDA(At, 1, 1); PG8_STAGE(PG8_SA(1, 0), a3, voffA);
            PG8_BAR; PG8_WAIT_L(0); PG8_MMA(1, 0, At, B0); PG8_BAR; PG8_SCHED;
            PG8_STAGE(PG8_SB(1, 1), b3 + hstep, voffB);
            PG8_WAIT_V(6); PG8_BAR; PG8_MMA(1, 1, At, B1); PG8_BAR;
            }
            if constexpr (Epi::HAS_MID) { if ((((t + 2) & 7) == 0) && ((t + 2) < nt)) E.mid(acc, cur, ((t + 2) >> 3) - 1, wr, wc, fr, fq); }
        }
        if constexpr (ALIGN_EPI) { if (wr == 0) PG8_BAR; }
        if constexpr (!Epi::AFTER_DRAIN) { E(acc, cur, wr, wc, fr, fq); S.done(cur); }
        if (!has_next) break;
#pragma unroll
        for (int a = 0; a < 2; ++a)
#pragma unroll
            for (int b = 0; b < 2; ++b)
#pragma unroll
                for (int m = 0; m < 4; ++m)
#pragma unroll
                    for (int n = 0; n < 2; ++n) acc[a][b][m][n] = (f32x4){0.f, 0.f, 0.f, 0.f};
        cur = nxt; cA = nA; cB = nB; ++ui;
        if constexpr (ALIGN_EPI) { if (wr == 1) PG8_BAR; }
    }
    PG8_WAIT_V(0);
    if constexpr (!ALIGN_EPI) { if (wr == 0) PG8_BAR; }
    PG8_BAR;
    if constexpr (Epi::AFTER_DRAIN) { E.fused(acc, cur, wr, wc, fr, fq, lds, wid, lane); S.done(cur); }
#undef PG8_SA
#undef PG8_SB
#undef PG8_STAGE
#undef PG8_LDA
#undef PG8_LDB
#undef PG8_MMA
#undef PG8_WAIT_V
#undef PG8_WAIT_L
#undef PG8_BAR
#undef PG8_SCHED
}
}

constexpr int NWAVES = 8;
constexpr int DM = 2048, SEQ = 8192, CTXL = 256, MT = SEQ + CTXL, DEPTH = 4, GRIDW = 64;
constexpr int INC = 13056, ZC = 4864, GC = 8192, BW = 512, FHID = 5632, F2 = 2 * FHID, NMOD = 6 * DM;
constexpr int ZC_QA = 0, ZC_KA = 512, ZC_VA = 640, ZC_QB = 768, ZC_KB = 1280, ZC_VB = 1792, ZC_XR = 2304, ZC_GR = 2816, ZC_XD = 3328, ZC_BD = 3840, ZC_CD = 4352;
constexpr float EPS = 1e-6f, LOG2E = 1.4426950408889634f;
constexpr int NPL = 9;
constexpr int N_PHASES = 2 + DEPTH * NPL;
#ifndef MK_ONE_LAUNCH
#define MK_ONE_LAUNCH 0
#endif
constexpr size_t MiB = 1u << 20;
constexpr size_t WS_CTL = 0, CTL_ZERO_BYTES = 1 * MiB;
constexpr size_t WS_MOD = 1 * MiB;
constexpr size_t WS_ROPE = 2 * MiB;
constexpr size_t WS_GW = 3 * MiB;
constexpr size_t WS_XC = 5 * MiB;
constexpr size_t WS_PS = 7 * MiB;
constexpr size_t WS_AB = 16 * MiB;
constexpr size_t WS_H = 88 * MiB;
constexpr size_t WS_Z = 124 * MiB;
constexpr size_t WS_G = 204 * MiB;
constexpr size_t WS_BR = 336 * MiB;
constexpr size_t WS_MG = 372 * MiB;
constexpr size_t WS_FH = 408 * MiB;
constexpr size_t WS_W = 512 * MiB;
constexpr size_t WL_IN = 0, WL_BR = 51 * MiB, WL_OUT = 59 * MiB, WL_F1 = 67 * MiB, WL_F2 = 111 * MiB, WL_STRIDE = 133 * MiB;
constexpr size_t WS_END = WS_W + DEPTH * WL_STRIDE;
static_assert((size_t)INC * DM * 2 <= WL_BR && (size_t)DM * DM * 2 <= WL_OUT - WL_BR && (size_t)F2 * DM * 2 <= WL_F2 - WL_F1 && (size_t)DM * FHID * 2 <= WL_STRIDE - WL_F2, "weight map");
static_assert(WS_AB + (size_t)4 * MT * 512 * 4 <= WS_H && WS_H + (size_t)MT * DM * 2 <= WS_Z && WS_Z + (size_t)MT * ZC * 2 <= WS_G && WS_G + (size_t)MT * GC * 2 <= WS_BR && WS_FH + (size_t)MT * FHID * 2 <= WS_W, "d_ws map");
constexpr int CW_BAR = 4096;
constexpr int RING_BYTES = 131072;
constexpr int LDSCTL_OFF = RING_BYTES, MISC_OFF = LDSCTL_OFF + 320;
constexpr int LDS_BYTES = 147456;

#define GAS __attribute__((address_space(1)))
#define LAS __attribute__((address_space(3)))
typedef unsigned short bf16;
typedef unsigned v4u __attribute__((ext_vector_type(4)));
typedef unsigned v2u __attribute__((ext_vector_type(2)));
typedef float f32x4 __attribute__((ext_vector_type(4)));
typedef float f32x16 __attribute__((ext_vector_type(16)));
typedef short bf16x8 __attribute__((ext_vector_type(8)));
typedef short s16x4 __attribute__((ext_vector_type(4)));
typedef GAS unsigned gu32;
#define RLX_AGENT __ATOMIC_RELAXED, __HIP_MEMORY_SCOPE_AGENT
#define LDS_WAIT() asm volatile("s_waitcnt lgkmcnt(0)" ::: "memory")
__device__ __forceinline__ unsigned f2bf(float f) { unsigned u = __builtin_bit_cast(unsigned, f); return (u + 0x7fffu + ((u >> 16) & 1u)) >> 16; }
__device__ __forceinline__ unsigned pk2(float lo, float hi) { return f2bf(lo) | (f2bf(hi) << 16); }
__device__ __forceinline__ float bflo(unsigned w) { return __uint_as_float(w << 16); }
__device__ __forceinline__ float bfhi(unsigned w) { return __uint_as_float(w & 0xffff0000u); }
__device__ __forceinline__ float bf1(bf16 b) { return __uint_as_float(((unsigned)b) << 16); }
__device__ __forceinline__ float sigm(float x) { return __builtin_amdgcn_rcpf(1.0f + __expf(-x)); }

#define XB_TMO      128
#define XB_XCNT(j)  (256  + 64 * (j))
#define XB_XSUB(j)  (1280 + 64 * (j))
#define XB_XGEN(j)  (2304 + 64 * (j))
#define XB_TOP      3328
#define XB_TOPGEN   3392
#define XCD_BAR_WORDS 3456
#define XB_SPIN_CAP (1u << 18)

__device__ __forceinline__ unsigned xb_ld(unsigned* p)              { return __hip_atomic_load(p, __ATOMIC_RELAXED, __HIP_MEMORY_SCOPE_AGENT); }
__device__ __forceinline__ unsigned xb_add(unsigned* p, unsigned v) { return __hip_atomic_fetch_add(p, v, __ATOMIC_RELAXED, __HIP_MEMORY_SCOPE_AGENT); }
__device__ __forceinline__ unsigned xb_xcc_id() { return (unsigned)__builtin_amdgcn_s_getreg((3 << 11) | 20) & 0xFu; }
#define XB_SPIN(cond, bar) do { unsigned _sp = 0; while (cond) { __builtin_amdgcn_s_sleep(1); \
    if ((++_sp & 255u) == 0u) { if (xb_ld(&(bar)[XB_TMO])) break; if (_sp > XB_SPIN_CAP) { atomicAdd(&(bar)[XB_TMO], 1u); break; } } } } while (0)

struct XcdBarrier {
    unsigned* bar; unsigned x;
    volatile LAS unsigned* st;
};

__device__ __forceinline__ XcdBarrier xcd_barrier_post(unsigned* bar, volatile LAS unsigned* st) {
    XcdBarrier b; b.bar = bar; b.x = xb_xcc_id(); b.st = st;
    if (threadIdx.x == 0) (void)xb_add(&bar[XB_XCNT(b.x)], 1u);
    return b;
}
__device__ __forceinline__ void xcd_barrier_complete(unsigned* bar, unsigned x, unsigned& nloc, unsigned& nx) {
    const unsigned G = gridDim.x * gridDim.y * gridDim.z;
    unsigned sum, cnt, mine, sp = 0u;
    for (;;) {
        sum = 0u; cnt = 0u; mine = 0u;
#pragma unroll
        for (unsigned j = 0; j < 16; ++j) { const unsigned c = xb_ld(&bar[XB_XCNT(j)]); sum += c; cnt += (c > 0u) ? 1u : 0u; mine = (j == x) ? c : mine; }
        if (sum == G) break;
        __builtin_amdgcn_s_sleep(1);
        if ((++sp & 255u) == 0u) { if (xb_ld(&bar[XB_TMO])) break; if (sp > XB_SPIN_CAP) { atomicAdd(&bar[XB_TMO], 1u); break; } }
    }
    nloc = mine > 0u ? mine : 1u; nx = cnt > 0u ? cnt : 1u;
}

__device__ __forceinline__ void xcd_barrier(const XcdBarrier& b) {
    asm volatile("s_waitcnt vmcnt(0)" ::: "memory");
    __syncthreads();
    if (threadIdx.x == 0) {
        unsigned* bar = b.bar;
        __builtin_amdgcn_s_waitcnt(0);
        unsigned nloc = b.st[0], nx = b.st[1];
        if (nloc == 0u) { xcd_barrier_complete(bar, b.x, nloc, nx); b.st[0] = nloc; b.st[1] = nx; }
        const unsigned old = xb_add(&bar[XB_XSUB(b.x)], 1u);
        const unsigned gen = old / nloc;
        if (old + 1u == (gen + 1u) * nloc) {
            __builtin_amdgcn_fence(__ATOMIC_RELEASE, "agent");
            asm volatile("s_waitcnt vmcnt(0)" ::: "memory");
            const unsigned og = xb_add(&bar[XB_TOP], 1u);
            const unsigned tg = og / nx;
            if (og + 1u == (tg + 1u) * nx) xb_add(&bar[XB_TOPGEN], 1u);
            else XB_SPIN(xb_ld(&bar[XB_TOPGEN]) == tg, bar);
            __builtin_amdgcn_fence(__ATOMIC_ACQUIRE, "agent");
            xb_add(&bar[XB_XGEN(b.x)], 1u);
            asm volatile("s_waitcnt vmcnt(0)" ::: "memory");
        } else {
            XB_SPIN(xb_ld(&bar[XB_XGEN(b.x)]) == gen, bar);
            __builtin_amdgcn_fence(__ATOMIC_ACQUIRE, "agent");
            asm volatile("s_waitcnt vmcnt(0)" ::: "memory");
        }
    }
    __syncthreads();
}

#define KAS __attribute__((address_space(4)))
struct Args { const float* in[25]; float* out; unsigned char* ws; int ph_lo, ph_hi; };
struct Frame {
    LAS unsigned char* lds;
    volatile LAS unsigned* MISC;
    gu32* ctl;
    int tid, lane, wave, G;
    const KAS Args* ka;
    float* out; unsigned char* ws;
};
enum { I_X = 0, I_C, I_CTX, I_CCTX, I_WMOD, I_BMOD, I_NORM1, I_NORM2, I_WIN, I_BGATE, I_ASINK, I_NBBIAS, I_CCONVW, I_CCONVB, I_CWA, I_CBA, I_CWX, I_CBX, I_CLAM, I_DCONVW, I_WBR, I_WOUT, I_WF1, I_WF2, I_FNORM };

__device__ __forceinline__ float wave_sum(float v) {
#pragma unroll
    for (int o = 1; o < 64; o <<= 1) v += __shfl_xor(v, o);
    return v;
}

__device__ __forceinline__ void transpose_item(const float* W, int ldw, int k0, int n0, bf16* dst, int ldt, LAS float* scr, int lane) {
#pragma unroll 8
    for (int i = 0; i < 32; ++i) { const int kk = 2 * i + (lane >> 5); scr[kk * 33 + (lane & 31)] = W[(size_t)(k0 + kk) * ldw + n0 + (lane & 31)]; }
    LDS_WAIT(); asm volatile("" ::: "memory");
    const int c = lane & 7;
#pragma unroll
    for (int j = 0; j < 4; ++j) { const int n = (lane >> 3) + 8 * j; const LAS float* s = scr + (8 * c) * 33 + n;
        v4u o; o.x = pk2(s[0 * 33], s[1 * 33]); o.y = pk2(s[2 * 33], s[3 * 33]); o.z = pk2(s[4 * 33], s[5 * 33]); o.w = pk2(s[6 * 33], s[7 * 33]);
        *(GAS v4u*)(dst + (size_t)n * ldt + 8 * c) = o; }
    LDS_WAIT(); asm volatile("" ::: "memory");
}

__device__ __forceinline__ void p0_prologue(Frame& F) {
    const int gw = blockIdx.x * NWAVES + F.wave, NGW = F.G * NWAVES;
    const int gt = blockIdx.x * (NWAVES * 64) + F.tid, NGT = F.G * NWAVES * 64;
    if (gt < 2048) {
        const int pos = gt >> 4, i = gt & 15;
        const float freq = exp2f(-(float)i * (13.287712379549449f / 16.0f));
        const float ang = (float)pos * freq;
        const float k = rintf(ang * 0.15915494309189535f);
        float r = fmaf(-k, 6.28125f, ang); r = fmaf(-k, 0.0019353071795864769f, r);
        float* rc = (float*)(F.ws + WS_ROPE);
        rc[gt] = __cosf(r); rc[2048 + gt] = __sinf(r);
    }
    {
        const f32x4* xs = (const f32x4*)F.ka->in[I_X]; f32x4* xd = (f32x4*)F.out;
        for (int i = gt; i < SEQ * DM / 4; i += NGT) xd[i] = xs[i];
        const f32x4* cs = (const f32x4*)F.ka->in[I_CTX]; f32x4* cd = (f32x4*)(F.ws + WS_XC);
        for (int i = gt; i < CTXL * DM / 4; i += NGT) cd[i] = cs[i];
    }
    {
        LAS float* sl = (LAS float*)F.lds;
        LAS float* sc = sl + 2048;
        LAS float* red = sc + 2048;
        for (int i = F.tid; i < 2048; i += NWAVES * 64) { const float a = F.ka->in[I_C][i], b = F.ka->in[I_CCTX][i]; sl[i] = a * sigm(a); sc[i] = b * sigm(b); }
        __syncthreads();
        const int half = F.lane >> 5, c4 = F.lane & 31;
        for (int item = blockIdx.x; item < DEPTH * 96; item += F.G) {
            const int l = item / 96, col0 = (item % 96) * 128;
            const float* W = F.ka->in[I_WMOD] + (size_t)l * DM * NMOD + col0 + 4 * c4;
            f32x4 al = {0.f, 0.f, 0.f, 0.f}, ac = {0.f, 0.f, 0.f, 0.f};
#pragma unroll 8
            for (int i = 0; i < 128; ++i) { const int row = F.wave * 256 + 2 * i + half; const f32x4 v = *(const f32x4*)(W + (size_t)row * NMOD); al += sl[row] * v; ac += sc[row] * v; }
#pragma unroll
            for (int e = 0; e < 4; ++e) { al[e] += __shfl_xor(al[e], 32); ac[e] += __shfl_xor(ac[e], 32); }
            if (half == 0) { *(LAS f32x4*)(red + (F.wave * 2 + 0) * 128 + 4 * c4) = al; *(LAS f32x4*)(red + (F.wave * 2 + 1) * 128 + 4 * c4) = ac; }
            __syncthreads();
            if (F.tid < 256) { const int which = F.tid >> 7, col = F.tid & 127; float s = F.ka->in[I_BMOD][l * NMOD + col0 + col];
#pragma unroll
                for (int w = 0; w < 8; ++w) s += red[(w * 2 + which) * 128 + col];
                ((float*)(F.ws + WS_MOD))[(size_t)(l * 2 + which) * NMOD + col0 + col] = s; }
            __syncthreads();
        }
    }
    {
        LAS float* scr = (LAS float*)(F.lds + F.wave * 16384);
        constexpr int I_IN = (DM / 64) * (INC / 32), I_BR = 4 * (BW / 64) * (DM / 32), I_OUT = (DM / 64) * (DM / 32), I_F1 = (DM / 64) * (F2 / 32), I_F2 = (FHID / 64) * (DM / 32);
        constexpr int PER_L = I_IN + I_BR + I_OUT + I_F1 + I_F2, I_GW = 64 * 8;
        constexpr int NITEMS = DEPTH * PER_L + I_GW;
        for (int it = gw; it < NITEMS; it += NGW) {
            if (it >= DEPTH * PER_L) {
                const int r = it - DEPTH * PER_L, mi = r >> 3, sub = r & 7, kb = sub >> 2, nb = sub & 3;
                const int blk = mi & 3, map = (mi >> 2) & 1, ld = mi >> 3;
                const float* W = (map ? F.ka->in[I_CWX] : F.ka->in[I_CWA]) + (size_t)(ld * 4 + blk) * 16384;
                bf16* dst = (bf16*)(F.ws + WS_GW) + (size_t)mi * 16384 + (size_t)(32 * nb) * 128 + 64 * kb;
                transpose_item(W, 128, 64 * kb, 32 * nb, dst, 128, scr, F.lane);
                continue;
            }
            const int l = it / PER_L; int r = it % PER_L;
            unsigned char* wl = F.ws + WS_W + (size_t)l * WL_STRIDE;
            if (r < I_IN) { const int nblk = INC / 32, kb = r / nblk, nb = r % nblk;
                transpose_item(F.ka->in[I_WIN] + (size_t)l * DM * INC, INC, 64 * kb, 32 * nb, (bf16*)(wl + WL_IN) + (size_t)(32 * nb) * DM + 64 * kb, DM, scr, F.lane); continue; }
            r -= I_IN;
            if (r < I_BR) { const int per = (BW / 64) * (DM / 32), k = r / per, rr = r % per, nblk = DM / 32, kb = rr / nblk, nb = rr % nblk;
                transpose_item(F.ka->in[I_WBR] + (size_t)(l * 4 + k) * BW * DM, DM, 64 * kb, 32 * nb, (bf16*)(wl + WL_BR) + (size_t)(32 * nb) * DM + k * BW + 64 * kb, DM, scr, F.lane); continue; }
            r -= I_BR;
            if (r < I_OUT) { const int nblk = DM / 32, kb = r / nblk, nb = r % nblk;
                transpose_item(F.ka->in[I_WOUT] + (size_t)l * DM * DM, DM, 64 * kb, 32 * nb, (bf16*)(wl + WL_OUT) + (size_t)(32 * nb) * DM + 64 * kb, DM, scr, F.lane); continue; }
            r -= I_OUT;
            if (r < I_F1) { const int nblk = F2 / 32, kb = r / nblk, nb = r % nblk; const int n0 = 32 * nb;
                const int j = n0 < FHID ? n0 : n0 - FHID; const int drow = (j >> 7) * 256 + (n0 < FHID ? 0 : 128) + (j & 127);
                transpose_item(F.ka->in[I_WF1] + (size_t)l * DM * F2, F2, 64 * kb, n0, (bf16*)(wl + WL_F1) + (size_t)drow * DM + 64 * kb, DM, scr, F.lane); continue; }
            r -= I_F1;
            { const int nblk = DM / 32, kb = r / nblk, nb = r % nblk;
                transpose_item(F.ka->in[I_WF2] + (size_t)l * FHID * DM, DM, 64 * kb, 32 * nb, (bf16*)(wl + WL_F2) + (size_t)(32 * nb) * FHID + 64 * kb, FHID, scr, F.lane); }
        }
    }
}

__device__ __forceinline__ void norm_phase(Frame& F, int l, int which, int nrows) {
    const int gw = blockIdx.x * NWAVES + F.wave, NGW = F.G * NWAVES;
    const float* gain = (which ? F.ka->in[I_NORM2] : F.ka->in[I_NORM1]) + l * DM;
    bf16* H = (bf16*)(F.ws + WS_H);
    for (int m = gw; m < nrows; m += NGW) {
        const bool lat = m < SEQ;
        const float* xrow = lat ? F.out + (size_t)m * DM : (const float*)(F.ws + WS_XC) + (size_t)(m - SEQ) * DM;
        const float* mod = (const float*)(F.ws + WS_MOD) + (size_t)(l * 2 + (lat ? 0 : 1)) * NMOD + (which ? 3 * DM : 0);
        f32x4 v[8]; float ss = 0.f;
#pragma unroll
        for (int j = 0; j < 8; ++j) { v[j] = *(const f32x4*)(xrow + 4 * F.lane + 256 * j); ss += (v[j][0] * v[j][0] + v[j][1] * v[j][1]) + (v[j][2] * v[j][2] + v[j][3] * v[j][3]); }
        const float rstd = 1.0f / sqrtf(wave_sum(ss) * (1.0f / DM) + EPS);
#pragma unroll
        for (int j = 0; j < 8; ++j) { const int c = 4 * F.lane + 256 * j;
            const f32x4 g = *(const f32x4*)(gain + c), sh = *(const f32x4*)(mod + c), scl = *(const f32x4*)(mod + DM + c);
            const f32x4 o = (v[j] * rstd * g) * (1.0f + scl) + sh;
            v2u w; w.x = pk2(o[0], o[1]); w.y = pk2(o[2], o[3]);
            *(v2u*)(H + (size_t)m * DM + c) = w; }
    }
}
__device__ __forceinline__ void final_norm_phase(Frame& F) {
    const int gw = blockIdx.x * NWAVES + F.wave, NGW = F.G * NWAVES;
    const float* gain = F.ka->in[I_FNORM];
    for (int m = gw; m < SEQ; m += NGW) {
        float* xrow = F.out + (size_t)m * DM;
        f32x4 v[8]; float ss = 0.f;
#pragma unroll
        for (int j = 0; j < 8; ++j) { v[j] = *(const f32x4*)(xrow + 4 * F.lane + 256 * j); ss += (v[j][0] * v[j][0] + v[j][1] * v[j][1]) + (v[j][2] * v[j][2] + v[j][3] * v[j][3]); }
        const float rstd = 1.0f / sqrtf(wave_sum(ss) * (1.0f / DM) + EPS);
#pragma unroll
        for (int j = 0; j < 8; ++j) { const int c = 4 * F.lane + 256 * j; const f32x4 g = *(const f32x4*)(gain + c); *(f32x4*)(xrow + c) = (v[j] * rstd) * g; }
    }
}

#define MFMA32(a, b, c) __builtin_amdgcn_mfma_f32_32x32x16_bf16((a), (b), (c), 0, 0, 0)
__device__ __forceinline__ int crow(int reg, int h) { return (reg & 3) + 8 * (reg >> 2) + 4 * h; }
typedef short v4i16_t __attribute__((ext_vector_type(4)));
__device__ __forceinline__ s16x4 tr_read(LAS unsigned char* p) { return __builtin_bit_cast(s16x4, __builtin_amdgcn_ds_read_tr16_b64_v4i16((LAS v4i16_t*)p)); }
__device__ __forceinline__ unsigned cvtpk(float lo, float hi) { return pg8::cvt_pk_bf16(lo, hi); }

constexpr int VPITCH = 144;
constexpr int ATT_WAVE_LDS = 32 * VPITCH + 1920;
constexpr float ATT_SCALE = 0.125f;
constexpr float NEG_BIG = -1.0e30f;

struct AttnState { f32x16 o0, o1; float m, l; };
template <class ScoreFn>
__device__ __forceinline__ void attn_keytile(AttnState& st, const bf16x8 (&qf)[4], const bf16* Kp, const bf16* Vp, LAS unsigned char* vlds, int lane, const ScoreFn& sf) {
    const int r = lane & 31, h = lane >> 5;
    bf16x8 kf[4];
#pragma unroll
    for (int ds = 0; ds < 4; ++ds) kf[ds] = *(const bf16x8*)(Kp + (size_t)r * ZC + 16 * ds + 8 * h);
    {
        const bf16* vsrc = Vp + (size_t)(lane >> 1) * ZC + (lane & 1) * 32;
        const v4u a0 = *(const v4u*)(vsrc), a1 = *(const v4u*)(vsrc + 8), a2 = *(const v4u*)(vsrc + 16), a3 = *(const v4u*)(vsrc + 24);
        LAS v4u* dst = (LAS v4u*)(vlds + (lane >> 1) * VPITCH + (lane & 1) * 64);
        dst[0] = a0; dst[1] = a1; dst[2] = a2; dst[3] = a3;
    }
    f32x16 s;
#pragma unroll
    for (int i = 0; i < 16; ++i) s[i] = 0.f;
#pragma unroll
    for (int ds = 0; ds < 4; ++ds) s = MFMA32(kf[ds], qf[ds], s);
    float mt = NEG_BIG;
#pragma unroll
    for (int i = 0; i < 16; ++i) { s[i] = sf(s[i], crow(i, h), r); mt = fmaxf(mt, s[i]); }
    mt = fmaxf(mt, __shfl_xor(mt, 32));
    const float mn = fmaxf(st.m, mt), alpha = __builtin_amdgcn_exp2f(st.m - mn);
    float ps = 0.f;
#pragma unroll
    for (int i = 0; i < 16; ++i) { s[i] = __builtin_amdgcn_exp2f(s[i] - mn); ps += s[i]; }
    st.l = st.l * alpha + ps; st.m = mn;
#pragma unroll
    for (int i = 0; i < 16; ++i) { st.o0[i] *= alpha; st.o1[i] *= alpha; }
    v4u p0, p1;
    p0.x = cvtpk(s[0], s[1]); p0.y = cvtpk(s[2], s[3]); p0.z = cvtpk(s[4], s[5]); p0.w = cvtpk(s[6], s[7]);
    p1.x = cvtpk(s[8], s[9]); p1.y = cvtpk(s[10], s[11]); p1.z = cvtpk(s[12], s[13]); p1.w = cvtpk(s[14], s[15]);
    const bf16x8 pf0 = __builtin_bit_cast(bf16x8, p0), pf1 = __builtin_bit_cast(bf16x8, p1);
    asm volatile("" ::: "memory");
    const int i16 = lane & 15, q = i16 >> 2, p = i16 & 3, dhalf = (lane >> 4) & 1;
    LAS unsigned char* vb = vlds + (4 * h + q) * VPITCH + (16 * dhalf + 4 * p) * 2;
#pragma unroll
    for (int dt = 0; dt < 2; ++dt) {
        const s16x4 lo0 = tr_read(vb + dt * 64), hi0 = tr_read(vb + 8 * VPITCH + dt * 64);
        const s16x4 lo1 = tr_read(vb + 16 * VPITCH + dt * 64), hi1 = tr_read(vb + 24 * VPITCH + dt * 64);
        const bf16x8 v0 = (bf16x8){lo0[0], lo0[1], lo0[2], lo0[3], hi0[0], hi0[1], hi0[2], hi0[3]};
        const bf16x8 v1 = (bf16x8){lo1[0], lo1[1], lo1[2], lo1[3], hi1[0], hi1[1], hi1[2], hi1[3]};
        if (dt == 0) { st.o0 = MFMA32(v0, pf0, st.o0); st.o0 = MFMA32(v1, pf1, st.o0); }
        else         { st.o1 = MFMA32(v0, pf0, st.o1); st.o1 = MFMA32(v1, pf1, st.o1); }
    }
    asm volatile("" ::: "memory");
}
__device__ __forceinline__ void attn_store(const AttnState& st, float linv, bf16* Op  , int lane) {
    const int r = lane & 31, h = lane >> 5;
    bf16* rowp = Op + (size_t)r * DM + 4 * h;
#pragma unroll
    for (int g = 0; g < 4; ++g) {
        v2u w0, w1;
        w0.x = cvtpk(st.o0[4 * g] * linv, st.o0[4 * g + 1] * linv); w0.y = cvtpk(st.o0[4 * g + 2] * linv, st.o0[4 * g + 3] * linv);
        w1.x = cvtpk(st.o1[4 * g] * linv, st.o1[4 * g + 1] * linv); w1.y = cvtpk(st.o1[4 * g + 2] * linv, st.o1[4 * g + 3] * linv);
        *(v2u*)(rowp + 8 * g) = w0; *(v2u*)(rowp + 32 + 8 * g) = w1;
    }
}
__device__ __forceinline__ void attn_init(AttnState& st) {
#pragma unroll
    for (int i = 0; i < 16; ++i) { st.o0[i] = 0.f; st.o1[i] = 0.f; }
    st.m = NEG_BIG; st.l = 0.f;
}
__device__ __forceinline__ void load_q(bf16x8 (&qf)[4], const bf16* Qp, int lane) {
    const int r = lane & 31, h = lane >> 5;
#pragma unroll
    for (int ds = 0; ds < 4; ++ds) qf[ds] = *(const bf16x8*)(Qp + (size_t)r * ZC + 16 * ds + 8 * h);
}

struct ScorePlain { __device__ __forceinline__ float operator()(float s, int, int) const { return s * (ATT_SCALE * LOG2E); } };
struct ScoreWin {
    int dk;
    __device__ __forceinline__ float operator()(float s, int krow, int qr) const { const int d = dk + krow - qr; return (d >= -128 && d <= 128) ? s * (ATT_SCALE * LOG2E) : NEG_BIG; }
};
struct ScoreNb {
    const LAS float* tab;
    int kc0, cq0, dr;
    __device__ __forceinline__ float operator()(float s, int krow, int qr) const {
        const int ck = kc0 + krow, cq = cq0 + qr; int cs = cq - 8; cs = cs < 0 ? 0 : (cs > 48 ? 48 : cs);
        int dc = ck - cq + 15; dc = dc < 0 ? 0 : (dc > 30 ? 30 : dc);
        const float b = tab[dr * 31 + dc];
        return (ck >= cs && ck < cs + 16) ? (s * ATT_SCALE + b) * LOG2E : NEG_BIG;
    }
};

__device__ __forceinline__ void attn_item(Frame& F, int l, int idx, int nqt, LAS unsigned char* wlds) {
    const int lane = F.lane;
    const bf16* Z = (const bf16*)(F.ws + WS_Z); bf16* BR = (bf16*)(F.ws + WS_BR);
    const bool isB = idx >= nqt * 8; if (isB) idx -= nqt * 8;
    const int qt = idx >> 3, hq = idx & 7;
    const bool lat = qt < 256; const int qrow0 = lat ? 32 * qt : SEQ + 32 * (qt - 256);
    AttnState st; attn_init(st); bf16x8 qf[4];
    if (!isB) {
        const int hk = hq >> 2;
        load_q(qf, Z + (size_t)qrow0 * ZC + ZC_QA + hq * 64, lane);
        const bf16* Kc = Z + ZC_KA + hk * 64; const bf16* Vc = Z + ZC_VA + hk * 64;
        if (lat) {
            const int p0 = qrow0; int klo = p0 - 128; if (klo < 0) klo = 0; int khi = p0 + 160; if (khi > SEQ) khi = SEQ;
            for (int k0 = klo; k0 < khi; k0 += 32) { ScoreWin sf{k0 - p0}; attn_keytile(st, qf, Kc + (size_t)k0 * ZC, Vc + (size_t)k0 * ZC, wlds, lane, sf); }
        }
        for (int j = 0; j < 8; ++j) { ScorePlain sf; const size_t kr = (size_t)(SEQ + 32 * j) * ZC; attn_keytile(st, qf, Kc + kr, Vc + kr, wlds, lane, sf); }
        float lsum = st.l + __shfl_xor(st.l, 32);
        lsum += __builtin_amdgcn_exp2f(F.ka->in[I_ASINK][l * 8 + hq] * LOG2E - st.m);
        attn_store(st, 1.0f / lsum, BR + (size_t)qrow0 * DM + hq * 64, lane);
    } else {
        load_q(qf, Z + (size_t)qrow0 * ZC + ZC_QB + hq * 64, lane);
        const bf16* Kc = Z + ZC_KB + hq * 64; const bf16* Vc = Z + ZC_VB + hq * 64;
        if (lat) {
            LAS float* tab = (LAS float*)(wlds + 32 * VPITCH);
            const float* bsrc = F.ka->in[I_NBBIAS] + (size_t)(l * 8 + hq) * 465;
            for (int i = lane; i < 465; i += 64) tab[i] = bsrc[i];
            asm volatile("s_waitcnt lgkmcnt(0)" ::: "memory");
            const int gr = qt >> 1, cq0 = (qt & 1) * 32; int kr0 = gr - 4; kr0 = kr0 < 0 ? 0 : (kr0 > 120 ? 120 : kr0);
            for (int i = 0; i < 8; ++i) { const int kr = kr0 + i;
#pragma unroll 1
                for (int c = 0; c < 2; ++c) { const int kc0 = c ? (cq0 ^ 32) : cq0; ScoreNb sf{tab, kc0, cq0, kr - gr + 7};
                    const size_t ko = (size_t)(kr * GRIDW + kc0) * ZC; attn_keytile(st, qf, Kc + ko, Vc + ko, wlds, lane, sf); } }
        }
        for (int j = 0; j < 8; ++j) { ScorePlain sf; const size_t kr = (size_t)(SEQ + 32 * j) * ZC; attn_keytile(st, qf, Kc + kr, Vc + kr, wlds, lane, sf); }
        const float lsum = st.l + __shfl_xor(st.l, 32);
        attn_store(st, 1.0f / lsum, BR + (size_t)qrow0 * DM + 512 + hq * 64, lane);
    }
}

__device__ __forceinline__ void dconv_phase(Frame& F, int l, int nrows) {
    const int gt = blockIdx.x * (NWAVES * 64) + F.tid, NGT = F.G * NWAVES * 64;
    const bf16* Z = (const bf16*)(F.ws + WS_Z); bf16* BR = (bf16*)(F.ws + WS_BR);
    const float* w = F.ka->in[I_DCONVW] + (size_t)l * 3 * 512;
    for (int it = gt; it < nrows * 64; it += NGT) {
        const int row = it >> 6, c0 = (it & 63) * 8;
        const int lo = row < SEQ ? 0 : SEQ, hi = row < SEQ ? SEQ : MT;
        float acc[8];
#pragma unroll
        for (int e = 0; e < 8; ++e) acc[e] = 0.f;
#pragma unroll
        for (int j = 0; j < 3; ++j) { const int rr = row + j - 1;
            if (rr >= lo && rr < hi) { const v4u cd = *(const v4u*)(Z + (size_t)rr * ZC + ZC_CD + c0), xd = *(const v4u*)(Z + (size_t)rr * ZC + ZC_XD + c0);
                const f32x4 w0 = *(const f32x4*)(w + j * 512 + c0), w1 = *(const f32x4*)(w + j * 512 + c0 + 4);
#pragma unroll
                for (int e = 0; e < 4; ++e) { acc[2 * e] += (e < 2 ? w0[2 * e] : w1[2 * e - 4]) * (bflo(cd[e]) * bflo(xd[e])); acc[2 * e + 1] += (e < 2 ? w0[2 * e + 1] : w1[2 * e - 3]) * (bfhi(cd[e]) * bfhi(xd[e])); } } }
        const v4u bd = *(const v4u*)(Z + (size_t)row * ZC + ZC_BD + c0);
        v4u o;
#pragma unroll
        for (int e = 0; e < 4; ++e) o[e] = pk2(acc[2 * e] * bflo(bd[e]), acc[2 * e + 1] * bfhi(bd[e]));
        *(v4u*)(BR + (size_t)row * DM + 1536 + c0) = o;
    }
}

__device__ __forceinline__ float gelu_tanh(float x) { const float z = 0.7978845608028654f * (x + 0.044715f * x * x * x); const float e = __expf(2.0f * z); return 0.5f * x * (1.0f + (1.0f - 2.0f * __builtin_amdgcn_rcpf(e + 1.0f))); }
constexpr int UB_PITCH = 1040;
__device__ __forceinline__ void scan_gate_item(Frame& F, int l, int c) {
    const bf16* Z = (const bf16*)(F.ws + WS_Z);
    float* AB = (float*)(F.ws + WS_AB);
    float* PS = (float*)(F.ws + WS_PS);
    LAS float* U32 = (LAS float*)F.lds;
    LAS unsigned char* Ub = F.lds + 65536;
    const int row_c = 64 * c;
    const int lo = row_c < SEQ ? 0 : SEQ, hi = row_c < SEQ ? SEQ : MT;
    const int lane = F.lane, r = lane & 31, h = lane >> 5;
    for (int sub = 0; sub < 2; ++sub) {
        const int row0 = row_c + 32 * sub;
        {
            const int ch = F.tid;
            const float* cw = F.ka->in[I_CCONVW] + (size_t)l * 4 * 512; const float w0 = cw[ch], w1 = cw[512 + ch], w2 = cw[1024 + ch], w3 = cw[1536 + ch], cb = F.ka->in[I_CCONVB][l * 512 + ch];
            const bf16* xp = Z + ZC_XR + ch;
            float xm2 = (row0 - 2 >= lo) ? bf1(xp[(size_t)(row0 - 2) * ZC]) : 0.f, xm1 = (row0 - 1 >= lo) ? bf1(xp[(size_t)(row0 - 1) * ZC]) : 0.f, x0 = bf1(xp[(size_t)row0 * ZC]);
#pragma unroll 4
            for (int tt = 0; tt < 32; ++tt) { const int rp = row0 + tt + 1; const float xp1 = (rp < hi) ? bf1(xp[(size_t)rp * ZC]) : 0.f;
                const float u = cb + w0 * xm2 + w1 * xm1 + w2 * x0 + w3 * xp1;
                U32[tt * 512 + ch] = u; *(LAS bf16*)(Ub + tt * UB_PITCH + ch * 2) = (bf16)f2bf(u);
                xm2 = xm1; xm1 = x0; x0 = xp1; }
        }
        __syncthreads();
        {
            const int dir = F.wave >> 2, n = F.wave & 3;
            bf16x8 af[8];
#pragma unroll
            for (int kk = 0; kk < 8; ++kk) af[kk] = *(const LAS bf16x8*)(Ub + r * UB_PITCH + (n * 128 + 16 * kk + 8 * h) * 2);
            const bf16* GWa = (const bf16*)(F.ws + WS_GW) + (size_t)((((l * 2 + dir) * 2 + 0) * 4 + n)) * 16384;
            const bf16* GWx = GWa + (size_t)4 * 16384;
            float* Ao = AB + ((size_t)(dir * 2 + 0) * MT + row0) * 512; float* Bo = AB + ((size_t)(dir * 2 + 1) * MT + row0) * 512;
#pragma unroll 1
            for (int g = 0; g < 4; ++g) {
                f32x16 pa, px;
#pragma unroll
                for (int i = 0; i < 16; ++i) { pa[i] = 0.f; px[i] = 0.f; }
                const bf16* wa = GWa + (size_t)(32 * g + r) * 128 + 8 * h; const bf16* wx = GWx + (size_t)(32 * g + r) * 128 + 8 * h;
#pragma unroll
                for (int kk = 0; kk < 8; ++kk) { pa = MFMA32(af[kk], *(const bf16x8*)(wa + 16 * kk), pa); px = MFMA32(af[kk], *(const bf16x8*)(wx + 16 * kk), px); }
                const int ch = n * 128 + 32 * g + r, pidx = (l * 2 + dir) * 512 + ch;
                const float ba = F.ka->in[I_CBA][pidx], bx = F.ka->in[I_CBX][pidx], lam = F.ka->in[I_CLAM][pidx];
                const float sp = log1pf(__expf(-lam));
#pragma unroll
                for (int i = 0; i < 16; ++i) { const int tt = crow(i, h);
                    const float rr = sigm(pa[i] + ba), ii = sigm(px[i] + bx), la = -8.0f * rr * sp;
                    const float a = __expf(la), b = sqrtf(-expm1f(2.0f * la)) * (ii * U32[tt * 512 + ch]);
                    Ao[(size_t)tt * 512 + ch] = a; Bo[(size_t)tt * 512 + ch] = b; }
            }
        }
        asm volatile("s_waitcnt vmcnt(0)" ::: "memory");
        __syncthreads();
    }
    {
        const int ch = F.tid;
        const float* Af = AB + ((size_t)0 * MT + row_c) * 512 + ch; const float* Bf = AB + ((size_t)1 * MT + row_c) * 512 + ch;
        const float* Abk = AB + ((size_t)2 * MT + row_c) * 512 + ch; const float* Bbk = AB + ((size_t)3 * MT + row_c) * 512 + ch;
        float P = 1.f, S = 0.f;
#pragma unroll 8
        for (int t = 0; t < 64; ++t) { const float a = Af[(size_t)t * 512], b = Bf[(size_t)t * 512]; S = a * S + b; P *= a; }
        PS[((size_t)(0 * 132 + c) * 512 + ch) * 2] = P; PS[((size_t)(0 * 132 + c) * 512 + ch) * 2 + 1] = S;
        P = 1.f; S = 0.f;
#pragma unroll 8
        for (int t = 63; t >= 0; --t) { const float a = Abk[(size_t)t * 512], b = Bbk[(size_t)t * 512]; S = a * S + b; P *= a; }
        PS[((size_t)(1 * 132 + c) * 512 + ch) * 2] = P; PS[((size_t)(1 * 132 + c) * 512 + ch) * 2 + 1] = S;
    }
    __syncthreads();
}
__device__ __forceinline__ void scan_final_item(Frame& F, int c) {
    const bf16* Z = (const bf16*)(F.ws + WS_Z); bf16* BR = (bf16*)(F.ws + WS_BR);
    const float* AB = (const float*)(F.ws + WS_AB); const float* PS = (const float*)(F.ws + WS_PS);
    LAS float* HF = (LAS float*)F.lds;
    const int ch = F.tid, row_c = 64 * c;
    float hf = 0.f, hb = 0.f;
    { const int nbefore = c >= 128 ? c - 128 : c + 4;
      for (int k = 0; k < nbefore; ++k) { const int cc = k < 4 ? 128 + k : k - 4; const float2 ps = *(const float2*)(PS + ((size_t)(0 * 132 + cc) * 512 + ch) * 2); hf = ps.x * hf + ps.y; } }
    { const int nbefore = c >= 128 ? 131 - c : 4 + (127 - c);
      for (int k = 0; k < nbefore; ++k) { const int cc = k < 4 ? 131 - k : 127 - (k - 4); const float2 ps = *(const float2*)(PS + ((size_t)(1 * 132 + cc) * 512 + ch) * 2); hb = ps.x * hb + ps.y; } }
    const float* Af = AB + ((size_t)0 * MT + row_c) * 512 + ch; const float* Bf = AB + ((size_t)1 * MT + row_c) * 512 + ch;
    const float* Abk = AB + ((size_t)2 * MT + row_c) * 512 + ch; const float* Bbk = AB + ((size_t)3 * MT + row_c) * 512 + ch;
#pragma unroll 8
    for (int t = 0; t < 64; ++t) { hf = Af[(size_t)t * 512] * hf + Bf[(size_t)t * 512]; HF[t * 512 + ch] = hf; }
#pragma unroll 8
    for (int t = 63; t >= 0; --t) { hb = Abk[(size_t)t * 512] * hb + Bbk[(size_t)t * 512];
        const float gr = bf1(Z[(size_t)(row_c + t) * ZC + ZC_GR + ch]);
        BR[(size_t)(row_c + t) * DM + 1024 + ch] = (bf16)f2bf((HF[t * 512 + ch] + hb) * gelu_tanh(gr)); }
}

__global__ void __launch_bounds__(NWAVES * 64, 2) mk_fwd(Args args) {
    extern __shared__ __attribute__((aligned(16))) unsigned char lds[];
    Frame F;
    F.lds = (LAS unsigned char*)lds;
    F.MISC = (volatile LAS unsigned*)(F.lds + MISC_OFF);
    F.tid = threadIdx.x; F.lane = F.tid & 63; F.wave = __builtin_amdgcn_readfirstlane(F.tid >> 6);
    F.G = gridDim.x;
    F.ka = (const KAS Args*)__builtin_amdgcn_kernarg_segment_ptr();
    F.out = args.out; F.ws = args.ws;
    F.ctl = (gu32*)(F.ws + WS_CTL);
    for (int u = F.tid; u < (LDS_BYTES - LDSCTL_OFF) / 4; u += NWAVES * 64) ((LAS unsigned*)(F.lds + LDSCTL_OFF))[u] = 0u;
    __syncthreads();
#if MK_ONE_LAUNCH
    XcdBarrier bar = xcd_barrier_post((unsigned*)(F.ctl + CW_BAR), F.MISC + 8);
#define GRID_BAR() xcd_barrier(bar)
#else
#define GRID_BAR() do { } while (0)
#endif
    const int lo = args.ph_lo, hi = args.ph_hi;
#define IN(k) (lo <= (k) && (k) < hi)
#ifndef PHMASK
#define PHMASK 0x7ff
#endif
#define PHON(b) (((PHMASK) >> (b)) & 1)
#define FRESH() do { int t_ = threadIdx.x; asm volatile("" : "+v"(t_)); F.tid = t_; F.lane = t_ & 63; } while (0)
#define SEAM(k) do { if (IN(k) && IN((k) + 1)) GRID_BAR(); } while (0)

    if (PHON(0) && IN(0)) { FRESH(); p0_prologue(F); }
    SEAM(0);

    for (int l = 0; l < DEPTH; ++l) {
        const int pb = 1 + l * NPL;
        const bool last = (l == DEPTH - 1);
        const int Mg = last ? SEQ : MT;
        unsigned char* wl = F.ws + WS_W + (size_t)l * WL_STRIDE;
        const float* modl = (const float*)(F.ws + WS_MOD) + (size_t)(l * 2) * NMOD; const float* modc = modl + NMOD;

        if (PHON(1) && IN(pb + 0)) { FRESH(); norm_phase(F, l, 0, MT); }
        SEAM(pb + 0);

        if (PHON(2) && IN(pb + 1)) {
            pg8::Gemm g{(const pg8::bf16_t*)(F.ws + WS_H), (const pg8::bf16_t*)(wl + WL_IN), MT, INC, DM}; pg8::StaticOrder S; S.init(MT, INC, F.G, (int)blockIdx.x);
            pg8::EpiIn E{(pg8::bf16_t*)(F.ws + WS_Z), (pg8::bf16_t*)(F.ws + WS_G), F.ka->in[I_BGATE] + (size_t)l * GC, (const float*)(F.ws + WS_ROPE), (const float*)(F.ws + WS_ROPE) + 2048};
            pg8::gemm_phase<pg8::EpiIn, pg8::StaticOrder, true, true>(F.lds, g, S, E);
        }
        SEAM(pb + 1);

        if (PHON(3) && IN(pb + 2)) {
            FRESH(); __syncthreads();
#ifndef MIXMASK
#define MIXMASK 15
#endif
            if (MIXMASK & 1) for (int c = blockIdx.x; c < 132; c += F.G) scan_gate_item(F, l, c);
            FRESH();
            __syncthreads();
            const int nqt = last ? 256 : 264, nitems = 2 * nqt * 8;
            const int gw = blockIdx.x * NWAVES + F.wave, NGW = F.G * NWAVES;
            LAS unsigned char* wlds = F.lds + F.wave * ATT_WAVE_LDS;
            for (int it = gw; it < nitems; it += NGW) { const bool isb = it >= nqt * 8; if ((MIXMASK & 2) && !isb) attn_item(F, l, it, nqt, wlds); if ((MIXMASK & 4) && isb) attn_item(F, l, it, nqt, wlds); }
            FRESH(); if (MIXMASK & 8) dconv_phase(F, l, last ? SEQ : MT);
        }
        SEAM(pb + 2);

        if (PHON(4) && IN(pb + 3)) {
            FRESH(); __syncthreads();
            const int nch = last ? 128 : 132;
            for (int c = blockIdx.x; c < nch; c += F.G) { scan_final_item(F, c); __syncthreads(); }
        }
        SEAM(pb + 3);

        if (PHON(5) && IN(pb + 4)) {
            __syncthreads();
            pg8::Gemm g{(const pg8::bf16_t*)(F.ws + WS_BR), (const pg8::bf16_t*)(wl + WL_BR), Mg, DM, DM}; pg8::StaticOrder S; S.init(Mg, DM, F.G, (int)blockIdx.x);
            pg8::EpiMerge E{(const pg8::bf16_t*)(F.ws + WS_G), (pg8::bf16_t*)(F.ws + WS_MG)};
            pg8::gemm_phase<pg8::EpiMerge, pg8::StaticOrder, true, true>(F.lds, g, S, E);
        }
        SEAM(pb + 4);

        if (PHON(6) && IN(pb + 5)) {
            pg8::Gemm g{(const pg8::bf16_t*)(F.ws + WS_MG), (const pg8::bf16_t*)(wl + WL_OUT), Mg, DM, DM}; pg8::StaticOrder S; S.init(Mg, DM, F.G, (int)blockIdx.x);
            pg8::EpiResid E{F.out, (float*)(F.ws + WS_XC), modl + 2 * DM, modc + 2 * DM};
            pg8::gemm_phase<pg8::EpiResid, pg8::StaticOrder, true, true>(F.lds, g, S, E);
        }
        SEAM(pb + 5);

        if (PHON(7) && IN(pb + 6)) { FRESH(); norm_phase(F, l, 1, Mg); }
        SEAM(pb + 6);

        if (PHON(8) && IN(pb + 7)) {
            pg8::Gemm g{(const pg8::bf16_t*)(F.ws + WS_H), (const pg8::bf16_t*)(wl + WL_F1), Mg, F2, DM}; pg8::StaticOrder S; S.init(Mg, F2, F.G, (int)blockIdx.x);
            pg8::EpiSwiglu E{(pg8::bf16_t*)(F.ws + WS_FH)};
            pg8::gemm_phase<pg8::EpiSwiglu, pg8::StaticOrder, true, true>(F.lds, g, S, E);
        }
        SEAM(pb + 7);

        if (PHON(9) && IN(pb + 8)) {
            pg8::Gemm g{(const pg8::bf16_t*)(F.ws + WS_FH), (const pg8::bf16_t*)(wl + WL_F2), Mg, DM, FHID}; pg8::StaticOrder S; S.init(Mg, DM, F.G, (int)blockIdx.x);
            pg8::EpiResid E{F.out, (float*)(F.ws + WS_XC), modl + 5 * DM, modc + 5 * DM};
            pg8::gemm_phase<pg8::EpiResid, pg8::StaticOrder, true, true>(F.lds, g, S, E);
        }
        SEAM(pb + 8);
    }

    if (PHON(10) && IN(N_PHASES - 1)) { FRESH(); final_norm_phase(F); }
#undef IN
#undef SEAM
}

extern "C" void kernel_launch(void* const* d_in, const int* in_sizes, int n_in, void* d_out, int out_size, void* d_ws, size_t ws_size, hipStream_t stream) {
    static int grid = 0;
    if (grid == 0) {
        if (n_in != 25 || out_size != SEQ * DM || ws_size < WS_END) { fprintf(stderr, "kernel_launch: unexpected problem (n_in %d, out %d, ws %zu, need %zu)\n", n_in, out_size, ws_size, (size_t)WS_END); grid = -1; return; }
        int dev = 0, cus = 0, per_cu = 0;
        if (hipGetDevice(&dev) != hipSuccess || hipDeviceGetAttribute(&cus, hipDeviceAttributeMultiprocessorCount, dev) != hipSuccess) { grid = -1; return; }
        if (hipFuncSetAttribute((const void*)mk_fwd, hipFuncAttributeMaxDynamicSharedMemorySize, LDS_BYTES) != hipSuccess) { fprintf(stderr, "kernel_launch: hipFuncSetAttribute failed\n"); grid = -1; return; }
        if (hipOccupancyMaxActiveBlocksPerMultiprocessor(&per_cu, (const void*)mk_fwd, NWAVES * 64, LDS_BYTES) != hipSuccess || per_cu < 1) fprintf(stderr, "kernel_launch: occupancy query reports %d\n", per_cu);
        (void)hipGetLastError();
        grid = cus;
    }
    if (grid < 0) return;
    (void)hipMemsetAsync((char*)d_ws + WS_CTL, 0, CTL_ZERO_BYTES, stream);
    Args a{};
    for (int i = 0; i < 25; ++i) a.in[i] = (const float*)d_in[i];
    a.out = (float*)d_out; a.ws = (unsigned char*)d_ws;
#if MK_ONE_LAUNCH
    a.ph_lo = 0; a.ph_hi = N_PHASES;
    hipLaunchKernelGGL(mk_fwd, dim3(grid), dim3(NWAVES * 64), LDS_BYTES, stream, a);
#else
    for (int p = 0; p < N_PHASES; ++p) { a.ph_lo = p; a.ph_hi = p + 1; hipLaunchKernelGGL(mk_fwd, dim3(grid), dim3(NWAVES * 64), LDS_BYTES, stream, a); }
#endif
}
```

```cpp
#include <hip/hip_runtime.h>
#include <cstdio>
#include <cstdint>
namespace pg8 {
#define PG8_LAS __attribute__((address_space(3)))
typedef unsigned short bf16_t;
typedef short bf16x8 __attribute__((ext_vector_type(8)));
typedef float f32x4 __attribute__((ext_vector_type(4)));
typedef unsigned u32x4 __attribute__((ext_vector_type(4)));
constexpr int BM = 256, BK = 64, HALF = 128, HTB = HALF * BK * 2  , STAGE_BYTES = 8 * HTB, NXCD = 8, WGM = 8;

__host__ __device__ __forceinline__ int lds_byte(int r, int c) { const int st = (r >> 4) * 2 + (c >> 5), rr = r & 15, cc = c & 31, ob = rr * 64 + cc * 2; return st * 1024 + (ob ^ (((ob >> 9) & 1) << 5)); }
__host__ __device__ __forceinline__ void stage_rc(int b, int& R, int& C) { const int st = b / 1024, sb = b % 1024, swz = sb ^ (((sb >> 9) & 1) << 5); R = (st >> 1) * 16 + swz / 64; C = (st & 1) * 32 + (swz % 64) / 2; }
__host__ __device__ __forceinline__ int perm32(int rho) { const int n = rho >> 4, i = rho & 15; return 8 * (i >> 2) + 4 * n + (i & 3); }

struct Unit { int pm, pn; };
struct Gemm { const bf16_t* A; const bf16_t* Bt; int M, N, K; };

struct StaticOrder {
    int nM, nN, nwg, G, c;
    __host__ __device__ void init(int M, int N, int G_, int c_) { nM = M / BM; nN = N / BM; nwg = nM * nN; G = G_; c = c_; }
    __host__ __device__ bool next(int i, Unit& u) const {
        const long L = (long)i * G + c; if (L >= nwg) return false;
        int wgid = (int)L; { const int q = nwg / NXCD, r = nwg % NXCD, xcd = wgid % NXCD, off = wgid / NXCD; wgid = (xcd < r ? xcd * (q + 1) : r * (q + 1) + (xcd - r) * q) + off; }
        const int nig = WGM * nN, gid = wgid / nig, fm = gid * WGM, gsz = (nM - fm) < WGM ? (nM - fm) : WGM;
        u.pm = fm + ((wgid % nig) % gsz); u.pn = (wgid % nig) / gsz; return true;
    }
    __device__ __forceinline__ void a_ready(const Unit&) const {}
    __device__ __forceinline__ void done(const Unit&) const {}
};
typedef float f32x2 __attribute__((ext_vector_type(2)));
typedef __bf16 bf16x2_t __attribute__((ext_vector_type(2)));
__device__ __forceinline__ unsigned cvt_pk_bf16(float lo, float hi) { f32x2 v = {lo, hi}; bf16x2_t b = __builtin_convertvector(v, bf16x2_t); return __builtin_bit_cast(unsigned, b); }
__device__ __forceinline__ float sigmoidf_fast(float x) { return __builtin_amdgcn_rcpf(1.0f + __expf(-x)); }
__device__ __forceinline__ float bf2f(unsigned short b) { return __uint_as_float(((unsigned)b) << 16); }

struct EpiIn {
    static constexpr bool PERM = true, AFTER_DRAIN = false, HAS_MID = false;
    bf16_t* Z; bf16_t* G; const float* bgate; const float* ropec; const float* ropes;
    __device__ __forceinline__ void operator()(const f32x4 (&acc)[2][2][4][2], const Unit& u, int wr, int wc, int fr, int fq) const {
        const int row0 = u.pm * BM + wr * 64 + fr;
        if (u.pn >= 19) {
            const int col0 = (u.pn - 19) * BM + wc * 32 + 8 * fq;
            f32x4 bv[2][2];
#pragma unroll
            for (int bj = 0; bj < 2; ++bj)
#pragma unroll
                for (int n = 0; n < 2; ++n) bv[bj][n] = *(const f32x4*)(bgate + col0 + bj * HALF + 4 * n);
#pragma unroll
            for (int ai = 0; ai < 2; ++ai)
#pragma unroll
                for (int m = 0; m < 4; ++m) { bf16_t* rowp = G + (size_t)(row0 + ai * HALF + m * 16) * 8192 + col0;
#pragma unroll
                    for (int bj = 0; bj < 2; ++bj) { const f32x4 v0 = acc[ai][bj][m][0] + bv[bj][0], v1 = acc[ai][bj][m][1] + bv[bj][1];
                        u32x4 w; w.x = cvt_pk_bf16(sigmoidf_fast(v0[0]), sigmoidf_fast(v0[1])); w.y = cvt_pk_bf16(sigmoidf_fast(v0[2]), sigmoidf_fast(v0[3]));
                        w.z = cvt_pk_bf16(sigmoidf_fast(v1[0]), sigmoidf_fast(v1[1])); w.w = cvt_pk_bf16(sigmoidf_fast(v1[2]), sigmoidf_fast(v1[3]));
                        *(u32x4*)(rowp + bj * HALF) = w; } }
        } else {
            const int colt = u.pn * BM, col0 = colt + wc * 32 + 8 * fq;
            const bool rope_tile = (u.pn <= 2) && (u.pm < 32);
#pragma unroll
            for (int ai = 0; ai < 2; ++ai)
#pragma unroll
                for (int m = 0; m < 4; ++m) { const int t = row0 + ai * HALF + m * 16; bf16_t* rowp = Z + (size_t)t * 4864 + col0;
#pragma unroll
                    for (int bj = 0; bj < 2; ++bj) { f32x4 v0 = acc[ai][bj][m][0], v1 = acc[ai][bj][m][1];
                        if (rope_tile && (colt + bj * HALF < 640)) {
                            const int pos = (wc & 1) ? (t & 63) : (t >> 6);
                            const float* cp = ropec + pos * 16 + 8 * (fq & 1); const float* sp = ropes + pos * 16 + 8 * (fq & 1);
                            const f32x4 c0 = *(const f32x4*)cp, c1 = *(const f32x4*)(cp + 4), s0 = *(const f32x4*)sp, s1 = *(const f32x4*)(sp + 4);
                            f32x4 p0, p1;
#pragma unroll
                            for (int e = 0; e < 4; ++e) { p0[e] = __shfl_xor(v0[e], 32); p1[e] = __shfl_xor(v1[e], 32); }
                            if (fq < 2) { v0 = v0 * c0 - p0 * s0; v1 = v1 * c1 - p1 * s1; }
                            else        { v0 = p0 * s0 + v0 * c0; v1 = p1 * s1 + v1 * c1; }
                        }
                        u32x4 w; w.x = cvt_pk_bf16(v0[0], v0[1]); w.y = cvt_pk_bf16(v0[2], v0[3]); w.z = cvt_pk_bf16(v1[0], v1[1]); w.w = cvt_pk_bf16(v1[2], v1[3]);
                        *(u32x4*)(rowp + bj * HALF) = w; } }
        }
    }
};

struct EpiMerge {
    static constexpr bool PERM = true, AFTER_DRAIN = false, HAS_MID = true;
    const bf16_t* G; bf16_t* O;
    __device__ __forceinline__ void mid(f32x4 (&acc)[2][2][4][2], const Unit& u, int seg, int wr, int wc, int fr, int fq) const {
        int row0 = u.pm * BM + wr * 64 + fr; asm volatile("" : "+v"(row0));
        const int col0 = u.pn * BM + wc * 32 + 8 * fq;
#pragma unroll
        for (int ai = 0; ai < 2; ++ai)
#pragma unroll
            for (int m = 0; m < 4; ++m) { const bf16_t* rowp = G + (size_t)(row0 + ai * HALF + m * 16) * 8192 + col0 + seg * 2048;
#pragma unroll
                for (int bj = 0; bj < 2; ++bj) { const u32x4 ga = *(const u32x4*)(rowp + bj * HALF), gb = *(const u32x4*)(rowp + 2048 + bj * HALF);
#pragma unroll
                    for (int e = 0; e < 4; ++e) { const unsigned a = ga[e], b = gb[e];
                        const float a0 = fmaxf(__uint_as_float(a << 16), 1e-30f), a1 = fmaxf(__uint_as_float(a & 0xffff0000u), 1e-30f);
                        const float b0 = fmaxf(__uint_as_float(b << 16), 1e-30f), b1 = fmaxf(__uint_as_float(b & 0xffff0000u), 1e-30f);
                        acc[ai][bj][m][e >> 1][(e & 1) * 2]     *= a0 * __builtin_amdgcn_rcpf(b0);
                        acc[ai][bj][m][e >> 1][(e & 1) * 2 + 1] *= a1 * __builtin_amdgcn_rcpf(b1); } }
                asm volatile("" ::: "memory"); }
    }
    __device__ __forceinline__ void operator()(const f32x4 (&acc)[2][2][4][2], const Unit& u, int wr, int wc, int fr, int fq) const {
        const int row0 = u.pm * BM + wr * 64 + fr, col0 = u.pn * BM + wc * 32 + 8 * fq;
#pragma unroll
        for (int ai = 0; ai < 2; ++ai)
#pragma unroll
            for (int m = 0; m < 4; ++m) { const size_t r = (size_t)(row0 + ai * HALF + m * 16); const bf16_t* gp = G + r * 8192 + col0 + 3 * 2048; bf16_t* op = O + r * 2048 + col0;
#pragma unroll
                for (int bj = 0; bj < 2; ++bj) { const u32x4 g = *(const u32x4*)(gp + bj * HALF); float gv[8];
#pragma unroll
                    for (int e = 0; e < 4; ++e) { gv[2 * e] = fmaxf(__uint_as_float(g[e] << 16), 1e-30f); gv[2 * e + 1] = fmaxf(__uint_as_float(g[e] & 0xffff0000u), 1e-30f); }
                    const f32x4 v0 = acc[ai][bj][m][0], v1 = acc[ai][bj][m][1];
                    u32x4 w; w.x = cvt_pk_bf16(v0[0] * gv[0], v0[1] * gv[1]); w.y = cvt_pk_bf16(v0[2] * gv[2], v0[3] * gv[3]); w.z = cvt_pk_bf16(v1[0] * gv[4], v1[1] * gv[5]); w.w = cvt_pk_bf16(v1[2] * gv[6], v1[3] * gv[7]);
                    *(u32x4*)(op + bj * HALF) = w; }
                asm volatile("" ::: "memory"); }
    }
};

struct EpiResid {
    static constexpr bool PERM = false, AFTER_DRAIN = false, HAS_MID = false;
    float* xl; float* xc; const float* gate_l; const float* gate_c;
    __device__ __forceinline__ void operator()(const f32x4 (&acc)[2][2][4][2], const Unit& u, int wr, int wc, int fr, int fq) const {
        const int row0 = u.pm * BM + wr * 64 + fr, col0 = u.pn * BM + wc * 32 + 4 * fq;
        const bool lat = u.pm < 32;
        float* X = lat ? xl : (xc - (size_t)8192 * 2048); const float* gate = lat ? gate_l : gate_c;
        f32x4 gv[2][2];
#pragma unroll
        for (int bj = 0; bj < 2; ++bj)
#pragma unroll
            for (int n = 0; n < 2; ++n) gv[bj][n] = *(const f32x4*)(gate + col0 + bj * HALF + n * 16);
#pragma unroll
        for (int ai = 0; ai < 2; ++ai)
#pragma unroll
            for (int m = 0; m < 4; ++m) { float* rowp = X + (size_t)(row0 + ai * HALF + m * 16) * 2048 + col0;
#pragma unroll
                for (int bj = 0; bj < 2; ++bj)
#pragma unroll
                    for (int n = 0; n < 2; ++n) { f32x4* q = (f32x4*)(rowp + bj * HALF + n * 16); *q = *q + gv[bj][n] * acc[ai][bj][m][n]; }
                if (m & 1) asm volatile("" ::: "memory"); }
    }
};

struct EpiSwiglu {
    static constexpr bool PERM = true, AFTER_DRAIN = false, HAS_MID = false;
    bf16_t* O;
    __device__ __forceinline__ void operator()(const f32x4 (&acc)[2][2][4][2], const Unit& u, int wr, int wc, int fr, int fq) const {
        const int row0 = u.pm * BM + wr * 64 + fr, col0 = u.pn * HALF + wc * 32 + 8 * fq;
#pragma unroll
        for (int ai = 0; ai < 2; ++ai)
#pragma unroll
            for (int m = 0; m < 4; ++m) { bf16_t* op = O + (size_t)(row0 + ai * HALF + m * 16) * 5632 + col0; float o[8];
#pragma unroll
                for (int n = 0; n < 2; ++n)
#pragma unroll
                    for (int e = 0; e < 4; ++e) { const float g = acc[ai][0][m][n][e], uu = acc[ai][1][m][n][e]; o[4 * n + e] = g * sigmoidf_fast(g) * uu; }
                u32x4 w; w.x = cvt_pk_bf16(o[0], o[1]); w.y = cvt_pk_bf16(o[2], o[3]); w.z = cvt_pk_bf16(o[4], o[5]); w.w = cvt_pk_bf16(o[6], o[7]);
                *(u32x4*)op = w; }
    }
};

template <class Epi, class Sched, bool ALIGN_EPI = false, bool SP2 = false>
__device__ __forceinline__ void gemm_phase(PG8_LAS unsigned char* lds, const Gemm g, const Sched& S, const Epi& E) {
    int tid_ = threadIdx.x; asm volatile("" : "+v"(tid_));
    const int tid = tid_, wid = __builtin_amdgcn_readfirstlane(tid >> 6), lane = tid & 63, wr = wid >> 2, wc = wid & 3, fr = lane & 15, fq = lane >> 4;
    const int K = g.K, nt = K / BK;
    unsigned voffA[2], voffB[2];
#pragma unroll
    for (int i = 0; i < 2; ++i) { int R, C; stage_rc(tid * 16 + i * 8192, R, C); const int Rb = Epi::PERM ? ((R & ~31) + perm32(R & 31)) : R;
        voffA[i] = (unsigned)(R * K + C) * 2u; voffB[i] = (unsigned)(Rb * K + C) * 2u; }
    const size_t kstep = (size_t)(BK * 2);
    const size_t hstep = (size_t)HALF * K * 2;
    const size_t tstep = 2 * hstep;
    const unsigned ldsw = (unsigned)wid * 1024u;
    const int aoff = lds_byte(wr * 64 + fr, fq * 8), boff = lds_byte(wc * 32 + fr, fq * 8);
#define PG8_SA(b, h) (((b) * 2 + (h)) * HTB)
#define PG8_SB(b, h) ((4 + (b) * 2 + (h)) * HTB)
#define PG8_STAGE(bufoff, gbase, voff) do { _Pragma("unroll") for (int _i = 0; _i < 2; ++_i) \
        __builtin_amdgcn_global_load_lds((const unsigned*)((const char*)(gbase) + (voff)[_i]), (PG8_LAS unsigned*)(lds + (bufoff) + ldsw + _i * 8192), 16, 0, 0); } while (0)
#define PG8_LDA(dst, b, h) do { _Pragma("unroll") for (int m = 0; m < 4; ++m) _Pragma("unroll") for (int k = 0; k < 2; ++k) dst[m][k] = *(const PG8_LAS bf16x8*)(lds + PG8_SA(b, h) + aoff + m * 2048 + k * 1024); } while (0)
#define PG8_LDB(dst, b, h) do { _Pragma("unroll") for (int n = 0; n < 2; ++n) _Pragma("unroll") for (int k = 0; k < 2; ++k) dst[n][k] = *(const PG8_LAS bf16x8*)(lds + PG8_SB(b, h) + boff + n * 2048 + k * 1024); } while (0)
#define PG8_MMA(ai, bj, At, Bt) do { __builtin_amdgcn_s_setprio(1); _Pragma("unroll") for (int m = 0; m < 4; ++m) _Pragma("unroll") for (int n = 0; n < 2; ++n) _Pragma("unroll") for (int k = 0; k < 2; ++k) \
        acc[ai][bj][m][n] = __builtin_amdgcn_mfma_f32_16x16x32_bf16(Bt[n][k], At[m][k], acc[ai][bj][m][n], 0, 0, 0); __builtin_amdgcn_s_setprio(0); } while (0)
#define PG8_WAIT_V(n) asm volatile("s_waitcnt vmcnt(" #n ")" ::: "memory")
#define PG8_WAIT_L(n) asm volatile("s_waitcnt lgkmcnt(" #n ")" ::: "memory")
#define PG8_BAR __builtin_amdgcn_s_barrier()
#define PG8_SCHED __builtin_amdgcn_sched_barrier(0)
    Unit cur, nxt; int ui = 0;
    if (!S.next(0, cur)) return;
    f32x4 acc[2][2][4][2];
#pragma unroll
    for (int a = 0; a < 2; ++a)
#pragma unroll
        for (int b = 0; b < 2; ++b)
#pragma unroll
            for (int m = 0; m < 4; ++m)
#pragma unroll
                for (int n = 0; n < 2; ++n) acc[a][b][m][n] = (f32x4){0.f, 0.f, 0.f, 0.f};
    bf16x8 At[4][2], B0[2][2], B1[2][2];
    const char* cA = (const char*)g.A + (size_t)cur.pm * tstep; const char* cB = (const char*)g.Bt + (size_t)cur.pn * tstep;
    S.a_ready(cur);
    if constexpr (SP2) {
        PG8_STAGE(PG8_SB(0, 0), cB, voffB); PG8_STAGE(PG8_SB(0, 1), cB + hstep, voffB); PG8_STAGE(PG8_SA(0, 0), cA, voffA); PG8_STAGE(PG8_SA(0, 1), cA + hstep, voffA);
        if (wr == 1) PG8_BAR;
        PG8_WAIT_V(2); PG8_BAR;
        PG8_STAGE(PG8_SB(1, 0), cB + kstep, voffB); PG8_STAGE(PG8_SA(1, 0), cA + kstep, voffA); PG8_STAGE(PG8_SB(1, 1), cB + hstep + kstep, voffB);
        PG8_WAIT_V(6); PG8_BAR;
    } else {
        PG8_STAGE(PG8_SB(0, 0), cB, voffB); PG8_STAGE(PG8_SA(0, 0), cA, voffA); PG8_STAGE(PG8_SB(0, 1), cB + hstep, voffB); PG8_STAGE(PG8_SA(0, 1), cA + hstep, voffA);
        if (wr == 1) PG8_BAR;
        PG8_WAIT_V(4); PG8_BAR;
        PG8_STAGE(PG8_SB(1, 0), cB + kstep, voffB); PG8_STAGE(PG8_SA(1, 0), cA + kstep, voffA); PG8_STAGE(PG8_SB(1, 1), cB + hstep + kstep, voffB);
        PG8_WAIT_V(6); PG8_BAR;
    }
    for (;;) {
        const bool has_next = S.next(ui + 1, nxt);
        const char* nA = has_next ? (const char*)g.A + (size_t)nxt.pm * tstep : cA; const char* nB = has_next ? (const char*)g.Bt + (size_t)nxt.pn * tstep : cB;
        for (int t = 0; t < nt; t += 2) {
            const bool last = (t == nt - 2);
            const char* a1 = cA + (size_t)(t + 1) * kstep;
            const char* a2 = last ? nA : cA + (size_t)(t + 2) * kstep; const char* b2 = last ? nB : cB + (size_t)(t + 2) * kstep;
            const char* a3 = a2 + kstep; const char* b3 = b2 + kstep;
            if (last && has_next) S.a_ready(nxt);
            if constexpr (SP2) {
            PG8_LDB(B0, 0, 0); PG8_LDB(B1, 0, 1); PG8_SCHED; PG8_LDA(At, 0, 0); PG8_STAGE(PG8_SA(1, 1), a1 + hstep, voffA);
            PG8_WAIT_V(8); PG8_WAIT_L(0); PG8_BAR; PG8_MMA(0, 0, At, B0); PG8_MMA(0, 1, At, B1); PG8_BAR; PG8_SCHED;
            PG8_LDA(At, 0, 1); PG8_STAGE(PG8_SB(0, 0), b2, voffB); PG8_STAGE(PG8_SB(0, 1), b2 + hstep, voffB); PG8_STAGE(PG8_SA(0, 0), a2, voffA);
            PG8_WAIT_V(8); PG8_WAIT_L(0); PG8_BAR; PG8_MMA(1, 0, At, B0); PG8_MMA(1, 1, At, B1); PG8_BAR; PG8_SCHED;
            PG8_LDB(B0, 1, 0); PG8_LDB(B1, 1, 1); PG8_SCHED; PG8_LDA(At, 1, 0); PG8_STAGE(PG8_SA(0, 1), a2 + hstep, voffA);
            PG8_WAIT_V(8); PG8_WAIT_L(0); PG8_BAR; PG8_MMA(0, 0, At, B0); PG8_MMA(0, 1, At, B1); PG8_BAR; PG8_SCHED;
            PG8_LDA(At, 1, 1); PG8_STAGE(PG8_SB(1, 0), b3, voffB); PG8_STAGE(PG8_SB(1, 1), b3 + hstep, voffB); PG8_STAGE(PG8_SA(1, 0), a3, voffA);
            PG8_WAIT_V(8); PG8_WAIT_L(0); PG8_BAR; PG8_MMA(1, 0, At, B0); PG8_MMA(1, 1, At, B1); PG8_BAR; PG8_SCHED;
            } else {
            PG8_LDB(B0, 0, 0); PG8_SCHED; PG8_LDA(At, 0, 0); PG8_STAGE(PG8_SA(1, 1), a1 + hstep, voffA);
            PG8_WAIT_L(8); PG8_BAR; PG8_WAIT_L(0); PG8_MMA(0, 0, At, B0); PG8_BAR; PG8_SCHED;
            PG8_LDB(B1, 0, 1); PG8_STAGE(PG8_SB(0, 0), b2, voffB);
            PG8_BAR; PG8_WAIT_L(0); PG8_MMA(0, 1, At, B1); PG8_BAR;
            PG8_LDA(At, 0, 1); PG8_STAGE(PG8_SA(0, 0), a2, voffA);
            PG8_BAR; PG8_WAIT_L(0); PG8_MMA(1, 0, At, B0); PG8_BAR; PG8_SCHED;
            PG8_STAGE(PG8_SB(0, 1), b2 + hstep, voffB);
            PG8_WAIT_V(6); PG8_BAR; PG8_MMA(1, 1, At, B1); PG8_BAR;
            PG8_LDB(B0, 1, 0); PG8_SCHED; PG8_LDA(At, 1, 0); PG8_STAGE(PG8_SA(0, 1), a2 + hstep, voffA);
            PG8_WAIT_L(8); PG8_BAR; PG8_WAIT_L(0); PG8_MMA(0, 0, At, B0); PG8_BAR; PG8_SCHED;
            PG8_LDB(B1, 1, 1); PG8_STAGE(PG8_SB(1, 0), b3, voffB);
            PG8_BAR; PG8_WAIT_L(0); PG8_MMA(0, 1, At, B1); PG8_BAR;
            PG8_LDA(At, 1, 1); PG8_STAGE(PG8_SA(1, 0), a3, voffA);
            PG8_BAR; PG8_WAIT_L(0); PG8_MMA(1, 0, At, B0); PG8_BAR; PG8_SCHED;
            PG8_STAGE(PG8_SB(1, 1), b3 + hstep, voffB);
            PG8_WAIT_V(6); PG8_BAR; PG8_MMA(1, 1, At, B1); PG8_BAR;
            }
            if constexpr (Epi::HAS_MID) { if ((((t + 2) & 7) == 0) && ((t + 2) < nt)) E.mid(acc, cur, ((t + 2) >> 3) - 1, wr, wc, fr, fq); }
        }
        if constexpr (ALIGN_EPI) { if (wr == 0) PG8_BAR; }
        if constexpr (!Epi::AFTER_DRAIN) { E(acc, cur, wr, wc, fr, fq); S.done(cur); }
        if (!has_next) break;
#pragma unroll
        for (int a = 0; a < 2; ++a)
#pragma unroll
            for (int b = 0; b < 2; ++b)
#pragma unroll
                for (int m = 0; m < 4; ++m)
#pragma unroll
                    for (int n = 0; n < 2; ++n) acc[a][b][m][n] = (f32x4){0.f, 0.f, 0.f, 0.f};
        cur = nxt; cA = nA; cB = nB; ++ui;
        if constexpr (ALIGN_EPI) { if (wr == 1) PG8_BAR; }
    }
    PG8_WAIT_V(0);
    if constexpr (!ALIGN_EPI) { if (wr == 0) PG8_BAR; }
    PG8_BAR;
    if constexpr (Epi::AFTER_DRAIN) { E.fused(acc, cur, wr, wc, fr, fq, lds, wid, lane); S.done(cur); }
#undef PG8_SA
#undef PG8_SB
#undef PG8_STAGE
#undef PG8_LDA
#undef PG8_LDB
#undef PG8_MMA
#undef PG8_WAIT_V
#undef PG8_WAIT_L
#undef PG8_BAR
#undef PG8_SCHED
}
}

constexpr int NWAVES = 8;
constexpr int DM = 2048, SEQ = 8192, CTXL = 256, MT = SEQ + CTXL, DEPTH = 4, GRIDW = 64;
constexpr int INC = 13056, ZC = 4864, GC = 8192, BW = 512, FHID = 5632, F2 = 2 * FHID, NMOD = 6 * DM;
constexpr int ZC_QA = 0, ZC_KA = 512, ZC_VA = 640, ZC_QB = 768, ZC_KB = 1280, ZC_VB = 1792, ZC_XR = 2304, ZC_GR = 2816, ZC_XD = 3328, ZC_BD = 3840, ZC_CD = 4352;
constexpr float EPS = 1e-6f, LOG2E = 1.4426950408889634f;
constexpr int NPL = 9;
constexpr int N_PHASES = 2 + DEPTH * NPL;
#ifndef MK_ONE_LAUNCH
#define MK_ONE_LAUNCH 1
#endif
constexpr size_t MiB = 1u << 20;
constexpr size_t WS_CTL = 0, CTL_ZERO_BYTES = 1 * MiB;
constexpr size_t WS_MOD = 1 * MiB;
constexpr size_t WS_ROPE = 2 * MiB;
constexpr size_t WS_GW = 3 * MiB;
constexpr size_t WS_XC = 5 * MiB;
constexpr size_t WS_PS = 7 * MiB;
constexpr size_t WS_AB = 16 * MiB;
constexpr size_t WS_H = 88 * MiB;
constexpr size_t WS_Z = 124 * MiB;
constexpr size_t WS_G = 204 * MiB;
constexpr size_t WS_BR = 336 * MiB;
constexpr size_t WS_MG = 372 * MiB;
constexpr size_t WS_FH = 408 * MiB;
constexpr size_t WS_W = 512 * MiB;
constexpr size_t WL_IN = 0, WL_BR = 51 * MiB, WL_OUT = 59 * MiB, WL_F1 = 67 * MiB, WL_F2 = 111 * MiB, WL_STRIDE = 133 * MiB;
constexpr size_t WS_END = WS_W + DEPTH * WL_STRIDE;
static_assert((size_t)INC * DM * 2 <= WL_BR && (size_t)DM * DM * 2 <= WL_OUT - WL_BR && (size_t)F2 * DM * 2 <= WL_F2 - WL_F1 && (size_t)DM * FHID * 2 <= WL_STRIDE - WL_F2, "weight map");
static_assert(WS_AB + (size_t)4 * MT * 512 * 4 <= WS_H && WS_H + (size_t)MT * DM * 2 <= WS_Z && WS_Z + (size_t)MT * ZC * 2 <= WS_G && WS_G + (size_t)MT * GC * 2 <= WS_BR && WS_FH + (size_t)MT * FHID * 2 <= WS_W, "d_ws map");
constexpr int CW_BAR = 4096;
constexpr int RING_BYTES = 131072;
constexpr int LDSCTL_OFF = RING_BYTES, MISC_OFF = LDSCTL_OFF + 320;
constexpr int LDS_BYTES = 147456;

#define GAS __attribute__((address_space(1)))
#define LAS __attribute__((address_space(3)))
typedef unsigned short bf16;
typedef unsigned v4u __attribute__((ext_vector_type(4)));
typedef unsigned v2u __attribute__((ext_vector_type(2)));
typedef float f32x4 __attribute__((ext_vector_type(4)));
typedef float f32x16 __attribute__((ext_vector_type(16)));
typedef short bf16x8 __attribute__((ext_vector_type(8)));
typedef short s16x4 __attribute__((ext_vector_type(4)));
typedef GAS unsigned gu32;
#define RLX_AGENT __ATOMIC_RELAXED, __HIP_MEMORY_SCOPE_AGENT
#define LDS_WAIT() asm volatile("s_waitcnt lgkmcnt(0)" ::: "memory")
__device__ __forceinline__ unsigned f2bf(float f) { unsigned u = __builtin_bit_cast(unsigned, f); return (u + 0x7fffu + ((u >> 16) & 1u)) >> 16; }
__device__ __forceinline__ unsigned pk2(float lo, float hi) { return f2bf(lo) | (f2bf(hi) << 16); }
__device__ __forceinline__ float bflo(unsigned w) { return __uint_as_float(w << 16); }
__device__ __forceinline__ float bfhi(unsigned w) { return __uint_as_float(w & 0xffff0000u); }
__device__ __forceinline__ float bf1(bf16 b) { return __uint_as_float(((unsigned)b) << 16); }
__device__ __forceinline__ float sigm(float x) { return __builtin_amdgcn_rcpf(1.0f + __expf(-x)); }

#define XB_TMO      128
#define XB_XCNT(j)  (256  + 64 * (j))
#define XB_XSUB(j)  (1280 + 64 * (j))
#define XB_XGEN(j)  (2304 + 64 * (j))
#define XB_TOP      3328
#define XB_TOPGEN   3392
#define XCD_BAR_WORDS 3456
#define XB_SPIN_CAP (1u << 18)

__device__ __forceinline__ unsigned xb_ld(unsigned* p)              { return __hip_atomic_load(p, __ATOMIC_RELAXED, __HIP_MEMORY_SCOPE_AGENT); }
__device__ __forceinline__ unsigned xb_add(unsigned* p, unsigned v) { return __hip_atomic_fetch_add(p, v, __ATOMIC_RELAXED, __HIP_MEMORY_SCOPE_AGENT); }
__device__ __forceinline__ unsigned xb_xcc_id() { return (unsigned)__builtin_amdgcn_s_getreg((3 << 11) | 20) & 0xFu; }
#define XB_SPIN(cond, bar) do { unsigned _sp = 0; while (cond) { __builtin_amdgcn_s_sleep(1); \
    if ((++_sp & 255u) == 0u) { if (xb_ld(&(bar)[XB_TMO])) break; if (_sp > XB_SPIN_CAP) { atomicAdd(&(bar)[XB_TMO], 1u); break; } } } } while (0)

struct XcdBarrier {
    unsigned* bar; unsigned x;
    volatile LAS unsigned* st;
};

__device__ __forceinline__ XcdBarrier xcd_barrier_post(unsigned* bar, volatile LAS unsigned* st) {
    XcdBarrier b; b.bar = bar; b.x = xb_xcc_id(); b.st = st;
    if (threadIdx.x == 0) (void)xb_add(&bar[XB_XCNT(b.x)], 1u);
    return b;
}
__device__ __forceinline__ void xcd_barrier_complete(unsigned* bar, unsigned x, unsigned& nloc, unsigned& nx) {
    const unsigned G = gridDim.x * gridDim.y * gridDim.z;
    unsigned sum, cnt, mine, sp = 0u;
    for (;;) {
        sum = 0u; cnt = 0u; mine = 0u;
#pragma unroll
        for (unsigned j = 0; j < 16; ++j) { const unsigned c = xb_ld(&bar[XB_XCNT(j)]); sum += c; cnt += (c > 0u) ? 1u : 0u; mine = (j == x) ? c : mine; }
        if (sum == G) break;
        __builtin_amdgcn_s_sleep(1);
        if ((++sp & 255u) == 0u) { if (xb_ld(&bar[XB_TMO])) break; if (sp > XB_SPIN_CAP) { atomicAdd(&bar[XB_TMO], 1u); break; } }
    }
    nloc = mine > 0u ? mine : 1u; nx = cnt > 0u ? cnt : 1u;
}

__device__ __forceinline__ void xcd_barrier(const XcdBarrier& b) {
    asm volatile("s_waitcnt vmcnt(0)" ::: "memory");
    __syncthreads();
    if (threadIdx.x == 0) {
        unsigned* bar = b.bar;
        __builtin_amdgcn_s_waitcnt(0);
        unsigned nloc = b.st[0], nx = b.st[1];
        if (nloc == 0u) { xcd_barrier_complete(bar, b.x, nloc, nx); b.st[0] = nloc; b.st[1] = nx; }
        const unsigned old = xb_add(&bar[XB_XSUB(b.x)], 1u);
        const unsigned gen = old / nloc;
        if (old + 1u == (gen + 1u) * nloc) {
            __builtin_amdgcn_fence(__ATOMIC_RELEASE, "agent");
            asm volatile("s_waitcnt vmcnt(0)" ::: "memory");
            const unsigned og = xb_add(&bar[XB_TOP], 1u);
            const unsigned tg = og / nx;
            if (og + 1u == (tg + 1u) * nx) xb_add(&bar[XB_TOPGEN], 1u);
            else XB_SPIN(xb_ld(&bar[XB_TOPGEN]) == tg, bar);
            __builtin_amdgcn_fence(__ATOMIC_ACQUIRE, "agent");
            xb_add(&bar[XB_XGEN(b.x)], 1u);
            asm volatile("s_waitcnt vmcnt(0)" ::: "memory");
        } else {
            XB_SPIN(xb_ld(&bar[XB_XGEN(b.x)]) == gen, bar);
            __builtin_amdgcn_fence(__ATOMIC_ACQUIRE, "agent");
            asm volatile("s_waitcnt vmcnt(0)" ::: "memory");
        }
    }
    __syncthreads();
}

#define KAS __attribute__((address_space(4)))
struct Args { const float* in[25]; float* out; unsigned char* ws; int ph_lo, ph_hi; };
struct Frame {
    LAS unsigned char* lds;
    volatile LAS unsigned* MISC;
    gu32* ctl;
    int tid, lane, wave, G;
    const KAS Args* ka;
    float* out; unsigned char* ws;
};
enum { I_X = 0, I_C, I_CTX, I_CCTX, I_WMOD, I_BMOD, I_NORM1, I_NORM2, I_WIN, I_BGATE, I_ASINK, I_NBBIAS, I_CCONVW, I_CCONVB, I_CWA, I_CBA, I_CWX, I_CBX, I_CLAM, I_DCONVW, I_WBR, I_WOUT, I_WF1, I_WF2, I_FNORM };

__device__ __forceinline__ float wave_sum(float v) {
#pragma unroll
    for (int o = 1; o < 64; o <<= 1) v += __shfl_xor(v, o);
    return v;
}

__device__ __forceinline__ void transpose_item(const float* W, int ldw, int k0, int n0, bf16* dst, int ldt, LAS float* scr, int lane) {
#pragma unroll 8
    for (int i = 0; i < 32; ++i) { const int kk = 2 * i + (lane >> 5); scr[kk * 33 + (lane & 31)] = W[(size_t)(k0 + kk) * ldw + n0 + (lane & 31)]; }
    LDS_WAIT(); asm volatile("" ::: "memory");
    const int c = lane & 7;
#pragma unroll
    for (int j = 0; j < 4; ++j) { const int n = (lane >> 3) + 8 * j; const LAS float* s = scr + (8 * c) * 33 + n;
        v4u o; o.x = pk2(s[0 * 33], s[1 * 33]); o.y = pk2(s[2 * 33], s[3 * 33]); o.z = pk2(s[4 * 33], s[5 * 33]); o.w = pk2(s[6 * 33], s[7 * 33]);
        *(GAS v4u*)(dst + (size_t)n * ldt + 8 * c) = o; }
    LDS_WAIT(); asm volatile("" ::: "memory");
}

__device__ __forceinline__ void p0_prologue(Frame& F) {
    const int gw = blockIdx.x * NWAVES + F.wave, NGW = F.G * NWAVES;
    const int gt = blockIdx.x * (NWAVES * 64) + F.tid, NGT = F.G * NWAVES * 64;
    if (gt < 2048) {
        const int pos = gt >> 4, i = gt & 15;
        const float freq = exp2f(-(float)i * (13.287712379549449f / 16.0f));
        const float ang = (float)pos * freq;
        const float k = rintf(ang * 0.15915494309189535f);
        float r = fmaf(-k, 6.28125f, ang); r = fmaf(-k, 0.0019353071795864769f, r);
        float* rc = (float*)(F.ws + WS_ROPE);
        rc[gt] = __cosf(r); rc[2048 + gt] = __sinf(r);
    }
    {
        const f32x4* xs = (const f32x4*)F.ka->in[I_X]; f32x4* xd = (f32x4*)F.out;
        for (int i = gt; i < SEQ * DM / 4; i += NGT) xd[i] = xs[i];
        const f32x4* cs = (const f32x4*)F.ka->in[I_CTX]; f32x4* cd = (f32x4*)(F.ws + WS_XC);
        for (int i = gt; i < CTXL * DM / 4; i += NGT) cd[i] = cs[i];
    }
    {
        LAS float* sl = (LAS float*)F.lds;
        LAS float* sc = sl + 2048;
        LAS float* red = sc + 2048;
        for (int i = F.tid; i < 2048; i += NWAVES * 64) { const float a = F.ka->in[I_C][i], b = F.ka->in[I_CCTX][i]; sl[i] = a * sigm(a); sc[i] = b * sigm(b); }
        __syncthreads();
        const int half = F.lane >> 5, c4 = F.lane & 31;
        for (int item = blockIdx.x; item < DEPTH * 96; item += F.G) {
            const int l = item / 96, col0 = (item % 96) * 128;
            const float* W = F.ka->in[I_WMOD] + (size_t)l * DM * NMOD + col0 + 4 * c4;
            f32x4 al = {0.f, 0.f, 0.f, 0.f}, ac = {0.f, 0.f, 0.f, 0.f};
#pragma unroll 8
            for (int i = 0; i < 128; ++i) { const int row = F.wave * 256 + 2 * i + half; const f32x4 v = *(const f32x4*)(W + (size_t)row * NMOD); al += sl[row] * v; ac += sc[row] * v; }
#pragma unroll
            for (int e = 0; e < 4; ++e) { al[e] += __shfl_xor(al[e], 32); ac[e] += __shfl_xor(ac[e], 32); }
            if (half == 0) { *(LAS f32x4*)(red + (F.wave * 2 + 0) * 128 + 4 * c4) = al; *(LAS f32x4*)(red + (F.wave * 2 + 1) * 128 + 4 * c4) = ac; }
            __syncthreads();
            if (F.tid < 256) { const int which = F.tid >> 7, col = F.tid & 127; float s = F.ka->in[I_BMOD][l * NMOD + col0 + col];
#pragma unroll
                for (int w = 0; w < 8; ++w) s += red[(w * 2 + which) * 128 + col];
                ((float*)(F.ws + WS_MOD))[(size_t)(l * 2 + which) * NMOD + col0 + col] = s; }
            __syncthreads();
        }
    }
    {
        LAS float* scr = (LAS float*)(F.lds + F.wave * 16384);
        constexpr int I_IN = (DM / 64) * (INC / 32), I_BR = 4 * (BW / 64) * (DM / 32), I_OUT = (DM / 64) * (DM / 32), I_F1 = (DM / 64) * (F2 / 32), I_F2 = (FHID / 64) * (DM / 32);
        constexpr int PER_L = I_IN + I_BR + I_OUT + I_F1 + I_F2, I_GW = 64 * 8;
        constexpr int NITEMS = DEPTH * PER_L + I_GW;
        for (int it = gw; it < NITEMS; it += NGW) {
            if (it >= DEPTH * PER_L) {
                const int r = it - DEPTH * PER_L, mi = r >> 3, sub = r & 7, kb = sub >> 2, nb = sub & 3;
                const int blk = mi & 3, map = (mi >> 2) & 1, ld = mi >> 3;
                const float* W = (map ? F.ka->in[I_CWX] : F.ka->in[I_CWA]) + (size_t)(ld * 4 + blk) * 16384;
                bf16* dst = (bf16*)(F.ws + WS_GW) + (size_t)mi * 16384 + (size_t)(32 * nb) * 128 + 64 * kb;
                transpose_item(W, 128, 64 * kb, 32 * nb, dst, 128, scr, F.lane);
                continue;
            }
            const int l = it / PER_L; int r = it % PER_L;
            unsigned char* wl = F.ws + WS_W + (size_t)l * WL_STRIDE;
            if (r < I_IN) { const int nblk = INC / 32, kb = r / nblk, nb = r % nblk;
                transpose_item(F.ka->in[I_WIN] + (size_t)l * DM * INC, INC, 64 * kb, 32 * nb, (bf16*)(wl + WL_IN) + (size_t)(32 * nb) * DM + 64 * kb, DM, scr, F.lane); continue; }
            r -= I_IN;
            if (r < I_BR) { const int per = (BW / 64) * (DM / 32), k = r / per, rr = r % per, nblk = DM / 32, kb = rr / nblk, nb = rr % nblk;
                transpose_item(F.ka->in[I_WBR] + (size_t)(l * 4 + k) * BW * DM, DM, 64 * kb, 32 * nb, (bf16*)(wl + WL_BR) + (size_t)(32 * nb) * DM + k * BW + 64 * kb, DM, scr, F.lane); continue; }
            r -= I_BR;
            if (r < I_OUT) { const int nblk = DM / 32, kb = r / nblk, nb = r % nblk;
                transpose_item(F.ka->in[I_WOUT] + (size_t)l * DM * DM, DM, 64 * kb, 32 * nb, (bf16*)(wl + WL_OUT) + (size_t)(32 * nb) * DM + 64 * kb, DM, scr, F.lane); continue; }
            r -= I_OUT;
            if (r < I_F1) { const int nblk = F2 / 32, kb = r / nblk, nb = r % nblk; const int n0 = 32 * nb;
                const int j = n0 < FHID ? n0 : n0 - FHID; const int drow = (j >> 7) * 256 + (n0 < FHID ? 0 : 128) + (j & 127);
                transpose_item(F.ka->in[I_WF1] + (size_t)l * DM * F2, F2, 64 * kb, n0, (bf16*)(wl + WL_F1) + (size_t)drow * DM + 64 * kb, DM, scr, F.lane); continue; }
            r -= I_F1;
            { const int nblk = DM / 32, kb = r / nblk, nb = r % nblk;
                transpose_item(F.ka->in[I_WF2] + (size_t)l * FHID * DM, DM, 64 * kb, 32 * nb, (bf16*)(wl + WL_F2) + (size_t)(32 * nb) * FHID + 64 * kb, FHID, scr, F.lane); }
        }
    }
}

__device__ __forceinline__ void norm_phase(Frame& F, int l, int which, int nrows) {
    const int gw = blockIdx.x * NWAVES + F.wave, NGW = F.G * NWAVES;
    const float* gain = (which ? F.ka->in[I_NORM2] : F.ka->in[I_NORM1]) + l * DM;
    bf16* H = (bf16*)(F.ws + WS_H);
    for (int m = gw; m < nrows; m += NGW) {
        const bool lat = m < SEQ;
        const float* xrow = lat ? F.out + (size_t)m * DM : (const float*)(F.ws + WS_XC) + (size_t)(m - SEQ) * DM;
        const float* mod = (const float*)(F.ws + WS_MOD) + (size_t)(l * 2 + (lat ? 0 : 1)) * NMOD + (which ? 3 * DM : 0);
        f32x4 v[8]; float ss = 0.f;
#pragma unroll
        for (int j = 0; j < 8; ++j) { v[j] = *(const f32x4*)(xrow + 4 * F.lane + 256 * j); ss += (v[j][0] * v[j][0] + v[j][1] * v[j][1]) + (v[j][2] * v[j][2] + v[j][3] * v[j][3]); }
        const float rstd = 1.0f / sqrtf(wave_sum(ss) * (1.0f / DM) + EPS);
#pragma unroll
        for (int j = 0; j < 8; ++j) { const int c = 4 * F.lane + 256 * j;
            const f32x4 g = *(const f32x4*)(gain + c), sh = *(const f32x4*)(mod + c), scl = *(const f32x4*)(mod + DM + c);
            const f32x4 o = (v[j] * rstd * g) * (1.0f + scl) + sh;
            v2u w; w.x = pk2(o[0], o[1]); w.y = pk2(o[2], o[3]);
            *(v2u*)(H + (size_t)m * DM + c) = w; }
    }
}
__device__ __forceinline__ void final_norm_phase(Frame& F) {
    const int gw = blockIdx.x * NWAVES + F.wave, NGW = F.G * NWAVES;
    const float* gain = F.ka->in[I_FNORM];
    for (int m = gw; m < SEQ; m += NGW) {
        float* xrow = F.out + (size_t)m * DM;
        f32x4 v[8]; float ss = 0.f;
#pragma unroll
        for (int j = 0; j < 8; ++j) { v[j] = *(const f32x4*)(xrow + 4 * F.lane + 256 * j); ss += (v[j][0] * v[j][0] + v[j][1] * v[j][1]) + (v[j][2] * v[j][2] + v[j][3] * v[j][3]); }
        const float rstd = 1.0f / sqrtf(wave_sum(ss) * (1.0f / DM) + EPS);
#pragma unroll
        for (int j = 0; j < 8; ++j) { const int c = 4 * F.lane + 256 * j; const f32x4 g = *(const f32x4*)(gain + c); *(f32x4*)(xrow + c) = (v[j] * rstd) * g; }
    }
}

#define MFMA32(a, b, c) __builtin_amdgcn_mfma_f32_32x32x16_bf16((a), (b), (c), 0, 0, 0)
__device__ __forceinline__ int crow(int reg, int h) { return (reg & 3) + 8 * (reg >> 2) + 4 * h; }
typedef short v4i16_t __attribute__((ext_vector_type(4)));
__device__ __forceinline__ s16x4 tr_read(LAS unsigned char* p) { return __builtin_bit_cast(s16x4, __builtin_amdgcn_ds_read_tr16_b64_v4i16((LAS v4i16_t*)p)); }
__device__ __forceinline__ unsigned cvtpk(float lo, float hi) { return pg8::cvt_pk_bf16(lo, hi); }

constexpr int VPITCH = 144;
constexpr int ATT_WAVE_LDS = 32 * VPITCH + 1920;
constexpr float ATT_SCALE = 0.125f;
constexpr float NEG_BIG = -1.0e30f;

struct AttnState { f32x16 o0, o1; float m, l; };
template <class ScoreFn>
__device__ __forceinline__ void attn_keytile(AttnState& st, const bf16x8 (&qf)[4], const bf16* Kp, const bf16* Vp, LAS unsigned char* vlds, int lane, const ScoreFn& sf) {
    const int r = lane & 31, h = lane >> 5;
    bf16x8 kf[4];
#pragma unroll
    for (int ds = 0; ds < 4; ++ds) kf[ds] = *(const bf16x8*)(Kp + (size_t)r * ZC + 16 * ds + 8 * h);
    {
        const bf16* vsrc = Vp + (size_t)(lane >> 1) * ZC + (lane & 1) * 32;
        const v4u a0 = *(const v4u*)(vsrc), a1 = *(const v4u*)(vsrc + 8), a2 = *(const v4u*)(vsrc + 16), a3 = *(const v4u*)(vsrc + 24);
        LAS v4u* dst = (LAS v4u*)(vlds + (lane >> 1) * VPITCH + (lane & 1) * 64);
        dst[0] = a0; dst[1] = a1; dst[2] = a2; dst[3] = a3;
    }
    f32x16 s;
#pragma unroll
    for (int i = 0; i < 16; ++i) s[i] = 0.f;
#pragma unroll
    for (int ds = 0; ds < 4; ++ds) s = MFMA32(kf[ds], qf[ds], s);
    float mt = NEG_BIG;
#pragma unroll
    for (int i = 0; i < 16; ++i) { s[i] = sf(s[i], crow(i, h), r); mt = fmaxf(mt, s[i]); }
    mt = fmaxf(mt, __shfl_xor(mt, 32));
    const float mn = fmaxf(st.m, mt), alpha = __builtin_amdgcn_exp2f(st.m - mn);
    float ps = 0.f;
#pragma unroll
    for (int i = 0; i < 16; ++i) { s[i] = __builtin_amdgcn_exp2f(s[i] - mn); ps += s[i]; }
    st.l = st.l * alpha + ps; st.m = mn;
#pragma unroll
    for (int i = 0; i < 16; ++i) { st.o0[i] *= alpha; st.o1[i] *= alpha; }
    v4u p0, p1;
    p0.x = cvtpk(s[0], s[1]); p0.y = cvtpk(s[2], s[3]); p0.z = cvtpk(s[4], s[5]); p0.w = cvtpk(s[6], s[7]);
    p1.x = cvtpk(s[8], s[9]); p1.y = cvtpk(s[10], s[11]); p1.z = cvtpk(s[12], s[13]); p1.w = cvtpk(s[14], s[15]);
    const bf16x8 pf0 = __builtin_bit_cast(bf16x8, p0), pf1 = __builtin_bit_cast(bf16x8, p1);
    asm volatile("" ::: "memory");
    const int i16 = lane & 15, q = i16 >> 2, p = i16 & 3, dhalf = (lane >> 4) & 1;
    LAS unsigned char* vb = vlds + (4 * h + q) * VPITCH + (16 * dhalf + 4 * p) * 2;
#pragma unroll
    for (int dt = 0; dt < 2; ++dt) {
        const s16x4 lo0 = tr_read(vb + dt * 64), hi0 = tr_read(vb + 8 * VPITCH + dt * 64);
        const s16x4 lo1 = tr_read(vb + 16 * VPITCH + dt * 64), hi1 = tr_read(vb + 24 * VPITCH + dt * 64);
        const bf16x8 v0 = (bf16x8){lo0[0], lo0[1], lo0[2], lo0[3], hi0[0], hi0[1], hi0[2], hi0[3]};
        const bf16x8 v1 = (bf16x8){lo1[0], lo1[1], lo1[2], lo1[3], hi1[0], hi1[1], hi1[2], hi1[3]};
        if (dt == 0) { st.o0 = MFMA32(v0, pf0, st.o0); st.o0 = MFMA32(v1, pf1, st.o0); }
        else         { st.o1 = MFMA32(v0, pf0, st.o1); st.o1 = MFMA32(v1, pf1, st.o1); }
    }
    asm volatile("" ::: "memory");
}
__device__ __forceinline__ void attn_store(const AttnState& st, float linv, bf16* Op  , int lane) {
    const int r = lane & 31, h = lane >> 5;
    bf16* rowp = Op + (size_t)r * DM + 4 * h;
#pragma unroll
    for (int g = 0; g < 4; ++g) {
        v2u w0, w1;
        w0.x = cvtpk(st.o0[4 * g] * linv, st.o0[4 * g + 1] * linv); w0.y = cvtpk(st.o0[4 * g + 2] * linv, st.o0[4 * g + 3] * linv);
        w1.x = cvtpk(st.o1[4 * g] * linv, st.o1[4 * g + 1] * linv); w1.y = cvtpk(st.o1[4 * g + 2] * linv, st.o1[4 * g + 3] * linv);
        *(v2u*)(rowp + 8 * g) = w0; *(v2u*)(rowp + 32 + 8 * g) = w1;
    }
}
__device__ __forceinline__ void attn_init(AttnState& st) {
#pragma unroll
    for (int i = 0; i < 16; ++i) { st.o0[i] = 0.f; st.o1[i] = 0.f; }
    st.m = NEG_BIG; st.l = 0.f;
}
__device__ __forceinline__ void load_q(bf16x8 (&qf)[4], const bf16* Qp, int lane) {
    const int r = lane & 31, h = lane >> 5;
#pragma unroll
    for (int ds = 0; ds < 4; ++ds) qf[ds] = *(const bf16x8*)(Qp + (size_t)r * ZC + 16 * ds + 8 * h);
}

struct ScorePlain { __device__ __forceinline__ float operator()(float s, int, int) const { return s * (ATT_SCALE * LOG2E); } };
struct ScoreWin {
    int dk;
    __device__ __forceinline__ float operator()(float s, int krow, int qr) const { const int d = dk + krow - qr; return (d >= -128 && d <= 128) ? s * (ATT_SCALE * LOG2E) : NEG_BIG; }
};
struct ScoreNb {
    const LAS float* tab;
    int kc0, cq0, dr;
    __device__ __forceinline__ float operator()(float s, int krow, int qr) const {
        const int ck = kc0 + krow, cq = cq0 + qr; int cs = cq - 8; cs = cs < 0 ? 0 : (cs > 48 ? 48 : cs);
        int dc = ck - cq + 15; dc = dc < 0 ? 0 : (dc > 30 ? 30 : dc);
        const float b = tab[dr * 31 + dc];
        return (ck >= cs && ck < cs + 16) ? (s * ATT_SCALE + b) * LOG2E : NEG_BIG;
    }
};

__device__ __forceinline__ void attn_item(Frame& F, int l, int idx, int nqt, LAS unsigned char* wlds) {
    const int lane = F.lane;
    const bf16* Z = (const bf16*)(F.ws + WS_Z); bf16* BR = (bf16*)(F.ws + WS_BR);
    const bool isB = idx >= nqt * 8; if (isB) idx -= nqt * 8;
    const int qt = idx >> 3, hq = idx & 7;
    const bool lat = qt < 256; const int qrow0 = lat ? 32 * qt : SEQ + 32 * (qt - 256);
    AttnState st; attn_init(st); bf16x8 qf[4];
    if (!isB) {
        const int hk = hq >> 2;
        load_q(qf, Z + (size_t)qrow0 * ZC + ZC_QA + hq * 64, lane);
        const bf16* Kc = Z + ZC_KA + hk * 64; const bf16* Vc = Z + ZC_VA + hk * 64;
        if (lat) {
            const int p0 = qrow0; int klo = p0 - 128; if (klo < 0) klo = 0; int khi = p0 + 160; if (khi > SEQ) khi = SEQ;
            for (int k0 = klo; k0 < khi; k0 += 32) { ScoreWin sf{k0 - p0}; attn_keytile(st, qf, Kc + (size_t)k0 * ZC, Vc + (size_t)k0 * ZC, wlds, lane, sf); }
        }
        for (int j = 0; j < 8; ++j) { ScorePlain sf; const size_t kr = (size_t)(SEQ + 32 * j) * ZC; attn_keytile(st, qf, Kc + kr, Vc + kr, wlds, lane, sf); }
        float lsum = st.l + __shfl_xor(st.l, 32);
        lsum += __builtin_amdgcn_exp2f(F.ka->in[I_ASINK][l * 8 + hq] * LOG2E - st.m);
        attn_store(st, 1.0f / lsum, BR + (size_t)qrow0 * DM + hq * 64, lane);
    } else {
        load_q(qf, Z + (size_t)qrow0 * ZC + ZC_QB + hq * 64, lane);
        const bf16* Kc = Z + ZC_KB + hq * 64; const bf16* Vc = Z + ZC_VB + hq * 64;
        if (lat) {
            LAS float* tab = (LAS float*)(wlds + 32 * VPITCH);
            const float* bsrc = F.ka->in[I_NBBIAS] + (size_t)(l * 8 + hq) * 465;
            for (int i = lane; i < 465; i += 64) tab[i] = bsrc[i];
            asm volatile("s_waitcnt lgkmcnt(0)" ::: "memory");
            const int gr = qt >> 1, cq0 = (qt & 1) * 32; int kr0 = gr - 4; kr0 = kr0 < 0 ? 0 : (kr0 > 120 ? 120 : kr0);
            for (int i = 0; i < 8; ++i) { const int kr = kr0 + i;
#pragma unroll 1
                for (int c = 0; c < 2; ++c) { const int kc0 = c ? (cq0 ^ 32) : cq0; ScoreNb sf{tab, kc0, cq0, kr - gr + 7};
                    const size_t ko = (size_t)(kr * GRIDW + kc0) * ZC; attn_keytile(st, qf, Kc + ko, Vc + ko, wlds, lane, sf); } }
        }
        for (int j = 0; j < 8; ++j) { ScorePlain sf; const size_t kr = (size_t)(SEQ + 32 * j) * ZC; attn_keytile(st, qf, Kc + kr, Vc + kr, wlds, lane, sf); }
        const float lsum = st.l + __shfl_xor(st.l, 32);
        attn_store(st, 1.0f / lsum, BR + (size_t)qrow0 * DM + 512 + hq * 64, lane);
    }
}

__device__ __forceinline__ void dconv_phase(Frame& F, int l, int nrows) {
    const int gt = blockIdx.x * (NWAVES * 64) + F.tid, NGT = F.G * NWAVES * 64;
    const bf16* Z = (const bf16*)(F.ws + WS_Z); bf16* BR = (bf16*)(F.ws + WS_BR);
    const float* w = F.ka->in[I_DCONVW] + (size_t)l * 3 * 512;
    for (int it = gt; it < nrows * 64; it += NGT) {
        const int row = it >> 6, c0 = (it & 63) * 8;
        const int lo = row < SEQ ? 0 : SEQ, hi = row < SEQ ? SEQ : MT;
        float acc[8];
#pragma unroll
        for (int e = 0; e < 8; ++e) acc[e] = 0.f;
#pragma unroll
        for (int j = 0; j < 3; ++j) { const int rr = row + j - 1;
            if (rr >= lo && rr < hi) { const v4u cd = *(const v4u*)(Z + (size_t)rr * ZC + ZC_CD + c0), xd = *(const v4u*)(Z + (size_t)rr * ZC + ZC_XD + c0);
                const f32x4 w0 = *(const f32x4*)(w + j * 512 + c0), w1 = *(const f32x4*)(w + j * 512 + c0 + 4);
#pragma unroll
                for (int e = 0; e < 4; ++e) { acc[2 * e] += (e < 2 ? w0[2 * e] : w1[2 * e - 4]) * (bflo(cd[e]) * bflo(xd[e])); acc[2 * e + 1] += (e < 2 ? w0[2 * e + 1] : w1[2 * e - 3]) * (bfhi(cd[e]) * bfhi(xd[e])); } } }
        const v4u bd = *(const v4u*)(Z + (size_t)row * ZC + ZC_BD + c0);
        v4u o;
#pragma unroll
        for (int e = 0; e < 4; ++e) o[e] = pk2(acc[2 * e] * bflo(bd[e]), acc[2 * e + 1] * bfhi(bd[e]));
        *(v4u*)(BR + (size_t)row * DM + 1536 + c0) = o;
    }
}

__device__ __forceinline__ float gelu_tanh(float x) { const float z = 0.7978845608028654f * (x + 0.044715f * x * x * x); const float e = __expf(2.0f * z); return 0.5f * x * (1.0f + (1.0f - 2.0f * __builtin_amdgcn_rcpf(e + 1.0f))); }
constexpr int UB_PITCH = 1040;
__device__ __forceinline__ void scan_gate_item(Frame& F, int l, int c) {
    const bf16* Z = (const bf16*)(F.ws + WS_Z);
    float* AB = (float*)(F.ws + WS_AB);
    float* PS = (float*)(F.ws + WS_PS);
    LAS float* U32 = (LAS float*)F.lds;
    LAS unsigned char* Ub = F.lds + 65536;
    const int row_c = 64 * c;
    const int lo = row_c < SEQ ? 0 : SEQ, hi = row_c < SEQ ? SEQ : MT;
    const int lane = F.lane, r = lane & 31, h = lane >> 5;
    for (int sub = 0; sub < 2; ++sub) {
        const int row0 = row_c + 32 * sub;
        {
            const int ch = F.tid;
            const float* cw = F.ka->in[I_CCONVW] + (size_t)l * 4 * 512; const float w0 = cw[ch], w1 = cw[512 + ch], w2 = cw[1024 + ch], w3 = cw[1536 + ch], cb = F.ka->in[I_CCONVB][l * 512 + ch];
            const bf16* xp = Z + ZC_XR + ch;
            float xm2 = (row0 - 2 >= lo) ? bf1(xp[(size_t)(row0 - 2) * ZC]) : 0.f, xm1 = (row0 - 1 >= lo) ? bf1(xp[(size_t)(row0 - 1) * ZC]) : 0.f, x0 = bf1(xp[(size_t)row0 * ZC]);
#pragma unroll 4
            for (int tt = 0; tt < 32; ++tt) { const int rp = row0 + tt + 1; const float xp1 = (rp < hi) ? bf1(xp[(size_t)rp * ZC]) : 0.f;
                const float u = cb + w0 * xm2 + w1 * xm1 + w2 * x0 + w3 * xp1;
                U32[tt * 512 + ch] = u; *(LAS bf16*)(Ub + tt * UB_PITCH + ch * 2) = (bf16)f2bf(u);
                xm2 = xm1; xm1 = x0; x0 = xp1; }
        }
        __syncthreads();
        {
            const int dir = F.wave >> 2, n = F.wave & 3;
            bf16x8 af[8];
#pragma unroll
            for (int kk = 0; kk < 8; ++kk) af[kk] = *(const LAS bf16x8*)(Ub + r * UB_PITCH + (n * 128 + 16 * kk + 8 * h) * 2);
            const bf16* GWa = (const bf16*)(F.ws + WS_GW) + (size_t)((((l * 2 + dir) * 2 + 0) * 4 + n)) * 16384;
            const bf16* GWx = GWa + (size_t)4 * 16384;
            float* Ao = AB + ((size_t)(dir * 2 + 0) * MT + row0) * 512; float* Bo = AB + ((size_t)(dir * 2 + 1) * MT + row0) * 512;
#pragma unroll 1
            for (int g = 0; g < 4; ++g) {
                f32x16 pa, px;
#pragma unroll
                for (int i = 0; i < 16; ++i) { pa[i] = 0.f; px[i] = 0.f; }
                const bf16* wa = GWa + (size_t)(32 * g + r) * 128 + 8 * h; const bf16* wx = GWx + (size_t)(32 * g + r) * 128 + 8 * h;
#pragma unroll
                for (int kk = 0; kk < 8; ++kk) { pa = MFMA32(af[kk], *(const bf16x8*)(wa + 16 * kk), pa); px = MFMA32(af[kk], *(const bf16x8*)(wx + 16 * kk), px); }
                const int ch = n * 128 + 32 * g + r, pidx = (l * 2 + dir) * 512 + ch;
                const float ba = F.ka->in[I_CBA][pidx], bx = F.ka->in[I_CBX][pidx], lam = F.ka->in[I_CLAM][pidx];
                const float sp = log1pf(__expf(-lam));
#pragma unroll
                for (int i = 0; i < 16; ++i) { const int tt = crow(i, h);
                    const float rr = sigm(pa[i] + ba), ii = sigm(px[i] + bx), la = -8.0f * rr * sp;
                    const float a = __expf(la), b = sqrtf(-expm1f(2.0f * la)) * (ii * U32[tt * 512 + ch]);
                    Ao[(size_t)tt * 512 + ch] = a; Bo[(size_t)tt * 512 + ch] = b; }
            }
        }
        asm volatile("s_waitcnt vmcnt(0)" ::: "memory");
        __syncthreads();
    }
    {
        const int ch = F.tid;
        const float* Af = AB + ((size_t)0 * MT + row_c) * 512 + ch; const float* Bf = AB + ((size_t)1 * MT + row_c) * 512 + ch;
        const float* Abk = AB + ((size_t)2 * MT + row_c) * 512 + ch; const float* Bbk = AB + ((size_t)3 * MT + row_c) * 512 + ch;
        float P = 1.f, S = 0.f;
#pragma unroll 8
        for (int t = 0; t < 64; ++t) { const float a = Af[(size_t)t * 512], b = Bf[(size_t)t * 512]; S = a * S + b; P *= a; }
        PS[((size_t)(0 * 132 + c) * 512 + ch) * 2] = P; PS[((size_t)(0 * 132 + c) * 512 + ch) * 2 + 1] = S;
        P = 1.f; S = 0.f;
#pragma unroll 8
        for (int t = 63; t >= 0; --t) { const float a = Abk[(size_t)t * 512], b = Bbk[(size_t)t * 512]; S = a * S + b; P *= a; }
        PS[((size_t)(1 * 132 + c) * 512 + ch) * 2] = P; PS[((size_t)(1 * 132 + c) * 512 + ch) * 2 + 1] = S;
    }
    __syncthreads();
}
__device__ __forceinline__ void scan_final_item(Frame& F, int c) {
    const bf16* Z = (const bf16*)(F.ws + WS_Z); bf16* BR = (bf16*)(F.ws + WS_BR);
    const float* AB = (const float*)(F.ws + WS_AB); const float* PS = (const float*)(F.ws + WS_PS);
    LAS float* HF = (LAS float*)F.lds;
    const int ch = F.tid, row_c = 64 * c;
    float hf = 0.f, hb = 0.f;
    { const int nbefore = c >= 128 ? c - 128 : c + 4;
      for (int k = 0; k < nbefore; ++k) { const int cc = k < 4 ? 128 + k : k - 4; const float2 ps = *(const float2*)(PS + ((size_t)(0 * 132 + cc) * 512 + ch) * 2); hf = ps.x * hf + ps.y; } }
    { const int nbefore = c >= 128 ? 131 - c : 4 + (127 - c);
      for (int k = 0; k < nbefore; ++k) { const int cc = k < 4 ? 131 - k : 127 - (k - 4); const float2 ps = *(const float2*)(PS + ((size_t)(1 * 132 + cc) * 512 + ch) * 2); hb = ps.x * hb + ps.y; } }
    const float* Af = AB + ((size_t)0 * MT + row_c) * 512 + ch; const float* Bf = AB + ((size_t)1 * MT + row_c) * 512 + ch;
    const float* Abk = AB + ((size_t)2 * MT + row_c) * 512 + ch; const float* Bbk = AB + ((size_t)3 * MT + row_c) * 512 + ch;
#pragma unroll 8
    for (int t = 0; t < 64; ++t) { hf = Af[(size_t)t * 512] * hf + Bf[(size_t)t * 512]; HF[t * 512 + ch] = hf; }
#pragma unroll 8
    for (int t = 63; t >= 0; --t) { hb = Abk[(size_t)t * 512] * hb + Bbk[(size_t)t * 512];
        const float gr = bf1(Z[(size_t)(row_c + t) * ZC + ZC_GR + ch]);
        BR[(size_t)(row_c + t) * DM + 1024 + ch] = (bf16)f2bf((HF[t * 512 + ch] + hb) * gelu_tanh(gr)); }
}

__global__ void __launch_bounds__(NWAVES * 64, 2) mk_fwd(Args args) {
    extern __shared__ __attribute__((aligned(16))) unsigned char lds[];
    Frame F;
    F.lds = (LAS unsigned char*)lds;
    F.MISC = (volatile LAS unsigned*)(F.lds + MISC_OFF);
    F.tid = threadIdx.x; F.lane = F.tid & 63; F.wave = __builtin_amdgcn_readfirstlane(F.tid >> 6);
    F.G = gridDim.x;
    F.ka = (const KAS Args*)__builtin_amdgcn_kernarg_segment_ptr();
    F.out = args.out; F.ws = args.ws;
    F.ctl = (gu32*)(F.ws + WS_CTL);
    for (int u = F.tid; u < (LDS_BYTES - LDSCTL_OFF) / 4; u += NWAVES * 64) ((LAS unsigned*)(F.lds + LDSCTL_OFF))[u] = 0u;
    __syncthreads();
#if MK_ONE_LAUNCH
    XcdBarrier bar = xcd_barrier_post((unsigned*)(F.ctl + CW_BAR), F.MISC + 8);
#define GRID_BAR() xcd_barrier(bar)
#else
#define GRID_BAR() do { } while (0)
#endif
    const int lo = args.ph_lo, hi = args.ph_hi;
#define IN(k) (lo <= (k) && (k) < hi)
#ifndef PHMASK
#define PHMASK 0x7ff
#endif
#define PHON(b) (((PHMASK) >> (b)) & 1)
#define FRESH() do { int t_ = threadIdx.x; asm volatile("" : "+v"(t_)); F.tid = t_; F.lane = t_ & 63; } while (0)
#define SEAM(k) do { if (IN(k) && IN((k) + 1)) GRID_BAR(); } while (0)

    if (PHON(0) && IN(0)) { FRESH(); p0_prologue(F); }
    SEAM(0);

    for (int l = 0; l < DEPTH; ++l) {
        const int pb = 1 + l * NPL;
        const bool last = (l == DEPTH - 1);
        const int Mg = last ? SEQ : MT;
        unsigned char* wl = F.ws + WS_W + (size_t)l * WL_STRIDE;
        const float* modl = (const float*)(F.ws + WS_MOD) + (size_t)(l * 2) * NMOD; const float* modc = modl + NMOD;

        if (PHON(1) && IN(pb + 0)) { FRESH(); norm_phase(F, l, 0, MT); }
        SEAM(pb + 0);

        if (PHON(2) && IN(pb + 1)) {
            pg8::Gemm g{(const pg8::bf16_t*)(F.ws + WS_H), (const pg8::bf16_t*)(wl + WL_IN), MT, INC, DM}; pg8::StaticOrder S; S.init(MT, INC, F.G, (int)blockIdx.x);
            pg8::EpiIn E{(pg8::bf16_t*)(F.ws + WS_Z), (pg8::bf16_t*)(F.ws + WS_G), F.ka->in[I_BGATE] + (size_t)l * GC, (const float*)(F.ws + WS_ROPE), (const float*)(F.ws + WS_ROPE) + 2048};
            pg8::gemm_phase<pg8::EpiIn, pg8::StaticOrder, true, true>(F.lds, g, S, E);
        }
        SEAM(pb + 1);

        if (PHON(3) && IN(pb + 2)) {
            FRESH(); __syncthreads();
#ifndef MIXMASK
#define MIXMASK 15
#endif
            if (MIXMASK & 1) for (int c = blockIdx.x; c < 132; c += F.G) scan_gate_item(F, l, c);
            FRESH();
            __syncthreads();
            const int nqt = last ? 256 : 264, nitems = 2 * nqt * 8;
            const int gw = blockIdx.x * NWAVES + F.wave, NGW = F.G * NWAVES;
            LAS unsigned char* wlds = F.lds + F.wave * ATT_WAVE_LDS;
            for (int it = gw; it < nitems; it += NGW) { const bool isb = it >= nqt * 8; if ((MIXMASK & 2) && !isb) attn_item(F, l, it, nqt, wlds); if ((MIXMASK & 4) && isb) attn_item(F, l, it, nqt, wlds); }
            FRESH(); if (MIXMASK & 8) dconv_phase(F, l, last ? SEQ : MT);
        }
        SEAM(pb + 2);

        if (PHON(4) && IN(pb + 3)) {
            FRESH(); __syncthreads();
            const int nch = last ? 128 : 132;
            for (int c = blockIdx.x; c < nch; c += F.G) { scan_final_item(F, c); __syncthreads(); }
        }
        SEAM(pb + 3);

        if (PHON(5) && IN(pb + 4)) {
            __syncthreads();
            pg8::Gemm g{(const pg8::bf16_t*)(F.ws + WS_BR), (const pg8::bf16_t*)(wl + WL_BR), Mg, DM, DM}; pg8::StaticOrder S; S.init(Mg, DM, F.G, (int)blockIdx.x);
            pg8::EpiMerge E{(const pg8::bf16_t*)(F.ws + WS_G), (pg8::bf16_t*)(F.ws + WS_MG)};
            pg8::gemm_phase<pg8::EpiMerge, pg8::StaticOrder, true, true>(F.lds, g, S, E);
        }
        SEAM(pb + 4);

        if (PHON(6) && IN(pb + 5)) {
            pg8::Gemm g{(const pg8::bf16_t*)(F.ws + WS_MG), (const pg8::bf16_t*)(wl + WL_OUT), Mg, DM, DM}; pg8::StaticOrder S; S.init(Mg, DM, F.G, (int)blockIdx.x);
            pg8::EpiResid E{F.out, (float*)(F.ws + WS_XC), modl + 2 * DM, modc + 2 * DM};
            pg8::gemm_phase<pg8::EpiResid, pg8::StaticOrder, true, true>(F.lds, g, S, E);
        }
        SEAM(pb + 5);

        if (PHON(7) && IN(pb + 6)) { FRESH(); norm_phase(F, l, 1, Mg); }
        SEAM(pb + 6);

        if (PHON(8) && IN(pb + 7)) {
            pg8::Gemm g{(const pg8::bf16_t*)(F.ws + WS_H), (const pg8::bf16_t*)(wl + WL_F1), Mg, F2, DM}; pg8::StaticOrder S; S.init(Mg, F2, F.G, (int)blockIdx.x);
            pg8::EpiSwiglu E{(pg8::bf16_t*)(F.ws + WS_FH)};
            pg8::gemm_phase<pg8::EpiSwiglu, pg8::StaticOrder, true, true>(F.lds, g, S, E);
        }
        SEAM(pb + 7);

        if (PHON(9) && IN(pb + 8)) {
            pg8::Gemm g{(const pg8::bf16_t*)(F.ws + WS_FH), (const pg8::bf16_t*)(wl + WL_F2), Mg, DM, FHID}; pg8::StaticOrder S; S.init(Mg, DM, F.G, (int)blockIdx.x);
            pg8::EpiResid E{F.out, (float*)(F.ws + WS_XC), modl + 5 * DM, modc + 5 * DM};
            pg8::gemm_phase<pg8::EpiResid, pg8::StaticOrder, true, true>(F.lds, g, S, E);
        }
        SEAM(pb + 8);
    }

    if (PHON(10) && IN(N_PHASES - 1)) { FRESH(); final_norm_phase(F); }
#undef IN
#undef SEAM
}

extern "C" void kernel_launch(void* const* d_in, const int* in_sizes, int n_in, void* d_out, int out_size, void* d_ws, size_t ws_size, hipStream_t stream) {
    static int grid = 0;
    if (grid == 0) {
        if (n_in != 25 || out_size != SEQ * DM || ws_size < WS_END) { fprintf(stderr, "kernel_launch: unexpected problem (n_in %d, out %d, ws %zu, need %zu)\n", n_in, out_size, ws_size, (size_t)WS_END); grid = -1; return; }
        int dev = 0, cus = 0, per_cu = 0;
        if (hipGetDevice(&dev) != hipSuccess || hipDeviceGetAttribute(&cus, hipDeviceAttributeMultiprocessorCount, dev) != hipSuccess) { grid = -1; return; }
        if (hipFuncSetAttribute((const void*)mk_fwd, hipFuncAttributeMaxDynamicSharedMemorySize, LDS_BYTES) != hipSuccess) { fprintf(stderr, "kernel_launch: hipFuncSetAttribute failed\n"); grid = -1; return; }
        if (hipOccupancyMaxActiveBlocksPerMultiprocessor(&per_cu, (const void*)mk_fwd, NWAVES * 64, LDS_BYTES) != hipSuccess || per_cu < 1) fprintf(stderr, "kernel_launch: occupancy query reports %d\n", per_cu);
        (void)hipGetLastError();
        grid = cus;
    }
    if (grid < 0) return;
    (void)hipMemsetAsync((char*)d_ws + WS_CTL, 0, CTL_ZERO_BYTES, stream);
    Args a{};
    for (int i = 0; i < 25; ++i) a.in[i] = (const float*)d_in[i];
    a.out = (float*)d_out; a.ws = (unsigned char*)d_ws;
#if MK_ONE_LAUNCH
    a.ph_lo = 0; a.ph_hi = N_PHASES;
    hipLaunchKernelGGL(mk_fwd, dim3(grid), dim3(NWAVES * 64), LDS_BYTES, stream, a);
#else
    for (int p = 0; p < N_PHASES; ++p) { a.ph_lo = p; a.ph_hi = p + 1; hipLaunchKernelGGL(mk_fwd, dim3(grid), dim3(NWAVES * 64), LDS_BYTES, stream, a); }
#endif
}
```

```cpp
#include <hip/hip_runtime.h>
#include <cstdio>
#include <cstdint>
namespace pg8 {
#define PG8_LAS __attribute__((address_space(3)))
typedef unsigned short bf16_t;
typedef short bf16x8 __attribute__((ext_vector_type(8)));
typedef float f32x4 __attribute__((ext_vector_type(4)));
typedef unsigned u32x4 __attribute__((ext_vector_type(4)));
constexpr int BM = 256, BK = 64, HALF = 128, HTB = HALF * BK * 2  , STAGE_BYTES = 8 * HTB, NXCD = 8, WGM = 8;

__host__ __device__ __forceinline__ int lds_byte(int r, int c) { const int st = (r >> 4) * 2 + (c >> 5), rr = r & 15, cc = c & 31, ob = rr * 64 + cc * 2; return st * 1024 + (ob ^ (((ob >> 9) & 1) << 5)); }
__host__ __device__ __forceinline__ void stage_rc(int b, int& R, int& C) { const int st = b / 1024, sb = b % 1024, swz = sb ^ (((sb >> 9) & 1) << 5); R = (st >> 1) * 16 + swz / 64; C = (st & 1) * 32 + (swz % 64) / 2; }
__host__ __device__ __forceinline__ int perm32(int rho) { const int n = rho >> 4, i = rho & 15; return 8 * (i >> 2) + 4 * n + (i & 3); }

struct Unit { int pm, pn, ko; };
struct Gemm { const bf16_t* A; const bf16_t* Bt; int M, N, K, ld; };

struct StaticOrder {
    int nM, nN, nwg, G, c;
    __host__ __device__ void init(int M, int N, int G_, int c_) { nM = M / BM; nN = N / BM; nwg = nM * nN; G = G_; c = c_; }
    __host__ __device__ bool next(int i, Unit& u) const {
        const long L = (long)i * G + c; if (L >= nwg) return false;
        int wgid = (int)L; { const int q = nwg / NXCD, r = nwg % NXCD, xcd = wgid % NXCD, off = wgid / NXCD; wgid = (xcd < r ? xcd * (q + 1) : r * (q + 1) + (xcd - r) * q) + off; }
        const int nig = WGM * nN, gid = wgid / nig, fm = gid * WGM, gsz = (nM - fm) < WGM ? (nM - fm) : WGM;
        u.pm = fm + ((wgid % nig) % gsz); u.pn = (wgid % nig) / gsz; u.ko = 0; return true;
    }
    __device__ __forceinline__ void a_ready(const Unit&) const {}
    __device__ __forceinline__ void done(const Unit&) const {}
};
typedef float f32x2 __attribute__((ext_vector_type(2)));
typedef __bf16 bf16x2_t __attribute__((ext_vector_type(2)));
__device__ __forceinline__ unsigned cvt_pk_bf16(float lo, float hi) { f32x2 v = {lo, hi}; bf16x2_t b = __builtin_convertvector(v, bf16x2_t); return __builtin_bit_cast(unsigned, b); }
__device__ __forceinline__ float sigmoidf_fast(float x) { return __builtin_amdgcn_rcpf(1.0f + __expf(-x)); }
__device__ __forceinline__ float bf2f(unsigned short b) { return __uint_as_float(((unsigned)b) << 16); }

struct EpiIn {
    static constexpr bool PERM = true, AFTER_DRAIN = false, HAS_MID = false;
    bf16_t* Z; bf16_t* G; const float* bgate; const float* ropec; const float* ropes;
    __device__ __forceinline__ void operator()(const f32x4 (&acc)[2][2][4][2], const Unit& u, int wr, int wc, int fr, int fq) const {
        const int row0 = u.pm * BM + wr * 64 + fr;
        if (u.pn >= 19) {
            const int col0 = (u.pn - 19) * BM + wc * 32 + 8 * fq;
            f32x4 bv[2][2];
#pragma unroll
            for (int bj = 0; bj < 2; ++bj)
#pragma unroll
                for (int n = 0; n < 2; ++n) bv[bj][n] = *(const f32x4*)(bgate + col0 + bj * HALF + 4 * n);
#pragma unroll
            for (int ai = 0; ai < 2; ++ai)
#pragma unroll
                for (int m = 0; m < 4; ++m) { bf16_t* rowp = G + (size_t)(row0 + ai * HALF + m * 16) * 8192 + col0;
#pragma unroll
                    for (int bj = 0; bj < 2; ++bj) { const f32x4 v0 = acc[ai][bj][m][0] + bv[bj][0], v1 = acc[ai][bj][m][1] + bv[bj][1];
                        u32x4 w; w.x = cvt_pk_bf16(sigmoidf_fast(v0[0]), sigmoidf_fast(v0[1])); w.y = cvt_pk_bf16(sigmoidf_fast(v0[2]), sigmoidf_fast(v0[3]));
                        w.z = cvt_pk_bf16(sigmoidf_fast(v1[0]), sigmoidf_fast(v1[1])); w.w = cvt_pk_bf16(sigmoidf_fast(v1[2]), sigmoidf_fast(v1[3]));
                        *(u32x4*)(rowp + bj * HALF) = w; } }
        } else {
            const int colt = u.pn * BM, col0 = colt + wc * 32 + 8 * fq;
            const bool rope_tile = (u.pn <= 2) && (u.pm < 32);
#pragma unroll
            for (int ai = 0; ai < 2; ++ai)
#pragma unroll
                for (int m = 0; m < 4; ++m) { const int t = row0 + ai * HALF + m * 16; bf16_t* rowp = Z + (size_t)t * 4864 + col0;
#pragma unroll
                    for (int bj = 0; bj < 2; ++bj) { f32x4 v0 = acc[ai][bj][m][0], v1 = acc[ai][bj][m][1];
                        if (rope_tile && (colt + bj * HALF < 640)) {
                            const int pos = (wc & 1) ? (t & 63) : (t >> 6);
                            const float* cp = ropec + pos * 16 + 8 * (fq & 1); const float* sp = ropes + pos * 16 + 8 * (fq & 1);
                            const f32x4 c0 = *(const f32x4*)cp, c1 = *(const f32x4*)(cp + 4), s0 = *(const f32x4*)sp, s1 = *(const f32x4*)(sp + 4);
                            f32x4 p0, p1;
#pragma unroll
                            for (int e = 0; e < 4; ++e) { p0[e] = __shfl_xor(v0[e], 32); p1[e] = __shfl_xor(v1[e], 32); }
                            if (fq < 2) { v0 = v0 * c0 - p0 * s0; v1 = v1 * c1 - p1 * s1; }
                            else        { v0 = p0 * s0 + v0 * c0; v1 = p1 * s1 + v1 * c1; }
                        }
                        u32x4 w; w.x = cvt_pk_bf16(v0[0], v0[1]); w.y = cvt_pk_bf16(v0[2], v0[3]); w.z = cvt_pk_bf16(v1[0], v1[1]); w.w = cvt_pk_bf16(v1[2], v1[3]);
                        *(u32x4*)(rowp + bj * HALF) = w; } }
        }
    }
};

struct EpiMerge {
    static constexpr bool PERM = true, AFTER_DRAIN = false, HAS_MID = true;
    const bf16_t* G; bf16_t* O;
    __device__ __forceinline__ void mid(f32x4 (&acc)[2][2][4][2], const Unit& u, int seg, int wr, int wc, int fr, int fq) const {
        int row0 = u.pm * BM + wr * 64 + fr; asm volatile("" : "+v"(row0));
        const int col0 = u.pn * BM + wc * 32 + 8 * fq;
#pragma unroll
        for (int ai = 0; ai < 2; ++ai)
#pragma unroll
            for (int m = 0; m < 4; ++m) { const bf16_t* rowp = G + (size_t)(row0 + ai * HALF + m * 16) * 8192 + col0 + seg * 2048;
#pragma unroll
                for (int bj = 0; bj < 2; ++bj) { const u32x4 ga = *(const u32x4*)(rowp + bj * HALF), gb = *(const u32x4*)(rowp + 2048 + bj * HALF);
#pragma unroll
                    for (int e = 0; e < 4; ++e) { const unsigned a = ga[e], b = gb[e];
                        const float a0 = fmaxf(__uint_as_float(a << 16), 1e-30f), a1 = fmaxf(__uint_as_float(a & 0xffff0000u), 1e-30f);
                        const float b0 = fmaxf(__uint_as_float(b << 16), 1e-30f), b1 = fmaxf(__uint_as_float(b & 0xffff0000u), 1e-30f);
                        acc[ai][bj][m][e >> 1][(e & 1) * 2]     *= a0 * __builtin_amdgcn_rcpf(b0);
                        acc[ai][bj][m][e >> 1][(e & 1) * 2 + 1] *= a1 * __builtin_amdgcn_rcpf(b1); } }
                asm volatile("" ::: "memory"); }
    }
    __device__ __forceinline__ void operator()(const f32x4 (&acc)[2][2][4][2], const Unit& u, int wr, int wc, int fr, int fq) const {
        const int row0 = u.pm * BM + wr * 64 + fr, col0 = u.pn * BM + wc * 32 + 8 * fq;
#pragma unroll
        for (int ai = 0; ai < 2; ++ai)
#pragma unroll
            for (int m = 0; m < 4; ++m) { const size_t r = (size_t)(row0 + ai * HALF + m * 16); const bf16_t* gp = G + r * 8192 + col0 + 3 * 2048; bf16_t* op = O + r * 2048 + col0;
#pragma unroll
                for (int bj = 0; bj < 2; ++bj) { const u32x4 g = *(const u32x4*)(gp + bj * HALF); float gv[8];
#pragma unroll
                    for (int e = 0; e < 4; ++e) { gv[2 * e] = fmaxf(__uint_as_float(g[e] << 16), 1e-30f); gv[2 * e + 1] = fmaxf(__uint_as_float(g[e] & 0xffff0000u), 1e-30f); }
                    const f32x4 v0 = acc[ai][bj][m][0], v1 = acc[ai][bj][m][1];
                    u32x4 w; w.x = cvt_pk_bf16(v0[0] * gv[0], v0[1] * gv[1]); w.y = cvt_pk_bf16(v0[2] * gv[2], v0[3] * gv[3]); w.z = cvt_pk_bf16(v1[0] * gv[4], v1[1] * gv[5]); w.w = cvt_pk_bf16(v1[2] * gv[6], v1[3] * gv[7]);
                    *(u32x4*)(op + bj * HALF) = w; }
                asm volatile("" ::: "memory"); }
    }
};

struct EpiResid {
    static constexpr bool PERM = false, AFTER_DRAIN = false, HAS_MID = false;
    float* xl; float* xc; const float* gate_l; const float* gate_c;
    __device__ __forceinline__ void operator()(const f32x4 (&acc)[2][2][4][2], const Unit& u, int wr, int wc, int fr, int fq) const {
        const int row0 = u.pm * BM + wr * 64 + fr, col0 = u.pn * BM + wc * 32 + 4 * fq;
        const bool lat = u.pm < 32;
        float* X = lat ? xl : (xc - (size_t)8192 * 2048); const float* gate = lat ? gate_l : gate_c;
        f32x4 gv[2][2];
#pragma unroll
        for (int bj = 0; bj < 2; ++bj)
#pragma unroll
            for (int n = 0; n < 2; ++n) gv[bj][n] = *(const f32x4*)(gate + col0 + bj * HALF + n * 16);
#pragma unroll
        for (int ai = 0; ai < 2; ++ai)
#pragma unroll
            for (int m = 0; m < 4; ++m) { float* rowp = X + (size_t)(row0 + ai * HALF + m * 16) * 2048 + col0;
#pragma unroll
                for (int bj = 0; bj < 2; ++bj)
#pragma unroll
                    for (int n = 0; n < 2; ++n) { f32x4* q = (f32x4*)(rowp + bj * HALF + n * 16); *q = *q + gv[bj][n] * acc[ai][bj][m][n]; }
                if (m & 1) asm volatile("" ::: "memory"); }
    }
};

struct EpiSwiglu {
    static constexpr bool PERM = true, AFTER_DRAIN = false, HAS_MID = false;
    bf16_t* O;
    __device__ __forceinline__ void operator()(const f32x4 (&acc)[2][2][4][2], const Unit& u, int wr, int wc, int fr, int fq) const {
        const int row0 = u.pm * BM + wr * 64 + fr, col0 = u.pn * HALF + wc * 32 + 8 * fq;
#pragma unroll
        for (int ai = 0; ai < 2; ++ai)
#pragma unroll
            for (int m = 0; m < 4; ++m) { bf16_t* op = O + (size_t)(row0 + ai * HALF + m * 16) * 5632 + col0; float o[8];
#pragma unroll
                for (int n = 0; n < 2; ++n)
#pragma unroll
                    for (int e = 0; e < 4; ++e) { const float g = acc[ai][0][m][n][e], uu = acc[ai][1][m][n][e]; o[4 * n + e] = g * sigmoidf_fast(g) * uu; }
                u32x4 w; w.x = cvt_pk_bf16(o[0], o[1]); w.y = cvt_pk_bf16(o[2], o[3]); w.z = cvt_pk_bf16(o[4], o[5]); w.w = cvt_pk_bf16(o[6], o[7]);
                *(u32x4*)op = w; }
    }
};


struct SplitKOrder {
    int pm, nN, S, ksub, G, c;
    __host__ __device__ bool next(int i, Unit& u) const { const int L = i * G + (G - 1 - c); if (L >= nN * S) return false; u.pm = pm; u.pn = L % nN; u.ko = (L / nN) * ksub; return true; }
    __device__ __forceinline__ void a_ready(const Unit&) const {}
    __device__ __forceinline__ void done(const Unit&) const {}
};
struct EpiSlab {
    static constexpr bool PERM = false, AFTER_DRAIN = false, HAS_MID = false;
    float* slab; int ksub;
    __device__ __forceinline__ void operator()(const f32x4 (&acc)[2][2][4][2], const Unit& u, int wr, int wc, int fr, int fq) const {
        const int row0 = wr * 64 + fr, col0 = u.pn * BM + wc * 32 + 4 * fq;
        float* base = slab + (size_t)(u.ko / ksub) * 256 * 2048;
#pragma unroll
        for (int ai = 0; ai < 2; ++ai)
#pragma unroll
            for (int m = 0; m < 4; ++m) { float* rowp = base + (size_t)(row0 + ai * HALF + m * 16) * 2048 + col0;
#pragma unroll
                for (int bj = 0; bj < 2; ++bj)
#pragma unroll
                    for (int n = 0; n < 2; ++n) *(f32x4*)(rowp + bj * HALF + n * 16) = acc[ai][bj][m][n]; }
    }
};
template <class Epi, class Sched, bool ALIGN_EPI = false, bool SP2 = false>
__device__ __forceinline__ void gemm_phase(PG8_LAS unsigned char* lds, const Gemm g, const Sched& S, const Epi& E) {
    int tid_ = threadIdx.x; asm volatile("" : "+v"(tid_));
    const int tid = tid_, wid = __builtin_amdgcn_readfirstlane(tid >> 6), lane = tid & 63, wr = wid >> 2, wc = wid & 3, fr = lane & 15, fq = lane >> 4;
    const int K = g.ld, nt = g.K / BK;
    unsigned voffA[2], voffB[2];
#pragma unroll
    for (int i = 0; i < 2; ++i) { int R, C; stage_rc(tid * 16 + i * 8192, R, C); const int Rb = Epi::PERM ? ((R & ~31) + perm32(R & 31)) : R;
        voffA[i] = (unsigned)(R * K + C) * 2u; voffB[i] = (unsigned)(Rb * K + C) * 2u; }
    const size_t kstep = (size_t)(BK * 2);
    const size_t hstep = (size_t)HALF * K * 2;
    const size_t tstep = 2 * hstep;
    const unsigned ldsw = (unsigned)wid * 1024u;
    const int aoff = lds_byte(wr * 64 + fr, fq * 8), boff = lds_byte(wc * 32 + fr, fq * 8);
#define PG8_SA(b, h) (((b) * 2 + (h)) * HTB)
#define PG8_SB(b, h) ((4 + (b) * 2 + (h)) * HTB)
#define PG8_STAGE(bufoff, gbase, voff) do { _Pragma("unroll") for (int _i = 0; _i < 2; ++_i) \
        __builtin_amdgcn_global_load_lds((const unsigned*)((const char*)(gbase) + (voff)[_i]), (PG8_LAS unsigned*)(lds + (bufoff) + ldsw + _i * 8192), 16, 0, 0); } while (0)
#define PG8_LDA(dst, b, h) do { _Pragma("unroll") for (int m = 0; m < 4; ++m) _Pragma("unroll") for (int k = 0; k < 2; ++k) dst[m][k] = *(const PG8_LAS bf16x8*)(lds + PG8_SA(b, h) + aoff + m * 2048 + k * 1024); } while (0)
#define PG8_LDB(dst, b, h) do { _Pragma("unroll") for (int n = 0; n < 2; ++n) _Pragma("unroll") for (int k = 0; k < 2; ++k) dst[n][k] = *(const PG8_LAS bf16x8*)(lds + PG8_SB(b, h) + boff + n * 2048 + k * 1024); } while (0)
#define PG8_MMA(ai, bj, At, Bt) do { __builtin_amdgcn_s_setprio(1); _Pragma("unroll") for (int m = 0; m < 4; ++m) _Pragma("unroll") for (int n = 0; n < 2; ++n) _Pragma("unroll") for (int k = 0; k < 2; ++k) \
        acc[ai][bj][m][n] = __builtin_amdgcn_mfma_f32_16x16x32_bf16(Bt[n][k], At[m][k], acc[ai][bj][m][n], 0, 0, 0); __builtin_amdgcn_s_setprio(0); } while (0)
#define PG8_WAIT_V(n) asm volatile("s_waitcnt vmcnt(" #n ")" ::: "memory")
#define PG8_WAIT_L(n) asm volatile("s_waitcnt lgkmcnt(" #n ")" ::: "memory")
#define PG8_BAR __builtin_amdgcn_s_barrier()
#define PG8_SCHED __builtin_amdgcn_sched_barrier(0)
    Unit cur, nxt; int ui = 0;
    if (!S.next(0, cur)) return;
    f32x4 acc[2][2][4][2];
#pragma unroll
    for (int a = 0; a < 2; ++a)
#pragma unroll
        for (int b = 0; b < 2; ++b)
#pragma unroll
            for (int m = 0; m < 4; ++m)
#pragma unroll
                for (int n = 0; n < 2; ++n) acc[a][b][m][n] = (f32x4){0.f, 0.f, 0.f, 0.f};
    bf16x8 At[4][2], B0[2][2], B1[2][2];
    const char* cA = (const char*)g.A + (size_t)cur.pm * tstep + (size_t)cur.ko * 2; const char* cB = (const char*)g.Bt + (size_t)cur.pn * tstep + (size_t)cur.ko * 2;
    S.a_ready(cur);
    if constexpr (SP2) {
        PG8_STAGE(PG8_SB(0, 0), cB, voffB); PG8_STAGE(PG8_SB(0, 1), cB + hstep, voffB); PG8_STAGE(PG8_SA(0, 0), cA, voffA); PG8_STAGE(PG8_SA(0, 1), cA + hstep, voffA);
        if (wr == 1) PG8_BAR;
        PG8_WAIT_V(2); PG8_BAR;
        PG8_STAGE(PG8_SB(1, 0), cB + kstep, voffB); PG8_STAGE(PG8_SA(1, 0), cA + kstep, voffA); PG8_STAGE(PG8_SB(1, 1), cB + hstep + kstep, voffB);
        PG8_WAIT_V(6); PG8_BAR;
    } else {
        PG8_STAGE(PG8_SB(0, 0), cB, voffB); PG8_STAGE(PG8_SA(0, 0), cA, voffA); PG8_STAGE(PG8_SB(0, 1), cB + hstep, voffB); PG8_STAGE(PG8_SA(0, 1), cA + hstep, voffA);
        if (wr == 1) PG8_BAR;
        PG8_WAIT_V(4); PG8_BAR;
        PG8_STAGE(PG8_SB(1, 0), cB + kstep, voffB); PG8_STAGE(PG8_SA(1, 0), cA + kstep, voffA); PG8_STAGE(PG8_SB(1, 1), cB + hstep + kstep, voffB);
        PG8_WAIT_V(6); PG8_BAR;
    }
    for (;;) {
        const bool has_next = S.next(ui + 1, nxt);
        const char* nA = has_next ? (const char*)g.A + (size_t)nxt.pm * tstep + (size_t)nxt.ko * 2 : cA; const char* nB = has_next ? (const char*)g.Bt + (size_t)nxt.pn * tstep + (size_t)nxt.ko * 2 : cB;
        for (int t = 0; t < nt; t += 2) {
            const bool last = (t == nt - 2);
            const char* a1 = cA + (size_t)(t + 1) * kstep;
            const char* a2 = last ? nA : cA + (size_t)(t + 2) * kstep; const char* b2 = last ? nB : cB + (size_t)(t + 2) * kstep;
            const char* a3 = a2 + kstep; const char* b3 = b2 + kstep;
            if (last && has_next) S.a_ready(nxt);
            if constexpr (SP2) {
            PG8_LDB(B0, 0, 0); PG8_LDB(B1, 0, 1); PG8_SCHED; PG8_LDA(At, 0, 0); PG8_STAGE(PG8_SA(1, 1), a1 + hstep, voffA);
            PG8_WAIT_V(8); PG8_WAIT_L(0); PG8_BAR; PG8_MMA(0, 0, At, B0); PG8_MMA(0, 1, At, B1); PG8_BAR; PG8_SCHED;
            PG8_LDA(At, 0, 1); PG8_STAGE(PG8_SB(0, 0), b2, voffB); PG8_STAGE(PG8_SB(0, 1), b2 + hstep, voffB); PG8_STAGE(PG8_SA(0, 0), a2, voffA);
            PG8_WAIT_V(8); PG8_WAIT_L(0); PG8_BAR; PG8_MMA(1, 0, At, B0); PG8_MMA(1, 1, At, B1); PG8_BAR; PG8_SCHED;
            PG8_LDB(B0, 1, 0); PG8_LDB(B1, 1, 1); PG8_SCHED; PG8_LDA(At, 1, 0); PG8_STAGE(PG8_SA(0, 1), a2 + hstep, voffA);
            PG8_WAIT_V(8); PG8_WAIT_L(0); PG8_BAR; PG8_MMA(0, 0, At, B0); PG8_MMA(0, 1, At, B1); PG8_BAR; PG8_SCHED;
            PG8_LDA(At, 1, 1); PG8_STAGE(PG8_SB(1, 0), b3, voffB); PG8_STAGE(PG8_SB(1, 1), b3 + hstep, voffB); PG8_STAGE(PG8_SA(1, 0), a3, voffA);
            PG8_WAIT_V(8); PG8_WAIT_L(0); PG8_BAR; PG8_MMA(1, 0, At, B0); PG8_MMA(1, 1, At, B1); PG8_BAR; PG8_SCHED;
            } else {
            PG8_LDB(B0, 0, 0); PG8_SCHED; PG8_LDA(At, 0, 0); PG8_STAGE(PG8_SA(1, 1), a1 + hstep, voffA);
            PG8_WAIT_L(8); PG8_BAR; PG8_WAIT_L(0); PG8_MMA(0, 0, At, B0); PG8_BAR; PG8_SCHED;
            PG8_LDB(B1, 0, 1); PG8_STAGE(PG8_SB(0, 0), b2, voffB);
            PG8_BAR; PG8_WAIT_L(0); PG8_MMA(0, 1, At, B1); PG8_BAR;
            PG8_LDA(At, 0, 1); PG8_STAGE(PG8_SA(0, 0), a2, voffA);
            PG8_BAR; PG8_WAIT_L(0); PG8_MMA(1, 0, At, B0); PG8_BAR; PG8_SCHED;
            PG8_STAGE(PG8_SB(0, 1), b2 + hstep, voffB);
            PG8_WAIT_V(6); PG8_BAR; PG8_MMA(1, 1, At, B1); PG8_BAR;
            PG8_LDB(B0, 1, 0); PG8_SCHED; PG8_LDA(At, 1, 0); PG8_STAGE(PG8_SA(0, 1), a2 + hstep, voffA);
            PG8_WAIT_L(8); PG8_BAR; PG8_WAIT_L(0); PG8_MMA(0, 0, At, B0); PG8_BAR; PG8_SCHED;
            PG8_LDB(B1, 1, 1); PG8_STAGE(PG8_SB(1, 0), b3, voffB);
            PG8_BAR; PG8_WAIT_L(0); PG8_MMA(0, 1, At, B1); PG8_BAR;
            PG8_LDA(At, 1, 1); PG8_STAGE(PG8_SA(1, 0), a3, voffA);
            PG8_BAR; PG8_WAIT_L(0); PG8_MMA(1, 0, At, B0); PG8_BAR; PG8_SCHED;
            PG8_STAGE(PG8_SB(1, 1), b3 + hstep, voffB);
            PG8_WAIT_V(6); PG8_BAR; PG8_MMA(1, 1, At, B1); PG8_BAR;
            }
            if constexpr (Epi::HAS_MID) { if ((((t + 2) & 7) == 0) && ((t + 2) < nt)) E.mid(acc, cur, ((t + 2) >> 3) - 1, wr, wc, fr, fq); }
        }
        if constexpr (ALIGN_EPI) { if (wr == 0) PG8_BAR; }
        if constexpr (!Epi::AFTER_DRAIN) { E(acc, cur, wr, wc, fr, fq); S.done(cur); }
        if (!has_next) break;
#pragma unroll
        for (int a = 0; a < 2; ++a)
#pragma unroll
            for (int b = 0; b < 2; ++b)
#pragma unroll
                for (int m = 0; m < 4; ++m)
#pragma unroll
                    for (int n = 0; n < 2; ++n) acc[a][b][m][n] = (f32x4){0.f, 0.f, 0.f, 0.f};
        cur = nxt; cA = nA; cB = nB; ++ui;
        if constexpr (ALIGN_EPI) { if (wr == 1) PG8_BAR; }
    }
    PG8_WAIT_V(0);
    if constexpr (!ALIGN_EPI) { if (wr == 0) PG8_BAR; }
    PG8_BAR;
    if constexpr (Epi::AFTER_DRAIN) { E.fused(acc, cur, wr, wc, fr, fq, lds, wid, lane); S.done(cur); }
#undef PG8_SA
#undef PG8_SB
#undef PG8_STAGE
#undef PG8_LDA
#undef PG8_LDB
#undef PG8_MMA
#undef PG8_WAIT_V
#undef PG8_WAIT_L
#undef PG8_BAR
#undef PG8_SCHED
}
}

constexpr int NWAVES = 8;
constexpr int DM = 2048, SEQ = 8192, CTXL = 256, MT = SEQ + CTXL, DEPTH = 4, GRIDW = 64;
constexpr int INC = 13056, ZC = 4864, GC = 8192, BW = 512, FHID = 5632, F2 = 2 * FHID, NMOD = 6 * DM;
constexpr int ZC_QA = 0, ZC_KA = 512, ZC_VA = 640, ZC_QB = 768, ZC_KB = 1280, ZC_VB = 1792, ZC_XR = 2304, ZC_GR = 2816, ZC_XD = 3328, ZC_BD = 3840, ZC_CD = 4352;
constexpr float EPS = 1e-6f, LOG2E = 1.4426950408889634f;
constexpr int NPL = 9;
constexpr int N_PHASES = 2 + DEPTH * NPL;
#ifndef MK_ONE_LAUNCH
#define MK_ONE_LAUNCH 1
#endif
constexpr size_t MiB = 1u << 20;
constexpr size_t WS_CTL = 0, CTL_ZERO_BYTES = 1 * MiB;
constexpr size_t WS_MOD = 1 * MiB;
constexpr size_t WS_ROPE = 2 * MiB;
constexpr size_t WS_GW = 3 * MiB;
constexpr size_t WS_XC = 5 * MiB;
constexpr size_t WS_PS = 7 * MiB;
constexpr size_t WS_AB = 16 * MiB;
constexpr size_t WS_H = 88 * MiB;
constexpr size_t WS_Z = 124 * MiB;
constexpr size_t WS_G = 204 * MiB;
constexpr size_t WS_BR = 336 * MiB;
constexpr size_t WS_MG = 372 * MiB;
constexpr size_t WS_FH = 408 * MiB;
constexpr size_t WS_W = 512 * MiB;
constexpr size_t WL_IN = 0, WL_BR = 51 * MiB, WL_OUT = 59 * MiB, WL_F1 = 67 * MiB, WL_F2 = 111 * MiB, WL_STRIDE = 133 * MiB;
constexpr size_t WS_END = WS_W + DEPTH * WL_STRIDE;
constexpr size_t WS_SLAB = WS_END + 80 * MiB;
constexpr size_t WS_NEED = WS_SLAB + 24 * MiB;
static_assert((size_t)INC * DM * 2 <= WL_BR && (size_t)DM * DM * 2 <= WL_OUT - WL_BR && (size_t)F2 * DM * 2 <= WL_F2 - WL_F1 && (size_t)DM * FHID * 2 <= WL_STRIDE - WL_F2, "weight map");
static_assert(WS_AB + (size_t)4 * MT * 512 * 4 <= WS_H && WS_H + (size_t)MT * DM * 2 <= WS_Z && WS_Z + (size_t)MT * ZC * 2 <= WS_G && WS_G + (size_t)MT * GC * 2 <= WS_BR && WS_FH + (size_t)MT * FHID * 2 <= WS_W, "d_ws map");
constexpr int CW_BAR = 4096;
constexpr int RING_BYTES = 131072;
constexpr int LDSCTL_OFF = RING_BYTES, MISC_OFF = LDSCTL_OFF + 320;
constexpr int LDS_BYTES = 147456;

#define GAS __attribute__((address_space(1)))
#define LAS __attribute__((address_space(3)))
typedef unsigned short bf16;
typedef unsigned v4u __attribute__((ext_vector_type(4)));
typedef unsigned v2u __attribute__((ext_vector_type(2)));
typedef float f32x4 __attribute__((ext_vector_type(4)));
typedef float f32x16 __attribute__((ext_vector_type(16)));
typedef short bf16x8 __attribute__((ext_vector_type(8)));
typedef short s16x4 __attribute__((ext_vector_type(4)));
typedef GAS unsigned gu32;
#define RLX_AGENT __ATOMIC_RELAXED, __HIP_MEMORY_SCOPE_AGENT
#define LDS_WAIT() asm volatile("s_waitcnt lgkmcnt(0)" ::: "memory")
__device__ __forceinline__ unsigned f2bf(float f) { unsigned u = __builtin_bit_cast(unsigned, f); return (u + 0x7fffu + ((u >> 16) & 1u)) >> 16; }
__device__ __forceinline__ unsigned pk2(float lo, float hi) { return f2bf(lo) | (f2bf(hi) << 16); }
__device__ __forceinline__ float bflo(unsigned w) { return __uint_as_float(w << 16); }
__device__ __forceinline__ float bfhi(unsigned w) { return __uint_as_float(w & 0xffff0000u); }
__device__ __forceinline__ float bf1(bf16 b) { return __uint_as_float(((unsigned)b) << 16); }
__device__ __forceinline__ float sigm(float x) { return __builtin_amdgcn_rcpf(1.0f + __expf(-x)); }

#define XB_TMO      128
#define XB_XCNT(j)  (256  + 64 * (j))
#define XB_XSUB(j)  (1280 + 64 * (j))
#define XB_XGEN(j)  (2304 + 64 * (j))
#define XB_TOP      3328
#define XB_TOPGEN   3392
#define XCD_BAR_WORDS 3456
#define XB_SPIN_CAP (1u << 18)

__device__ __forceinline__ unsigned xb_ld(unsigned* p)              { return __hip_atomic_load(p, __ATOMIC_RELAXED, __HIP_MEMORY_SCOPE_AGENT); }
__device__ __forceinline__ unsigned xb_add(unsigned* p, unsigned v) { return __hip_atomic_fetch_add(p, v, __ATOMIC_RELAXED, __HIP_MEMORY_SCOPE_AGENT); }
__device__ __forceinline__ unsigned xb_xcc_id() { return (unsigned)__builtin_amdgcn_s_getreg((3 << 11) | 20) & 0xFu; }
#define XB_SPIN(cond, bar) do { unsigned _sp = 0; while (cond) { __builtin_amdgcn_s_sleep(1); \
    if ((++_sp & 255u) == 0u) { if (xb_ld(&(bar)[XB_TMO])) break; if (_sp > XB_SPIN_CAP) { atomicAdd(&(bar)[XB_TMO], 1u); break; } } } } while (0)

struct XcdBarrier {
    unsigned* bar; unsigned x;
    volatile LAS unsigned* st;
};

__device__ __forceinline__ XcdBarrier xcd_barrier_post(unsigned* bar, volatile LAS unsigned* st) {
    XcdBarrier b; b.bar = bar; b.x = xb_xcc_id(); b.st = st;
    if (threadIdx.x == 0) (void)xb_add(&bar[XB_XCNT(b.x)], 1u);
    return b;
}
__device__ __forceinline__ void xcd_barrier_complete(unsigned* bar, unsigned x, unsigned& nloc, unsigned& nx) {
    const unsigned G = gridDim.x * gridDim.y * gridDim.z;
    unsigned sum, cnt, mine, sp = 0u;
    for (;;) {
        sum = 0u; cnt = 0u; mine = 0u;
#pragma unroll
        for (unsigned j = 0; j < 16; ++j) { const unsigned c = xb_ld(&bar[XB_XCNT(j)]); sum += c; cnt += (c > 0u) ? 1u : 0u; mine = (j == x) ? c : mine; }
        if (sum == G) break;
        __builtin_amdgcn_s_sleep(1);
        if ((++sp & 255u) == 0u) { if (xb_ld(&bar[XB_TMO])) break; if (sp > XB_SPIN_CAP) { atomicAdd(&bar[XB_TMO], 1u); break; } }
    }
    nloc = mine > 0u ? mine : 1u; nx = cnt > 0u ? cnt : 1u;
}

__device__ __forceinline__ void xcd_barrier(const XcdBarrier& b) {
    asm volatile("s_waitcnt vmcnt(0)" ::: "memory");
    __syncthreads();
    if (threadIdx.x == 0) {
        unsigned* bar = b.bar;
        __builtin_amdgcn_s_waitcnt(0);
        unsigned nloc = b.st[0], nx = b.st[1];
        if (nloc == 0u) { xcd_barrier_complete(bar, b.x, nloc, nx); b.st[0] = nloc; b.st[1] = nx; }
        const unsigned old = xb_add(&bar[XB_XSUB(b.x)], 1u);
        const unsigned gen = old / nloc;
        if (old + 1u == (gen + 1u) * nloc) {
            __builtin_amdgcn_fence(__ATOMIC_RELEASE, "agent");
            asm volatile("s_waitcnt vmcnt(0)" ::: "memory");
            const unsigned og = xb_add(&bar[XB_TOP], 1u);
            const unsigned tg = og / nx;
            if (og + 1u == (tg + 1u) * nx) xb_add(&bar[XB_TOPGEN], 1u);
            else XB_SPIN(xb_ld(&bar[XB_TOPGEN]) == tg, bar);
            __builtin_amdgcn_fence(__ATOMIC_ACQUIRE, "agent");
            xb_add(&bar[XB_XGEN(b.x)], 1u);
            asm volatile("s_waitcnt vmcnt(0)" ::: "memory");
        } else {
            XB_SPIN(xb_ld(&bar[XB_XGEN(b.x)]) == gen, bar);
            __builtin_amdgcn_fence(__ATOMIC_ACQUIRE, "agent");
            asm volatile("s_waitcnt vmcnt(0)" ::: "memory");
        }
    }
    __syncthreads();
}

#define KAS __attribute__((address_space(4)))
struct Args { const float* in[25]; float* out; unsigned char* ws; int ph_lo, ph_hi; };
struct Frame {
    LAS unsigned char* lds;
    volatile LAS unsigned* MISC;
    gu32* ctl;
    int tid, lane, wave, G;
    const KAS Args* ka;
    float* out; unsigned char* ws;
};
enum { I_X = 0, I_C, I_CTX, I_CCTX, I_WMOD, I_BMOD, I_NORM1, I_NORM2, I_WIN, I_BGATE, I_ASINK, I_NBBIAS, I_CCONVW, I_CCONVB, I_CWA, I_CBA, I_CWX, I_CBX, I_CLAM, I_DCONVW, I_WBR, I_WOUT, I_WF1, I_WF2, I_FNORM };

__device__ __forceinline__ float wave_sum(float v) {
#pragma unroll
    for (int o = 1; o < 64; o <<= 1) v += __shfl_xor(v, o);
    return v;
}

__device__ __forceinline__ void transpose_item(const float* W, int ldw, int k0, int n0, bf16* dst, int ldt, LAS float* scr, int lane) {
#pragma unroll 8
    for (int i = 0; i < 32; ++i) { const int kk = 2 * i + (lane >> 5); scr[kk * 33 + (lane & 31)] = W[(size_t)(k0 + kk) * ldw + n0 + (lane & 31)]; }
    LDS_WAIT(); asm volatile("" ::: "memory");
    const int c = lane & 7;
#pragma unroll
    for (int j = 0; j < 4; ++j) { const int n = (lane >> 3) + 8 * j; const LAS float* s = scr + (8 * c) * 33 + n;
        v4u o; o.x = pk2(s[0 * 33], s[1 * 33]); o.y = pk2(s[2 * 33], s[3 * 33]); o.z = pk2(s[4 * 33], s[5 * 33]); o.w = pk2(s[6 * 33], s[7 * 33]);
        *(GAS v4u*)(dst + (size_t)n * ldt + 8 * c) = o; }
    LDS_WAIT(); asm volatile("" ::: "memory");
}

__device__ __forceinline__ void p0_prologue(Frame& F) {
    const int gw = blockIdx.x * NWAVES + F.wave, NGW = F.G * NWAVES;
    const int gt = blockIdx.x * (NWAVES * 64) + F.tid, NGT = F.G * NWAVES * 64;
    if (gt < 2048) {
        const int pos = gt >> 4, i = gt & 15;
        const float freq = exp2f(-(float)i * (13.287712379549449f / 16.0f));
        const float ang = (float)pos * freq;
        const float k = rintf(ang * 0.15915494309189535f);
        float r = fmaf(-k, 6.28125f, ang); r = fmaf(-k, 0.0019353071795864769f, r);
        float* rc = (float*)(F.ws + WS_ROPE);
        rc[gt] = __cosf(r); rc[2048 + gt] = __sinf(r);
    }
    {
        const f32x4* xs = (const f32x4*)F.ka->in[I_X]; f32x4* xd = (f32x4*)F.out;
        for (int i = gt; i < SEQ * DM / 4; i += NGT) xd[i] = xs[i];
        const f32x4* cs = (const f32x4*)F.ka->in[I_CTX]; f32x4* cd = (f32x4*)(F.ws + WS_XC);
        for (int i = gt; i < CTXL * DM / 4; i += NGT) cd[i] = cs[i];
    }
    {
        LAS float* sl = (LAS float*)F.lds;
        LAS float* sc = sl + 2048;
        LAS float* red = sc + 2048;
        for (int i = F.tid; i < 2048; i += NWAVES * 64) { const float a = F.ka->in[I_C][i], b = F.ka->in[I_CCTX][i]; sl[i] = a * sigm(a); sc[i] = b * sigm(b); }
        __syncthreads();
        const int half = F.lane >> 5, c4 = F.lane & 31;
        for (int item = blockIdx.x; item < DEPTH * 96; item += F.G) {
            const int l = item / 96, col0 = (item % 96) * 128;
            const float* W = F.ka->in[I_WMOD] + (size_t)l * DM * NMOD + col0 + 4 * c4;
            f32x4 al = {0.f, 0.f, 0.f, 0.f}, ac = {0.f, 0.f, 0.f, 0.f};
#pragma unroll 8
            for (int i = 0; i < 128; ++i) { const int row = F.wave * 256 + 2 * i + half; const f32x4 v = *(const f32x4*)(W + (size_t)row * NMOD); al += sl[row] * v; ac += sc[row] * v; }
#pragma unroll
            for (int e = 0; e < 4; ++e) { al[e] += __shfl_xor(al[e], 32); ac[e] += __shfl_xor(ac[e], 32); }
            if (half == 0) { *(LAS f32x4*)(red + (F.wave * 2 + 0) * 128 + 4 * c4) = al; *(LAS f32x4*)(red + (F.wave * 2 + 1) * 128 + 4 * c4) = ac; }
            __syncthreads();
            if (F.tid < 256) { const int which = F.tid >> 7, col = F.tid & 127; float s = F.ka->in[I_BMOD][l * NMOD + col0 + col];
#pragma unroll
                for (int w = 0; w < 8; ++w) s += red[(w * 2 + which) * 128 + col];
                ((float*)(F.ws + WS_MOD))[(size_t)(l * 2 + which) * NMOD + col0 + col] = s; }
            __syncthreads();
        }
    }
    {
        LAS float* scr = (LAS float*)(F.lds + F.wave * 16384);
        constexpr int I_IN = (DM / 64) * (INC / 32), I_BR = 4 * (BW / 64) * (DM / 32), I_OUT = (DM / 64) * (DM / 32), I_F1 = (DM / 64) * (F2 / 32), I_F2 = (FHID / 64) * (DM / 32);
        constexpr int PER_L = I_IN + I_BR + I_OUT + I_F1 + I_F2, I_GW = 64 * 8;
        constexpr int NITEMS = DEPTH * PER_L + I_GW;
        for (int it = gw; it < NITEMS; it += NGW) {
            if (it >= DEPTH * PER_L) {
                const int r = it - DEPTH * PER_L, mi = r >> 3, sub = r & 7, kb = sub >> 2, nb = sub & 3;
                const int blk = mi & 3, map = (mi >> 2) & 1, ld = mi >> 3;
                const float* W = (map ? F.ka->in[I_CWX] : F.ka->in[I_CWA]) + (size_t)(ld * 4 + blk) * 16384;
                bf16* dst = (bf16*)(F.ws + WS_GW) + (size_t)mi * 16384 + (size_t)(32 * nb) * 128 + 64 * kb;
                transpose_item(W, 128, 64 * kb, 32 * nb, dst, 128, scr, F.lane);
                continue;
            }
            const int l = it / PER_L; int r = it % PER_L;
            unsigned char* wl = F.ws + WS_W + (size_t)l * WL_STRIDE;
            if (r < I_IN) { const int nblk = INC / 32, kb = r / nblk, nb = r % nblk;
                transpose_item(F.ka->in[I_WIN] + (size_t)l * DM * INC, INC, 64 * kb, 32 * nb, (bf16*)(wl + WL_IN) + (size_t)(32 * nb) * DM + 64 * kb, DM, scr, F.lane); continue; }
            r -= I_IN;
            if (r < I_BR) { const int per = (BW / 64) * (DM / 32), k = r / per, rr = r % per, nblk = DM / 32, kb = rr / nblk, nb = rr % nblk;
                transpose_item(F.ka->in[I_WBR] + (size_t)(l * 4 + k) * BW * DM, DM, 64 * kb, 32 * nb, (bf16*)(wl + WL_BR) + (size_t)(32 * nb) * DM + k * BW + 64 * kb, DM, scr, F.lane); continue; }
            r -= I_BR;
            if (r < I_OUT) { const int nblk = DM / 32, kb = r / nblk, nb = r % nblk;
                transpose_item(F.ka->in[I_WOUT] + (size_t)l * DM * DM, DM, 64 * kb, 32 * nb, (bf16*)(wl + WL_OUT) + (size_t)(32 * nb) * DM + 64 * kb, DM, scr, F.lane); continue; }
            r -= I_OUT;
            if (r < I_F1) { const int nblk = F2 / 32, kb = r / nblk, nb = r % nblk; const int n0 = 32 * nb;
                const int j = n0 < FHID ? n0 : n0 - FHID; const int drow = (j >> 7) * 256 + (n0 < FHID ? 0 : 128) + (j & 127);
                transpose_item(F.ka->in[I_WF1] + (size_t)l * DM * F2, F2, 64 * kb, n0, (bf16*)(wl + WL_F1) + (size_t)drow * DM + 64 * kb, DM, scr, F.lane); continue; }
            r -= I_F1;
            { const int nblk = DM / 32, kb = r / nblk, nb = r % nblk;
                transpose_item(F.ka->in[I_WF2] + (size_t)l * FHID * DM, DM, 64 * kb, 32 * nb, (bf16*)(wl + WL_F2) + (size_t)(32 * nb) * FHID + 64 * kb, FHID, scr, F.lane); }
        }
    }
}

template <int NS> __device__ __forceinline__ void norm_phase(Frame& F, int l, int which, int nrows, bool pend, const float* pgate) {
    const int gw = blockIdx.x * NWAVES + F.wave, NGW = F.G * NWAVES;
    const float* gain = (which ? F.ka->in[I_NORM2] : F.ka->in[I_NORM1]) + l * DM;
    bf16* H = (bf16*)(F.ws + WS_H);
    for (int m = gw; m < nrows; m += NGW) {
        const bool lat = m < SEQ;
        const float* xrow = lat ? F.out + (size_t)m * DM : (const float*)(F.ws + WS_XC) + (size_t)(m - SEQ) * DM;
        const float* mod = (const float*)(F.ws + WS_MOD) + (size_t)(l * 2 + (lat ? 0 : 1)) * NMOD + (which ? 3 * DM : 0);
        f32x4 v[8]; float ss = 0.f;
#pragma unroll
        for (int j = 0; j < 8; ++j) v[j] = *(const f32x4*)(xrow + 4 * F.lane + 256 * j);
        if (!lat && pend) {
            const float* sp = (const float*)(F.ws + WS_SLAB) + (size_t)(m - SEQ) * DM + 4 * F.lane;
#pragma unroll
            for (int j = 0; j < 8; ++j) { f32x4 t[NS];
#pragma unroll
                for (int s = 0; s < NS; ++s) t[s] = *(const f32x4*)(sp + (size_t)s * CTXL * DM + 256 * j);
                f32x4 a = t[0];
#pragma unroll
                for (int s = 1; s < NS; ++s) a += t[s];
                v[j] += *(const f32x4*)(pgate + 4 * F.lane + 256 * j) * a;
                *(f32x4*)((float*)(F.ws + WS_XC) + (size_t)(m - SEQ) * DM + 4 * F.lane + 256 * j) = v[j]; }
        }
#pragma unroll
        for (int j = 0; j < 8; ++j) ss += (v[j][0] * v[j][0] + v[j][1] * v[j][1]) + (v[j][2] * v[j][2] + v[j][3] * v[j][3]);
        const float rstd = 1.0f / sqrtf(wave_sum(ss) * (1.0f / DM) + EPS);
#pragma unroll
        for (int j = 0; j < 8; ++j) { const int c = 4 * F.lane + 256 * j;
            const f32x4 g = *(const f32x4*)(gain + c), sh = *(const f32x4*)(mod + c), scl = *(const f32x4*)(mod + DM + c);
            const f32x4 o = (v[j] * rstd * g) * (1.0f + scl) + sh;
            v2u w; w.x = pk2(o[0], o[1]); w.y = pk2(o[2], o[3]);
            *(v2u*)(H + (size_t)m * DM + c) = w; }
    }
}
__device__ __forceinline__ void final_norm_phase(Frame& F) {
    const int gw = blockIdx.x * NWAVES + F.wave, NGW = F.G * NWAVES;
    const float* gain = F.ka->in[I_FNORM];
    for (int m = gw; m < SEQ; m += NGW) {
        float* xrow = F.out + (size_t)m * DM;
        f32x4 v[8]; float ss = 0.f;
#pragma unroll
        for (int j = 0; j < 8; ++j) { v[j] = *(const f32x4*)(xrow + 4 * F.lane + 256 * j); ss += (v[j][0] * v[j][0] + v[j][1] * v[j][1]) + (v[j][2] * v[j][2] + v[j][3] * v[j][3]); }
        const float rstd = 1.0f / sqrtf(wave_sum(ss) * (1.0f / DM) + EPS);
#pragma unroll
        for (int j = 0; j < 8; ++j) { const int c = 4 * F.lane + 256 * j; const f32x4 g = *(const f32x4*)(gain + c); *(f32x4*)(xrow + c) = (v[j] * rstd) * g; }
    }
}

#define MFMA32(a, b, c) __builtin_amdgcn_mfma_f32_32x32x16_bf16((a), (b), (c), 0, 0, 0)
__device__ __forceinline__ int crow(int reg, int h) { return (reg & 3) + 8 * (reg >> 2) + 4 * h; }
typedef short v4i16_t __attribute__((ext_vector_type(4)));
__device__ __forceinline__ s16x4 tr_read(LAS unsigned char* p) { return __builtin_bit_cast(s16x4, __builtin_amdgcn_ds_read_tr16_b64_v4i16((LAS v4i16_t*)p)); }
__device__ __forceinline__ unsigned cvtpk(float lo, float hi) { return pg8::cvt_pk_bf16(lo, hi); }

constexpr int VPITCH = 144;
constexpr int ATT_WAVE_LDS = 32 * VPITCH + 1920;
constexpr float ATT_SCALE = 0.125f;
constexpr float NEG_BIG = -1.0e30f;

struct AttnState { f32x16 o0, o1; float m, l; };
template <class ScoreFn>
__device__ __forceinline__ void attn_keytile(AttnState& st, const bf16x8 (&qf)[4], const bf16* Kp, const bf16* Vp, LAS unsigned char* vlds, int lane, const ScoreFn& sf) {
    const int r = lane & 31, h = lane >> 5;
    bf16x8 kf[4];
#pragma unroll
    for (int ds = 0; ds < 4; ++ds) kf[ds] = *(const bf16x8*)(Kp + (size_t)r * ZC + 16 * ds + 8 * h);
    {
        const bf16* vsrc = Vp + (size_t)(lane >> 1) * ZC + (lane & 1) * 32;
        const v4u a0 = *(const v4u*)(vsrc), a1 = *(const v4u*)(vsrc + 8), a2 = *(const v4u*)(vsrc + 16), a3 = *(const v4u*)(vsrc + 24);
        LAS v4u* dst = (LAS v4u*)(vlds + (lane >> 1) * VPITCH + (lane & 1) * 64);
        dst[0] = a0; dst[1] = a1; dst[2] = a2; dst[3] = a3;
    }
    f32x16 s;
#pragma unroll
    for (int i = 0; i < 16; ++i) s[i] = 0.f;
#pragma unroll
    for (int ds = 0; ds < 4; ++ds) s = MFMA32(kf[ds], qf[ds], s);
    float mt = NEG_BIG;
#pragma unroll
    for (int i = 0; i < 16; ++i) { s[i] = sf(s[i], crow(i, h), r); mt = fmaxf(mt, s[i]); }
    mt = fmaxf(mt, __shfl_xor(mt, 32));
    const float mn = fmaxf(st.m, mt), alpha = __builtin_amdgcn_exp2f(st.m - mn);
    float ps = 0.f;
#pragma unroll
    for (int i = 0; i < 16; ++i) { s[i] = __builtin_amdgcn_exp2f(s[i] - mn); ps += s[i]; }
    st.l = st.l * alpha + ps; st.m = mn;
#pragma unroll
    for (int i = 0; i < 16; ++i) { st.o0[i] *= alpha; st.o1[i] *= alpha; }
    v4u p0, p1;
    p0.x = cvtpk(s[0], s[1]); p0.y = cvtpk(s[2], s[3]); p0.z = cvtpk(s[4], s[5]); p0.w = cvtpk(s[6], s[7]);
    p1.x = cvtpk(s[8], s[9]); p1.y = cvtpk(s[10], s[11]); p1.z = cvtpk(s[12], s[13]); p1.w = cvtpk(s[14], s[15]);
    const bf16x8 pf0 = __builtin_bit_cast(bf16x8, p0), pf1 = __builtin_bit_cast(bf16x8, p1);
    asm volatile("" ::: "memory");
    const int i16 = lane & 15, q = i16 >> 2, p = i16 & 3, dhalf = (lane >> 4) & 1;
    LAS unsigned char* vb = vlds + (4 * h + q) * VPITCH + (16 * dhalf + 4 * p) * 2;
#pragma unroll
    for (int dt = 0; dt < 2; ++dt) {
        const s16x4 lo0 = tr_read(vb + dt * 64), hi0 = tr_read(vb + 8 * VPITCH + dt * 64);
        const s16x4 lo1 = tr_read(vb + 16 * VPITCH + dt * 64), hi1 = tr_read(vb + 24 * VPITCH + dt * 64);
        const bf16x8 v0 = (bf16x8){lo0[0], lo0[1], lo0[2], lo0[3], hi0[0], hi0[1], hi0[2], hi0[3]};
        const bf16x8 v1 = (bf16x8){lo1[0], lo1[1], lo1[2], lo1[3], hi1[0], hi1[1], hi1[2], hi1[3]};
        if (dt == 0) { st.o0 = MFMA32(v0, pf0, st.o0); st.o0 = MFMA32(v1, pf1, st.o0); }
        else         { st.o1 = MFMA32(v0, pf0, st.o1); st.o1 = MFMA32(v1, pf1, st.o1); }
    }
    asm volatile("" ::: "memory");
}
__device__ __forceinline__ void attn_store(const AttnState& st, float linv, bf16* Op  , int lane) {
    const int r = lane & 31, h = lane >> 5;
    bf16* rowp = Op + (size_t)r * DM + 4 * h;
#pragma unroll
    for (int g = 0; g < 4; ++g) {
        v2u w0, w1;
        w0.x = cvtpk(st.o0[4 * g] * linv, st.o0[4 * g + 1] * linv); w0.y = cvtpk(st.o0[4 * g + 2] * linv, st.o0[4 * g + 3] * linv);
        w1.x = cvtpk(st.o1[4 * g] * linv, st.o1[4 * g + 1] * linv); w1.y = cvtpk(st.o1[4 * g + 2] * linv, st.o1[4 * g + 3] * linv);
        *(v2u*)(rowp + 8 * g) = w0; *(v2u*)(rowp + 32 + 8 * g) = w1;
    }
}
__device__ __forceinline__ void attn_init(AttnState& st) {
#pragma unroll
    for (int i = 0; i < 16; ++i) { st.o0[i] = 0.f; st.o1[i] = 0.f; }
    st.m = NEG_BIG; st.l = 0.f;
}
__device__ __forceinline__ void load_q(bf16x8 (&qf)[4], const bf16* Qp, int lane) {
    const int r = lane & 31, h = lane >> 5;
#pragma unroll
    for (int ds = 0; ds < 4; ++ds) qf[ds] = *(const bf16x8*)(Qp + (size_t)r * ZC + 16 * ds + 8 * h);
}

struct ScorePlain { __device__ __forceinline__ float operator()(float s, int, int) const { return s * (ATT_SCALE * LOG2E); } };
struct ScoreWin {
    int dk;
    __device__ __forceinline__ float operator()(float s, int krow, int qr) const { const int d = dk + krow - qr; return (d >= -128 && d <= 128) ? s * (ATT_SCALE * LOG2E) : NEG_BIG; }
};
struct ScoreNb {
    const LAS float* tab;
    int kc0, cq0, dr;
    __device__ __forceinline__ float operator()(float s, int krow, int qr) const {
        const int ck = kc0 + krow, cq = cq0 + qr; int cs = cq - 8; cs = cs < 0 ? 0 : (cs > 48 ? 48 : cs);
        int dc = ck - cq + 15; dc = dc < 0 ? 0 : (dc > 30 ? 30 : dc);
        const float b = tab[dr * 31 + dc];
        return (ck >= cs && ck < cs + 16) ? (s * ATT_SCALE + b) * LOG2E : NEG_BIG;
    }
};

__device__ __forceinline__ void attn_item(Frame& F, int l, int idx, int nqt, LAS unsigned char* wlds) {
    const int lane = F.lane;
    const bf16* Z = (const bf16*)(F.ws + WS_Z); bf16* BR = (bf16*)(F.ws + WS_BR);
    const bool isB = idx >= nqt * 8; if (isB) idx -= nqt * 8;
    const int qt = idx >> 3, hq = idx & 7;
    const bool lat = qt < 256; const int qrow0 = lat ? 32 * qt : SEQ + 32 * (qt - 256);
    AttnState st; attn_init(st); bf16x8 qf[4];
    if (!isB) {
        const int hk = hq >> 2;
        load_q(qf, Z + (size_t)qrow0 * ZC + ZC_QA + hq * 64, lane);
        const bf16* Kc = Z + ZC_KA + hk * 64; const bf16* Vc = Z + ZC_VA + hk * 64;
        if (lat) {
            const int p0 = qrow0; int klo = p0 - 128; if (klo < 0) klo = 0; int khi = p0 + 160; if (khi > SEQ) khi = SEQ;
            for (int k0 = klo; k0 < khi; k0 += 32) { ScoreWin sf{k0 - p0}; attn_keytile(st, qf, Kc + (size_t)k0 * ZC, Vc + (size_t)k0 * ZC, wlds, lane, sf); }
        }
        for (int j = 0; j < 8; ++j) { ScorePlain sf; const size_t kr = (size_t)(SEQ + 32 * j) * ZC; attn_keytile(st, qf, Kc + kr, Vc + kr, wlds, lane, sf); }
        float lsum = st.l + __shfl_xor(st.l, 32);
        lsum += __builtin_amdgcn_exp2f(F.ka->in[I_ASINK][l * 8 + hq] * LOG2E - st.m);
        attn_store(st, 1.0f / lsum, BR + (size_t)qrow0 * DM + hq * 64, lane);
    } else {
        load_q(qf, Z + (size_t)qrow0 * ZC + ZC_QB + hq * 64, lane);
        const bf16* Kc = Z + ZC_KB + hq * 64; const bf16* Vc = Z + ZC_VB + hq * 64;
        if (lat) {
            LAS float* tab = (LAS float*)(wlds + 32 * VPITCH);
            const float* bsrc = F.ka->in[I_NBBIAS] + (size_t)(l * 8 + hq) * 465;
            for (int i = lane; i < 465; i += 64) tab[i] = bsrc[i];
            asm volatile("s_waitcnt lgkmcnt(0)" ::: "memory");
            const int gr = qt >> 1, cq0 = (qt & 1) * 32; int kr0 = gr - 4; kr0 = kr0 < 0 ? 0 : (kr0 > 120 ? 120 : kr0);
            for (int i = 0; i < 8; ++i) { const int kr = kr0 + i;
#pragma unroll 1
                for (int c = 0; c < 2; ++c) { const int kc0 = c ? (cq0 ^ 32) : cq0; ScoreNb sf{tab, kc0, cq0, kr - gr + 7};
                    const size_t ko = (size_t)(kr * GRIDW + kc0) * ZC; attn_keytile(st, qf, Kc + ko, Vc + ko, wlds, lane, sf); } }
        }
        for (int j = 0; j < 8; ++j) { ScorePlain sf; const size_t kr = (size_t)(SEQ + 32 * j) * ZC; attn_keytile(st, qf, Kc + kr, Vc + kr, wlds, lane, sf); }
        const float lsum = st.l + __shfl_xor(st.l, 32);
        attn_store(st, 1.0f / lsum, BR + (size_t)qrow0 * DM + 512 + hq * 64, lane);
    }
}

__device__ __forceinline__ void dconv_phase(Frame& F, int l, int nrows) {
    const int gt = blockIdx.x * (NWAVES * 64) + F.tid, NGT = F.G * NWAVES * 64;
    const bf16* Z = (const bf16*)(F.ws + WS_Z); bf16* BR = (bf16*)(F.ws + WS_BR);
    const float* w = F.ka->in[I_DCONVW] + (size_t)l * 3 * 512;
    for (int it = gt; it < nrows * 64; it += NGT) {
        const int row = it >> 6, c0 = (it & 63) * 8;
        const int lo = row < SEQ ? 0 : SEQ, hi = row < SEQ ? SEQ : MT;
        float acc[8];
#pragma unroll
        for (int e = 0; e < 8; ++e) acc[e] = 0.f;
#pragma unroll
        for (int j = 0; j < 3; ++j) { const int rr = row + j - 1;
            if (rr >= lo && rr < hi) { const v4u cd = *(const v4u*)(Z + (size_t)rr * ZC + ZC_CD + c0), xd = *(const v4u*)(Z + (size_t)rr * ZC + ZC_XD + c0);
                const f32x4 w0 = *(const f32x4*)(w + j * 512 + c0), w1 = *(const f32x4*)(w + j * 512 + c0 + 4);
#pragma unroll
                for (int e = 0; e < 4; ++e) { acc[2 * e] += (e < 2 ? w0[2 * e] : w1[2 * e - 4]) * (bflo(cd[e]) * bflo(xd[e])); acc[2 * e + 1] += (e < 2 ? w0[2 * e + 1] : w1[2 * e - 3]) * (bfhi(cd[e]) * bfhi(xd[e])); } } }
        const v4u bd = *(const v4u*)(Z + (size_t)row * ZC + ZC_BD + c0);
        v4u o;
#pragma unroll
        for (int e = 0; e < 4; ++e) o[e] = pk2(acc[2 * e] * bflo(bd[e]), acc[2 * e + 1] * bfhi(bd[e]));
        *(v4u*)(BR + (size_t)row * DM + 1536 + c0) = o;
    }
}

__device__ __forceinline__ float gelu_tanh(float x) { const float z = 0.7978845608028654f * (x + 0.044715f * x * x * x); const float e = __expf(2.0f * z); return 0.5f * x * (1.0f + (1.0f - 2.0f * __builtin_amdgcn_rcpf(e + 1.0f))); }
constexpr int UB_PITCH = 1040;
__device__ __forceinline__ void scan_gate_item(Frame& F, int l, int c) {
    const bf16* Z = (const bf16*)(F.ws + WS_Z);
    float* AB = (float*)(F.ws + WS_AB);
    float* PS = (float*)(F.ws + WS_PS);
    LAS float* U32 = (LAS float*)F.lds;
    LAS unsigned char* Ub = F.lds + 65536;
    const int row_c = 64 * c;
    const int lo = row_c < SEQ ? 0 : SEQ, hi = row_c < SEQ ? SEQ : MT;
    const int lane = F.lane, r = lane & 31, h = lane >> 5;
    for (int sub = 0; sub < 2; ++sub) {
        const int row0 = row_c + 32 * sub;
        {
            const int ch = F.tid;
            const float* cw = F.ka->in[I_CCONVW] + (size_t)l * 4 * 512; const float w0 = cw[ch], w1 = cw[512 + ch], w2 = cw[1024 + ch], w3 = cw[1536 + ch], cb = F.ka->in[I_CCONVB][l * 512 + ch];
            const bf16* xp = Z + ZC_XR + ch;
            float xm2 = (row0 - 2 >= lo) ? bf1(xp[(size_t)(row0 - 2) * ZC]) : 0.f, xm1 = (row0 - 1 >= lo) ? bf1(xp[(size_t)(row0 - 1) * ZC]) : 0.f, x0 = bf1(xp[(size_t)row0 * ZC]);
#pragma unroll 4
            for (int tt = 0; tt < 32; ++tt) { const int rp = row0 + tt + 1; const float xp1 = (rp < hi) ? bf1(xp[(size_t)rp * ZC]) : 0.f;
                const float u = cb + w0 * xm2 + w1 * xm1 + w2 * x0 + w3 * xp1;
                U32[tt * 512 + ch] = u; *(LAS bf16*)(Ub + tt * UB_PITCH + ch * 2) = (bf16)f2bf(u);
                xm2 = xm1; xm1 = x0; x0 = xp1; }
        }
        __syncthreads();
        {
            const int dir = F.wave >> 2, n = F.wave & 3;
            bf16x8 af[8];
#pragma unroll
            for (int kk = 0; kk < 8; ++kk) af[kk] = *(const LAS bf16x8*)(Ub + r * UB_PITCH + (n * 128 + 16 * kk + 8 * h) * 2);
            const bf16* GWa = (const bf16*)(F.ws + WS_GW) + (size_t)((((l * 2 + dir) * 2 + 0) * 4 + n)) * 16384;
            const bf16* GWx = GWa + (size_t)4 * 16384;
            float* Ao = AB + ((size_t)(dir * 2 + 0) * MT + row0) * 512; float* Bo = AB + ((size_t)(dir * 2 + 1) * MT + row0) * 512;
#pragma unroll 1
            for (int g = 0; g < 4; ++g) {
                f32x16 pa, px;
#pragma unroll
                for (int i = 0; i < 16; ++i) { pa[i] = 0.f; px[i] = 0.f; }
                const bf16* wa = GWa + (size_t)(32 * g + r) * 128 + 8 * h; const bf16* wx = GWx + (size_t)(32 * g + r) * 128 + 8 * h;
#pragma unroll
                for (int kk = 0; kk < 8; ++kk) { pa = MFMA32(af[kk], *(const bf16x8*)(wa + 16 * kk), pa); px = MFMA32(af[kk], *(const bf16x8*)(wx + 16 * kk), px); }
                const int ch = n * 128 + 32 * g + r, pidx = (l * 2 + dir) * 512 + ch;
                const float ba = F.ka->in[I_CBA][pidx], bx = F.ka->in[I_CBX][pidx], lam = F.ka->in[I_CLAM][pidx];
                const float sp = log1pf(__expf(-lam));
#pragma unroll
                for (int i = 0; i < 16; ++i) { const int tt = crow(i, h);
                    const float rr = sigm(pa[i] + ba), ii = sigm(px[i] + bx), la = -8.0f * rr * sp;
                    const float a = __expf(la), b = sqrtf(-expm1f(2.0f * la)) * (ii * U32[tt * 512 + ch]);
                    Ao[(size_t)tt * 512 + ch] = a; Bo[(size_t)tt * 512 + ch] = b; }
            }
        }
        asm volatile("s_waitcnt vmcnt(0)" ::: "memory");
        __syncthreads();
    }
    {
        const int ch = F.tid;
        const float* Af = AB + ((size_t)0 * MT + row_c) * 512 + ch; const float* Bf = AB + ((size_t)1 * MT + row_c) * 512 + ch;
        const float* Abk = AB + ((size_t)2 * MT + row_c) * 512 + ch; const float* Bbk = AB + ((size_t)3 * MT + row_c) * 512 + ch;
        float P = 1.f, S = 0.f;
#pragma unroll 8
        for (int t = 0; t < 64; ++t) { const float a = Af[(size_t)t * 512], b = Bf[(size_t)t * 512]; S = a * S + b; P *= a; }
        PS[((size_t)(0 * 132 + c) * 512 + ch) * 2] = P; PS[((size_t)(0 * 132 + c) * 512 + ch) * 2 + 1] = S;
        P = 1.f; S = 0.f;
#pragma unroll 8
        for (int t = 63; t >= 0; --t) { const float a = Abk[(size_t)t * 512], b = Bbk[(size_t)t * 512]; S = a * S + b; P *= a; }
        PS[((size_t)(1 * 132 + c) * 512 + ch) * 2] = P; PS[((size_t)(1 * 132 + c) * 512 + ch) * 2 + 1] = S;
    }
    __syncthreads();
}
__device__ __forceinline__ void scan_final_item(Frame& F, int c) {
    const bf16* Z = (const bf16*)(F.ws + WS_Z); bf16* BR = (bf16*)(F.ws + WS_BR);
    const float* AB = (const float*)(F.ws + WS_AB); const float* PS = (const float*)(F.ws + WS_PS);
    LAS float* HF = (LAS float*)F.lds;
    const int ch = F.tid, row_c = 64 * c;
    float hf = 0.f, hb = 0.f;
    { const int nbefore = c >= 128 ? c - 128 : c + 4;
      for (int k = 0; k < nbefore; ++k) { const int cc = k < 4 ? 128 + k : k - 4; const float2 ps = *(const float2*)(PS + ((size_t)(0 * 132 + cc) * 512 + ch) * 2); hf = ps.x * hf + ps.y; } }
    { const int nbefore = c >= 128 ? 131 - c : 4 + (127 - c);
      for (int k = 0; k < nbefore; ++k) { const int cc = k < 4 ? 131 - k : 127 - (k - 4); const float2 ps = *(const float2*)(PS + ((size_t)(1 * 132 + cc) * 512 + ch) * 2); hb = ps.x * hb + ps.y; } }
    const float* Af = AB + ((size_t)0 * MT + row_c) * 512 + ch; const float* Bf = AB + ((size_t)1 * MT + row_c) * 512 + ch;
    const float* Abk = AB + ((size_t)2 * MT + row_c) * 512 + ch; const float* Bbk = AB + ((size_t)3 * MT + row_c) * 512 + ch;
#pragma unroll 8
    for (int t = 0; t < 64; ++t) { hf = Af[(size_t)t * 512] * hf + Bf[(size_t)t * 512]; HF[t * 512 + ch] = hf; }
#pragma unroll 8
    for (int t = 63; t >= 0; --t) { hb = Abk[(size_t)t * 512] * hb + Bbk[(size_t)t * 512];
        const float gr = bf1(Z[(size_t)(row_c + t) * ZC + ZC_GR + ch]);
        BR[(size_t)(row_c + t) * DM + 1024 + ch] = (bf16)f2bf((HF[t * 512 + ch] + hb) * gelu_tanh(gr)); }
}

__global__ void __launch_bounds__(NWAVES * 64, 2) mk_fwd(Args args) {
    extern __shared__ __attribute__((aligned(16))) unsigned char lds[];
    Frame F;
    F.lds = (LAS unsigned char*)lds;
    F.MISC = (volatile LAS unsigned*)(F.lds + MISC_OFF);
    F.tid = threadIdx.x; F.lane = F.tid & 63; F.wave = __builtin_amdgcn_readfirstlane(F.tid >> 6);
    F.G = gridDim.x;
    F.ka = (const KAS Args*)__builtin_amdgcn_kernarg_segment_ptr();
    F.out = args.out; F.ws = args.ws;
    F.ctl = (gu32*)(F.ws + WS_CTL);
    for (int u = F.tid; u < (LDS_BYTES - LDSCTL_OFF) / 4; u += NWAVES * 64) ((LAS unsigned*)(F.lds + LDSCTL_OFF))[u] = 0u;
    __syncthreads();
#if MK_ONE_LAUNCH
    XcdBarrier bar = xcd_barrier_post((unsigned*)(F.ctl + CW_BAR), F.MISC + 8);
#define GRID_BAR() xcd_barrier(bar)
#else
#define GRID_BAR() do { } while (0)
#endif
    const int lo = args.ph_lo, hi = args.ph_hi;
#define IN(k) (lo <= (k) && (k) < hi)
#ifndef PHMASK
#define PHMASK 0x7ff
#endif
#define PHON(b) (((PHMASK) >> (b)) & 1)
#ifndef REPMASK
#define REPMASK 0
#endif
#define REPS(b) ((((REPMASK) >> (b)) & 1) ? 2 : 1)
#define FRESH() do { int t_ = threadIdx.x; asm volatile("" : "+v"(t_)); F.tid = t_; F.lane = t_ & 63; } while (0)
#define SEAM(k) do { if (IN(k) && IN((k) + 1)) GRID_BAR(); } while (0)

    for (int rep_ = 0; rep_ < REPS(0); ++rep_) { if (rep_) GRID_BAR(); if (PHON(0) && IN(0)) { FRESH(); p0_prologue(F); } }
    SEAM(0);

    for (int l = 0; l < DEPTH; ++l) {
        const int pb = 1 + l * NPL;
        const bool last = (l == DEPTH - 1);
        const int Mg = last ? SEQ : MT;
        unsigned char* wl = F.ws + WS_W + (size_t)l * WL_STRIDE;
        const float* modl = (const float*)(F.ws + WS_MOD) + (size_t)(l * 2) * NMOD; const float* modc = modl + NMOD;

        for (int rep_ = 0; rep_ < REPS(1); ++rep_) { if (rep_) GRID_BAR();
        if (PHON(1) && IN(pb + 0)) { FRESH(); norm_phase<11>(F, l, 0, MT, rep_ == 0 && l > 0, modc - 2 * NMOD + 5 * DM); }
        }
        SEAM(pb + 0);

        for (int rep_ = 0; rep_ < REPS(2); ++rep_) { if (rep_) GRID_BAR();
        if (PHON(2) && IN(pb + 1)) {
            pg8::Gemm g{(const pg8::bf16_t*)(F.ws + WS_H), (const pg8::bf16_t*)(wl + WL_IN), MT, INC, DM, DM}; pg8::StaticOrder S; S.init(MT, INC, F.G, (int)blockIdx.x);
            pg8::EpiIn E{(pg8::bf16_t*)(F.ws + WS_Z), (pg8::bf16_t*)(F.ws + WS_G), F.ka->in[I_BGATE] + (size_t)l * GC, (const float*)(F.ws + WS_ROPE), (const float*)(F.ws + WS_ROPE) + 2048};
            pg8::gemm_phase<pg8::EpiIn, pg8::StaticOrder, true, true>(F.lds, g, S, E);
        }
        }
        SEAM(pb + 1);

        for (int rep_ = 0; rep_ < REPS(3); ++rep_) { if (rep_) GRID_BAR();
        if (PHON(3) && IN(pb + 2)) {
            FRESH(); __syncthreads();
#ifndef MIXMASK
#define MIXMASK 15
#endif
            if (MIXMASK & 1) for (int c = blockIdx.x; c < 132; c += F.G) scan_gate_item(F, l, c);
            FRESH();
            __syncthreads();
            const int nqt = last ? 256 : 264, nitems = 2 * nqt * 8;
            const int gw = blockIdx.x * NWAVES + F.wave, NGW = F.G * NWAVES;
            LAS unsigned char* wlds = F.lds + F.wave * ATT_WAVE_LDS;
            for (int it = gw; it < nitems; it += NGW) { const bool isb = it >= nqt * 8; if ((MIXMASK & 2) && !isb) attn_item(F, l, it, nqt, wlds); if ((MIXMASK & 4) && isb) attn_item(F, l, it, nqt, wlds); }
            FRESH(); if (MIXMASK & 8) dconv_phase(F, l, last ? SEQ : MT);
        }
        }
        SEAM(pb + 2);

        for (int rep_ = 0; rep_ < REPS(4); ++rep_) { if (rep_) GRID_BAR();
        if (PHON(4) && IN(pb + 3)) {
            FRESH(); __syncthreads();
            const int nch = last ? 128 : 132;
            for (int c = blockIdx.x; c < nch; c += F.G) { scan_final_item(F, c); __syncthreads(); }
        }
        }
        SEAM(pb + 3);

        for (int rep_ = 0; rep_ < REPS(5); ++rep_) { if (rep_) GRID_BAR();
        if (PHON(5) && IN(pb + 4)) {
            __syncthreads();
            pg8::Gemm g{(const pg8::bf16_t*)(F.ws + WS_BR), (const pg8::bf16_t*)(wl + WL_BR), Mg, DM, DM, DM}; pg8::StaticOrder S; S.init(Mg, DM, F.G, (int)blockIdx.x);
            pg8::EpiMerge E{(const pg8::bf16_t*)(F.ws + WS_G), (pg8::bf16_t*)(F.ws + WS_MG)};
            pg8::gemm_phase<pg8::EpiMerge, pg8::StaticOrder, true, true>(F.lds, g, S, E);
        }
        }
        SEAM(pb + 4);

        for (int rep_ = 0; rep_ < REPS(6); ++rep_) { if (rep_) GRID_BAR();
        if (PHON(6) && IN(pb + 5)) {
            pg8::Gemm g{(const pg8::bf16_t*)(F.ws + WS_MG), (const pg8::bf16_t*)(wl + WL_OUT), SEQ, DM, DM, DM}; pg8::StaticOrder S; S.init(SEQ, DM, F.G, (int)blockIdx.x);
            pg8::EpiResid E{rep_ ? (float*)(F.ws + WS_END) : F.out, rep_ ? (float*)(F.ws + WS_END) + (size_t)SEQ * DM : (float*)(F.ws + WS_XC), modl + 2 * DM, modc + 2 * DM};
            pg8::gemm_phase<pg8::EpiResid, pg8::StaticOrder, true, true>(F.lds, g, S, E);
            if (!last) {
                pg8::Gemm gc{(const pg8::bf16_t*)(F.ws + WS_MG), (const pg8::bf16_t*)(wl + WL_OUT), MT, DM, 256, DM}; pg8::SplitKOrder SC{32, DM / 256, 8, 256, F.G, (int)blockIdx.x};
                pg8::EpiSlab EC{(float*)(F.ws + WS_SLAB), 256};
                pg8::gemm_phase<pg8::EpiSlab, pg8::SplitKOrder, true, true>(F.lds, gc, SC, EC);
            }
        }
        }
        SEAM(pb + 5);

        for (int rep_ = 0; rep_ < REPS(7); ++rep_) { if (rep_) GRID_BAR();
        if (PHON(7) && IN(pb + 6)) { FRESH(); norm_phase<8>(F, l, 1, Mg, rep_ == 0 && !last, modc + 2 * DM); }
        }
        SEAM(pb + 6);

        for (int rep_ = 0; rep_ < REPS(8); ++rep_) { if (rep_) GRID_BAR();
        if (PHON(8) && IN(pb + 7)) {
            pg8::Gemm g{(const pg8::bf16_t*)(F.ws + WS_H), (const pg8::bf16_t*)(wl + WL_F1), Mg, F2, DM, DM}; pg8::StaticOrder S; S.init(Mg, F2, F.G, (int)blockIdx.x);
            pg8::EpiSwiglu E{(pg8::bf16_t*)(F.ws + WS_FH)};
            pg8::gemm_phase<pg8::EpiSwiglu, pg8::StaticOrder, true, true>(F.lds, g, S, E);
        }
        }
        SEAM(pb + 7);

        for (int rep_ = 0; rep_ < REPS(9); ++rep_) { if (rep_) GRID_BAR();
        if (PHON(9) && IN(pb + 8)) {
            pg8::Gemm g{(const pg8::bf16_t*)(F.ws + WS_FH), (const pg8::bf16_t*)(wl + WL_F2), SEQ, DM, FHID, FHID}; pg8::StaticOrder S; S.init(SEQ, DM, F.G, (int)blockIdx.x);
            pg8::EpiResid E{rep_ ? (float*)(F.ws + WS_END) : F.out, rep_ ? (float*)(F.ws + WS_END) + (size_t)SEQ * DM : (float*)(F.ws + WS_XC), modl + 5 * DM, modc + 5 * DM};
            pg8::gemm_phase<pg8::EpiResid, pg8::StaticOrder, true, true>(F.lds, g, S, E);
            if (!last) {
                pg8::Gemm gc{(const pg8::bf16_t*)(F.ws + WS_FH), (const pg8::bf16_t*)(wl + WL_F2), MT, DM, 512, FHID}; pg8::SplitKOrder SC{32, DM / 256, 11, 512, F.G, (int)blockIdx.x};
                pg8::EpiSlab EC{(float*)(F.ws + WS_SLAB), 512};
                pg8::gemm_phase<pg8::EpiSlab, pg8::SplitKOrder, true, true>(F.lds, gc, SC, EC);
            }
        }
        }
        SEAM(pb + 8);
    }

    if (PHON(10) && IN(N_PHASES - 1)) { FRESH(); final_norm_phase(F); }
#undef IN
#undef SEAM
}

extern "C" void kernel_launch(void* const* d_in, const int* in_sizes, int n_in, void* d_out, int out_size, void* d_ws, size_t ws_size, hipStream_t stream) {
    static int grid = 0;
    if (grid == 0) {
        if (n_in != 25 || out_size != SEQ * DM || ws_size < WS_NEED) { fprintf(stderr, "kernel_launch: unexpected problem (n_in %d, out %d, ws %zu, need %zu)\n", n_in, out_size, ws_size, (size_t)WS_NEED); grid = -1; return; }
        int dev = 0, cus = 0, per_cu = 0;
        if (hipGetDevice(&dev) != hipSuccess || hipDeviceGetAttribute(&cus, hipDeviceAttributeMultiprocessorCount, dev) != hipSuccess) { grid = -1; return; }
        if (hipFuncSetAttribute((const void*)mk_fwd, hipFuncAttributeMaxDynamicSharedMemorySize, LDS_BYTES) != hipSuccess) { fprintf(stderr, "kernel_launch: hipFuncSetAttribute failed\n"); grid = -1; return; }
        if (hipOccupancyMaxActiveBlocksPerMultiprocessor(&per_cu, (const void*)mk_fwd, NWAVES * 64, LDS_BYTES) != hipSuccess || per_cu < 1) fprintf(stderr, "kernel_launch: occupancy query reports %d\n", per_cu);
        (void)hipGetLastError();
        grid = cus;
    }
    if (grid < 0) return;
    (void)hipMemsetAsync((char*)d_ws + WS_CTL, 0, CTL_ZERO_BYTES, stream);
    Args a{};
    for (int i = 0; i < 25; ++i) a.in[i] = (const float*)d_in[i];
    a.out = (float*)d_out; a.ws = (unsigned char*)d_ws;
#if MK_ONE_LAUNCH
    a.ph_lo = 0; a.ph_hi = N_PHASES;
    hipLaunchKernelGGL(mk_fwd, dim3(grid), dim3(NWAVES * 64), LDS_BYTES, stream, a);
#else
    for (int p = 0; p < N_PHASES; ++p) { a.ph_lo = p; a.ph_hi = p + 1; hipLaunchKernelGGL(mk_fwd, dim3(grid), dim3(NWAVES * 64), LDS_BYTES, stream, a); }
#endif
}
```

```cpp
#include <hip/hip_runtime.h>
#include <cstdio>
#include <cstdint>
namespace pg8 {
#define PG8_LAS __attribute__((address_space(3)))
typedef unsigned short bf16_t;
typedef short bf16x8 __attribute__((ext_vector_type(8)));
typedef float f32x4 __attribute__((ext_vector_type(4)));
typedef unsigned u32x4 __attribute__((ext_vector_type(4)));
constexpr int BM = 256, BK = 64, HALF = 128, HTB = HALF * BK * 2  , STAGE_BYTES = 8 * HTB, NXCD = 8, WGM = 8;

__host__ __device__ __forceinline__ int lds_byte(int r, int c) { const int st = (r >> 4) * 2 + (c >> 5), rr = r & 15, cc = c & 31, ob = rr * 64 + cc * 2; return st * 1024 + (ob ^ (((ob >> 9) & 1) << 5)); }
__host__ __device__ __forceinline__ void stage_rc(int b, int& R, int& C) { const int st = b / 1024, sb = b % 1024, swz = sb ^ (((sb >> 9) & 1) << 5); R = (st >> 1) * 16 + swz / 64; C = (st & 1) * 32 + (swz % 64) / 2; }
__host__ __device__ __forceinline__ int perm32(int rho) { const int n = rho >> 4, i = rho & 15; return 8 * (i >> 2) + 4 * n + (i & 3); }

struct Unit { int pm, pn, ko; };
struct Gemm { const bf16_t* A; const bf16_t* Bt; int M, N, K, ld; };

struct StaticOrder {
    int nM, nN, nwg, G, c;
    __host__ __device__ void init(int M, int N, int G_, int c_) { nM = M / BM; nN = N / BM; nwg = nM * nN; G = G_; c = c_; }
    __host__ __device__ bool next(int i, Unit& u) const {
        const long L = (long)i * G + c; if (L >= nwg) return false;
        int wgid = (int)L; { const int q = nwg / NXCD, r = nwg % NXCD, xcd = wgid % NXCD, off = wgid / NXCD; wgid = (xcd < r ? xcd * (q + 1) : r * (q + 1) + (xcd - r) * q) + off; }
        const int nig = WGM * nN, gid = wgid / nig, fm = gid * WGM, gsz = (nM - fm) < WGM ? (nM - fm) : WGM;
        u.pm = fm + ((wgid % nig) % gsz); u.pn = (wgid % nig) / gsz; u.ko = 0; return true;
    }
    __device__ __forceinline__ void a_ready(const Unit&) const {}
    __device__ __forceinline__ void done(const Unit&) const {}
};
typedef float f32x2 __attribute__((ext_vector_type(2)));
typedef __bf16 bf16x2_t __attribute__((ext_vector_type(2)));
__device__ __forceinline__ unsigned cvt_pk_bf16(float lo, float hi) { f32x2 v = {lo, hi}; bf16x2_t b = __builtin_convertvector(v, bf16x2_t); return __builtin_bit_cast(unsigned, b); }
__device__ __forceinline__ float sigmoidf_fast(float x) { return __builtin_amdgcn_rcpf(1.0f + __expf(-x)); }
__device__ __forceinline__ float bf2f(unsigned short b) { return __uint_as_float(((unsigned)b) << 16); }

struct EpiIn {
    static constexpr bool PERM = true, AFTER_DRAIN = false, HAS_MID = false;
    bf16_t* Z; bf16_t* G; const float* bgate; const float* ropec; const float* ropes;
    __device__ __forceinline__ void operator()(const f32x4 (&acc)[2][2][4][2], const Unit& u, int wr, int wc, int fr, int fq) const {
        const int row0 = u.pm * BM + wr * 64 + fr;
        if (u.pn >= 19) {
            const int col0 = (u.pn - 19) * BM + wc * 32 + 8 * fq;
            f32x4 bv[2][2];
#pragma unroll
            for (int bj = 0; bj < 2; ++bj)
#pragma unroll
                for (int n = 0; n < 2; ++n) bv[bj][n] = *(const f32x4*)(bgate + col0 + bj * HALF + 4 * n);
#pragma unroll
            for (int ai = 0; ai < 2; ++ai)
#pragma unroll
                for (int m = 0; m < 4; ++m) { bf16_t* rowp = G + (size_t)(row0 + ai * HALF + m * 16) * 8192 + col0;
#pragma unroll
                    for (int bj = 0; bj < 2; ++bj) { const f32x4 v0 = acc[ai][bj][m][0] + bv[bj][0], v1 = acc[ai][bj][m][1] + bv[bj][1];
                        u32x4 w; w.x = cvt_pk_bf16(sigmoidf_fast(v0[0]), sigmoidf_fast(v0[1])); w.y = cvt_pk_bf16(sigmoidf_fast(v0[2]), sigmoidf_fast(v0[3]));
                        w.z = cvt_pk_bf16(sigmoidf_fast(v1[0]), sigmoidf_fast(v1[1])); w.w = cvt_pk_bf16(sigmoidf_fast(v1[2]), sigmoidf_fast(v1[3]));
                        *(u32x4*)(rowp + bj * HALF) = w; } }
        } else {
            const int colt = u.pn * BM, col0 = colt + wc * 32 + 8 * fq;
            const bool rope_tile = (u.pn <= 2) && (u.pm < 32);
#pragma unroll
            for (int ai = 0; ai < 2; ++ai)
#pragma unroll
                for (int m = 0; m < 4; ++m) { const int t = row0 + ai * HALF + m * 16; bf16_t* rowp = Z + (size_t)t * 4864 + col0;
#pragma unroll
                    for (int bj = 0; bj < 2; ++bj) { f32x4 v0 = acc[ai][bj][m][0], v1 = acc[ai][bj][m][1];
                        if (rope_tile && (colt + bj * HALF < 640)) {
                            const int pos = (wc & 1) ? (t & 63) : (t >> 6);
                            const float* cp = ropec + pos * 16 + 8 * (fq & 1); const float* sp = ropes + pos * 16 + 8 * (fq & 1);
                            const f32x4 c0 = *(const f32x4*)cp, c1 = *(const f32x4*)(cp + 4), s0 = *(const f32x4*)sp, s1 = *(const f32x4*)(sp + 4);
                            f32x4 p0, p1;
#pragma unroll
                            for (int e = 0; e < 4; ++e) { p0[e] = __shfl_xor(v0[e], 32); p1[e] = __shfl_xor(v1[e], 32); }
                            if (fq < 2) { v0 = v0 * c0 - p0 * s0; v1 = v1 * c1 - p1 * s1; }
                            else        { v0 = p0 * s0 + v0 * c0; v1 = p1 * s1 + v1 * c1; }
                        }
                        u32x4 w; w.x = cvt_pk_bf16(v0[0], v0[1]); w.y = cvt_pk_bf16(v0[2], v0[3]); w.z = cvt_pk_bf16(v1[0], v1[1]); w.w = cvt_pk_bf16(v1[2], v1[3]);
                        *(u32x4*)(rowp + bj * HALF) = w; } }
        }
    }
};

struct EpiMerge {
    static constexpr bool PERM = true, AFTER_DRAIN = false, HAS_MID = true;
    const bf16_t* G; bf16_t* O;
    __device__ __forceinline__ void mid(f32x4 (&acc)[2][2][4][2], const Unit& u, int seg, int wr, int wc, int fr, int fq) const {
        int row0 = u.pm * BM + wr * 64 + fr; asm volatile("" : "+v"(row0));
        const int col0 = u.pn * BM + wc * 32 + 8 * fq;
#pragma unroll
        for (int ai = 0; ai < 2; ++ai)
#pragma unroll
            for (int m = 0; m < 4; ++m) { const bf16_t* rowp = G + (size_t)(row0 + ai * HALF + m * 16) * 8192 + col0 + seg * 2048;
#pragma unroll
                for (int bj = 0; bj < 2; ++bj) { const u32x4 ga = *(const u32x4*)(rowp + bj * HALF), gb = *(const u32x4*)(rowp + 2048 + bj * HALF);
#pragma unroll
                    for (int e = 0; e < 4; ++e) { const unsigned a = ga[e], b = gb[e];
                        const float a0 = fmaxf(__uint_as_float(a << 16), 1e-30f), a1 = fmaxf(__uint_as_float(a & 0xffff0000u), 1e-30f);
                        const float b0 = fmaxf(__uint_as_float(b << 16), 1e-30f), b1 = fmaxf(__uint_as_float(b & 0xffff0000u), 1e-30f);
                        acc[ai][bj][m][e >> 1][(e & 1) * 2]     *= a0 * __builtin_amdgcn_rcpf(b0);
                        acc[ai][bj][m][e >> 1][(e & 1) * 2 + 1] *= a1 * __builtin_amdgcn_rcpf(b1); } }
                asm volatile("" ::: "memory"); }
    }
    __device__ __forceinline__ void operator()(const f32x4 (&acc)[2][2][4][2], const Unit& u, int wr, int wc, int fr, int fq) const {
        const int row0 = u.pm * BM + wr * 64 + fr, col0 = u.pn * BM + wc * 32 + 8 * fq;
#pragma unroll
        for (int ai = 0; ai < 2; ++ai)
#pragma unroll
            for (int m = 0; m < 4; ++m) { const size_t r = (size_t)(row0 + ai * HALF + m * 16); const bf16_t* gp = G + r * 8192 + col0 + 3 * 2048; bf16_t* op = O + r * 2048 + col0;
#pragma unroll
                for (int bj = 0; bj < 2; ++bj) { const u32x4 g = *(const u32x4*)(gp + bj * HALF); float gv[8];
#pragma unroll
                    for (int e = 0; e < 4; ++e) { gv[2 * e] = fmaxf(__uint_as_float(g[e] << 16), 1e-30f); gv[2 * e + 1] = fmaxf(__uint_as_float(g[e] & 0xffff0000u), 1e-30f); }
                    const f32x4 v0 = acc[ai][bj][m][0], v1 = acc[ai][bj][m][1];
                    u32x4 w; w.x = cvt_pk_bf16(v0[0] * gv[0], v0[1] * gv[1]); w.y = cvt_pk_bf16(v0[2] * gv[2], v0[3] * gv[3]); w.z = cvt_pk_bf16(v1[0] * gv[4], v1[1] * gv[5]); w.w = cvt_pk_bf16(v1[2] * gv[6], v1[3] * gv[7]);
                    *(u32x4*)(op + bj * HALF) = w; }
                asm volatile("" ::: "memory"); }
    }
};

struct EpiResid {
    static constexpr bool PERM = false, AFTER_DRAIN = false, HAS_MID = false;
    float* xl; float* xc; const float* gate_l; const float* gate_c;
    __device__ __forceinline__ void operator()(const f32x4 (&acc)[2][2][4][2], const Unit& u, int wr, int wc, int fr, int fq) const {
        const int row0 = u.pm * BM + wr * 64 + fr, col0 = u.pn * BM + wc * 32 + 4 * fq;
        const bool lat = u.pm < 32;
        float* X = lat ? xl : (xc - (size_t)8192 * 2048); const float* gate = lat ? gate_l : gate_c;
        f32x4 gv[2][2];
#pragma unroll
        for (int bj = 0; bj < 2; ++bj)
#pragma unroll
            for (int n = 0; n < 2; ++n) gv[bj][n] = *(const f32x4*)(gate + col0 + bj * HALF + n * 16);
#pragma unroll
        for (int ai = 0; ai < 2; ++ai)
#pragma unroll
            for (int m = 0; m < 4; ++m) { float* rowp = X + (size_t)(row0 + ai * HALF + m * 16) * 2048 + col0;
#pragma unroll
                for (int bj = 0; bj < 2; ++bj)
#pragma unroll
                    for (int n = 0; n < 2; ++n) { f32x4* q = (f32x4*)(rowp + bj * HALF + n * 16); *q = *q + gv[bj][n] * acc[ai][bj][m][n]; }
                if (m & 1) asm volatile("" ::: "memory"); }
    }
};

struct EpiSwiglu {
    static constexpr bool PERM = true, AFTER_DRAIN = false, HAS_MID = false;
    bf16_t* O;
    __device__ __forceinline__ void operator()(const f32x4 (&acc)[2][2][4][2], const Unit& u, int wr, int wc, int fr, int fq) const {
        const int row0 = u.pm * BM + wr * 64 + fr, col0 = u.pn * HALF + wc * 32 + 8 * fq;
#pragma unroll
        for (int ai = 0; ai < 2; ++ai)
#pragma unroll
            for (int m = 0; m < 4; ++m) { bf16_t* op = O + (size_t)(row0 + ai * HALF + m * 16) * 5632 + col0; float o[8];
#pragma unroll
                for (int n = 0; n < 2; ++n)
#pragma unroll
                    for (int e = 0; e < 4; ++e) { const float g = acc[ai][0][m][n][e], uu = acc[ai][1][m][n][e]; o[4 * n + e] = g * sigmoidf_fast(g) * uu; }
                u32x4 w; w.x = cvt_pk_bf16(o[0], o[1]); w.y = cvt_pk_bf16(o[2], o[3]); w.z = cvt_pk_bf16(o[4], o[5]); w.w = cvt_pk_bf16(o[6], o[7]);
                *(u32x4*)op = w; }
    }
};


struct SplitKOrder {
    int pm, nN, S, ksub, G, c;
    __host__ __device__ bool next(int i, Unit& u) const { const int L = i * G + (G - 1 - c); if (L >= nN * S) return false; u.pm = pm; u.pn = L % nN; u.ko = (L / nN) * ksub; return true; }
    __device__ __forceinline__ void a_ready(const Unit&) const {}
    __device__ __forceinline__ void done(const Unit&) const {}
};
struct EpiSlab {
    static constexpr bool PERM = false, AFTER_DRAIN = false, HAS_MID = false;
    float* slab; int ksub;
    __device__ __forceinline__ void operator()(const f32x4 (&acc)[2][2][4][2], const Unit& u, int wr, int wc, int fr, int fq) const {
        const int row0 = wr * 64 + fr, col0 = u.pn * BM + wc * 32 + 4 * fq;
        float* base = slab + (size_t)(u.ko / ksub) * 256 * 2048;
#pragma unroll
        for (int ai = 0; ai < 2; ++ai)
#pragma unroll
            for (int m = 0; m < 4; ++m) { float* rowp = base + (size_t)(row0 + ai * HALF + m * 16) * 2048 + col0;
#pragma unroll
                for (int bj = 0; bj < 2; ++bj)
#pragma unroll
                    for (int n = 0; n < 2; ++n) *(f32x4*)(rowp + bj * HALF + n * 16) = acc[ai][bj][m][n]; }
    }
};
template <class Epi, class Sched, bool ALIGN_EPI = false, bool SP2 = false>
__device__ __forceinline__ void gemm_phase(PG8_LAS unsigned char* lds, const Gemm g, const Sched& S, const Epi& E) {
    int tid_ = threadIdx.x; asm volatile("" : "+v"(tid_));
    const int tid = tid_, wid = __builtin_amdgcn_readfirstlane(tid >> 6), lane = tid & 63, wr = wid >> 2, wc = wid & 3, fr = lane & 15, fq = lane >> 4;
    const int K = g.ld, nt = g.K / BK;
    unsigned voffA[2], voffB[2];
#pragma unroll
    for (int i = 0; i < 2; ++i) { int R, C; stage_rc(tid * 16 + i * 8192, R, C); const int Rb = Epi::PERM ? ((R & ~31) + perm32(R & 31)) : R;
        voffA[i] = (unsigned)(R * K + C) * 2u; voffB[i] = (unsigned)(Rb * K + C) * 2u; }
    const size_t kstep = (size_t)(BK * 2);
    const size_t hstep = (size_t)HALF * K * 2;
    const size_t tstep = 2 * hstep;
    const unsigned ldsw = (unsigned)wid * 1024u;
    const int aoff = lds_byte(wr * 64 + fr, fq * 8), boff = lds_byte(wc * 32 + fr, fq * 8);
#define PG8_SA(b, h) (((b) * 2 + (h)) * HTB)
#define PG8_SB(b, h) ((4 + (b) * 2 + (h)) * HTB)
#define PG8_STAGE(bufoff, gbase, voff) do { _Pragma("unroll") for (int _i = 0; _i < 2; ++_i) \
        __builtin_amdgcn_global_load_lds((const unsigned*)((const char*)(gbase) + (voff)[_i]), (PG8_LAS unsigned*)(lds + (bufoff) + ldsw + _i * 8192), 16, 0, 0); } while (0)
#define PG8_LDA(dst, b, h) do { _Pragma("unroll") for (int m = 0; m < 4; ++m) _Pragma("unroll") for (int k = 0; k < 2; ++k) dst[m][k] = *(const PG8_LAS bf16x8*)(lds + PG8_SA(b, h) + aoff + m * 2048 + k * 1024); } while (0)
#define PG8_LDB(dst, b, h) do { _Pragma("unroll") for (int n = 0; n < 2; ++n) _Pragma("unroll") for (int k = 0; k < 2; ++k) dst[n][k] = *(const PG8_LAS bf16x8*)(lds + PG8_SB(b, h) + boff + n * 2048 + k * 1024); } while (0)
#define PG8_MMA(ai, bj, At, Bt) do { __builtin_amdgcn_s_setprio(1); _Pragma("unroll") for (int m = 0; m < 4; ++m) _Pragma("unroll") for (int n = 0; n < 2; ++n) _Pragma("unroll") for (int k = 0; k < 2; ++k) \
        acc[ai][bj][m][n] = __builtin_amdgcn_mfma_f32_16x16x32_bf16(Bt[n][k], At[m][k], acc[ai][bj][m][n], 0, 0, 0); __builtin_amdgcn_s_setprio(0); } while (0)
#define PG8_WAIT_V(n) asm volatile("s_waitcnt vmcnt(" #n ")" ::: "memory")
#define PG8_WAIT_L(n) asm volatile("s_waitcnt lgkmcnt(" #n ")" ::: "memory")
#define PG8_BAR __builtin_amdgcn_s_barrier()
#define PG8_SCHED __builtin_amdgcn_sched_barrier(0)
    Unit cur, nxt; int ui = 0;
    if (!S.next(0, cur)) return;
    f32x4 acc[2][2][4][2];
#pragma unroll
    for (int a = 0; a < 2; ++a)
#pragma unroll
        for (int b = 0; b < 2; ++b)
#pragma unroll
            for (int m = 0; m < 4; ++m)
#pragma unroll
                for (int n = 0; n < 2; ++n) acc[a][b][m][n] = (f32x4){0.f, 0.f, 0.f, 0.f};
    bf16x8 At[4][2], B0[2][2], B1[2][2];
    const char* cA = (const char*)g.A + (size_t)cur.pm * tstep + (size_t)cur.ko * 2; const char* cB = (const char*)g.Bt + (size_t)cur.pn * tstep + (size_t)cur.ko * 2;
    S.a_ready(cur);
    if constexpr (SP2) {
        PG8_STAGE(PG8_SB(0, 0), cB, voffB); PG8_STAGE(PG8_SB(0, 1), cB + hstep, voffB); PG8_STAGE(PG8_SA(0, 0), cA, voffA); PG8_STAGE(PG8_SA(0, 1), cA + hstep, voffA);
        if (wr == 1) PG8_BAR;
        PG8_WAIT_V(2); PG8_BAR;
        PG8_STAGE(PG8_SB(1, 0), cB + kstep, voffB); PG8_STAGE(PG8_SA(1, 0), cA + kstep, voffA); PG8_STAGE(PG8_SB(1, 1), cB + hstep + kstep, voffB);
        PG8_WAIT_V(6); PG8_BAR;
    } else {
        PG8_STAGE(PG8_SB(0, 0), cB, voffB); PG8_STAGE(PG8_SA(0, 0), cA, voffA); PG8_STAGE(PG8_SB(0, 1), cB + hstep, voffB); PG8_STAGE(PG8_SA(0, 1), cA + hstep, voffA);
        if (wr == 1) PG8_BAR;
        PG8_WAIT_V(4); PG8_BAR;
        PG8_STAGE(PG8_SB(1, 0), cB + kstep, voffB); PG8_STAGE(PG8_SA(1, 0), cA + kstep, voffA); PG8_STAGE(PG8_SB(1, 1), cB + hstep + kstep, voffB);
        PG8_WAIT_V(6); PG8_BAR;
    }
    for (;;) {
        const bool has_next = S.next(ui + 1, nxt);
        const char* nA = has_next ? (const char*)g.A + (size_t)nxt.pm * tstep + (size_t)nxt.ko * 2 : cA; const char* nB = has_next ? (const char*)g.Bt + (size_t)nxt.pn * tstep + (size_t)nxt.ko * 2 : cB;
        for (int t = 0; t < nt; t += 2) {
            const bool last = (t == nt - 2);
            const char* a1 = cA + (size_t)(t + 1) * kstep;
            const char* a2 = last ? nA : cA + (size_t)(t + 2) * kstep; const char* b2 = last ? nB : cB + (size_t)(t + 2) * kstep;
            const char* a3 = a2 + kstep; const char* b3 = b2 + kstep;
            if (last && has_next) S.a_ready(nxt);
            if constexpr (SP2) {
            PG8_LDB(B0, 0, 0); PG8_LDB(B1, 0, 1); PG8_SCHED; PG8_LDA(At, 0, 0); PG8_STAGE(PG8_SA(1, 1), a1 + hstep, voffA);
            PG8_WAIT_V(8); PG8_WAIT_L(0); PG8_BAR; PG8_MMA(0, 0, At, B0); PG8_MMA(0, 1, At, B1); PG8_BAR; PG8_SCHED;
            PG8_LDA(At, 0, 1); PG8_STAGE(PG8_SB(0, 0), b2, voffB); PG8_STAGE(PG8_SB(0, 1), b2 + hstep, voffB); PG8_STAGE(PG8_SA(0, 0), a2, voffA);
            PG8_WAIT_V(8); PG8_WAIT_L(0); PG8_BAR; PG8_MMA(1, 0, At, B0); PG8_MMA(1, 1, At, B1); PG8_BAR; PG8_SCHED;
            PG8_LDB(B0, 1, 0); PG8_LDB(B1, 1, 1); PG8_SCHED; PG8_LDA(At, 1, 0); PG8_STAGE(PG8_SA(0, 1), a2 + hstep, voffA);
            PG8_WAIT_V(8); PG8_WAIT_L(0); PG8_BAR; PG8_MMA(0, 0, At, B0); PG8_MMA(0, 1, At, B1); PG8_BAR; PG8_SCHED;
            PG8_LDA(At, 1, 1); PG8_STAGE(PG8_SB(1, 0), b3, voffB); PG8_STAGE(PG8_SB(1, 1), b3 + hstep, voffB); PG8_STAGE(PG8_SA(1, 0), a3, voffA);
            PG8_WAIT_V(8); PG8_WAIT_L(0); PG8_BAR; PG8_MMA(1, 0, At, B0); PG8_MMA(1, 1, At, B1); PG8_BAR; PG8_SCHED;
            } else {
            PG8_LDB(B0, 0, 0); PG8_SCHED; PG8_LDA(At, 0, 0); PG8_STAGE(PG8_SA(1, 1), a1 + hstep, voffA);
            PG8_WAIT_L(8); PG8_BAR; PG8_WAIT_L(0); PG8_MMA(0, 0, At, B0); PG8_BAR; PG8_SCHED;
            PG8_LDB(B1, 0, 1); PG8_STAGE(PG8_SB(0, 0), b2, voffB);
            PG8_BAR; PG8_WAIT_L(0); PG8_MMA(0, 1, At, B1); PG8_BAR;
            PG8_LDA(At, 0, 1); PG8_STAGE(PG8_SA(0, 0), a2, voffA);
            PG8_BAR; PG8_WAIT_L(0); PG8_MMA(1, 0, At, B0); PG8_BAR; PG8_SCHED;
            PG8_STAGE(PG8_SB(0, 1), b2 + hstep, voffB);
            PG8_WAIT_V(6); PG8_BAR; PG8_MMA(1, 1, At, B1); PG8_BAR;
            PG8_LDB(B0, 1, 0); PG8_SCHED; PG8_LDA(At, 1, 0); PG8_STAGE(PG8_SA(0, 1), a2 + hstep, voffA);
            PG8_WAIT_L(8); PG8_BAR; PG8_WAIT_L(0); PG8_MMA(0, 0, At, B0); PG8_BAR; PG8_SCHED;
            PG8_LDB(B1, 1, 1); PG8_STAGE(PG8_SB(1, 0), b3, voffB);
            PG8_BAR; PG8_WAIT_L(0); PG8_MMA(0, 1, At, B1); PG8_BAR;
            PG8_LDA(At, 1, 1); PG8_STAGE(PG8_SA(1, 0), a3, voffA);
            PG8_BAR; PG8_WAIT_L(0); PG8_MMA(1, 0, At, B0); PG8_BAR; PG8_SCHED;
            PG8_STAGE(PG8_SB(1, 1), b3 + hstep, voffB);
            PG8_WAIT_V(6); PG8_BAR; PG8_MMA(1, 1, At, B1); PG8_BAR;
            }
            if constexpr (Epi::HAS_MID) { if ((((t + 2) & 7) == 0) && ((t + 2) < nt)) E.mid(acc, cur, ((t + 2) >> 3) - 1, wr, wc, fr, fq); }
        }
        if constexpr (ALIGN_EPI) { if (wr == 0) PG8_BAR; }
        if constexpr (!Epi::AFTER_DRAIN) { E(acc, cur, wr, wc, fr, fq); S.done(cur); }
        if (!has_next) break;
#pragma unroll
        for (int a = 0; a < 2; ++a)
#pragma unroll
            for (int b = 0; b < 2; ++b)
#pragma unroll
                for (int m = 0; m < 4; ++m)
#pragma unroll
                    for (int n = 0; n < 2; ++n) acc[a][b][m][n] = (f32x4){0.f, 0.f, 0.f, 0.f};
        cur = nxt; cA = nA; cB = nB; ++ui;
        if constexpr (ALIGN_EPI) { if (wr == 1) PG8_BAR; }
    }
    PG8_WAIT_V(0);
    if constexpr (!ALIGN_EPI) { if (wr == 0) PG8_BAR; }
    PG8_BAR;
    if constexpr (Epi::AFTER_DRAIN) { E.fused(acc, cur, wr, wc, fr, fq, lds, wid, lane); S.done(cur); }
#undef PG8_SA
#undef PG8_SB
#undef PG8_STAGE
#undef PG8_LDA
#undef PG8_LDB
#undef PG8_MMA
#undef PG8_WAIT_V
#undef PG8_WAIT_L
#undef PG8_BAR
#undef PG8_SCHED
}
}

constexpr int NWAVES = 8;
constexpr int DM = 2048, SEQ = 8192, CTXL = 256, MT = SEQ + CTXL, DEPTH = 4, GRIDW = 64;
constexpr int INC = 13056, ZC = 4864, GC = 8192, BW = 512, FHID = 5632, F2 = 2 * FHID, NMOD = 6 * DM;
constexpr int ZC_QA = 0, ZC_KA = 512, ZC_VA = 640, ZC_QB = 768, ZC_KB = 1280, ZC_VB = 1792, ZC_XR = 2304, ZC_GR = 2816, ZC_XD = 3328, ZC_BD = 3840, ZC_CD = 4352;
constexpr float EPS = 1e-6f, LOG2E = 1.4426950408889634f;
constexpr int NPL = 9;
constexpr int N_PHASES = 2 + DEPTH * NPL;
#ifndef MK_ONE_LAUNCH
#define MK_ONE_LAUNCH 1
#endif
constexpr size_t MiB = 1u << 20;
constexpr size_t WS_CTL = 0, CTL_ZERO_BYTES = 1 * MiB;
constexpr size_t WS_MOD = 1 * MiB;
constexpr size_t WS_ROPE = 2 * MiB;
constexpr size_t WS_GW = 3 * MiB;
constexpr size_t WS_XC = 5 * MiB;
constexpr size_t WS_PS = 7 * MiB;
constexpr size_t WS_AB = 16 * MiB;
constexpr size_t WS_H = 88 * MiB;
constexpr size_t WS_Z = 124 * MiB;
constexpr size_t WS_G = 204 * MiB;
constexpr size_t WS_BR = 336 * MiB;
constexpr size_t WS_MG = 372 * MiB;
constexpr size_t WS_FH = 408 * MiB;
constexpr size_t WS_W = 512 * MiB;
constexpr size_t WL_IN = 0, WL_BR = 51 * MiB, WL_OUT = 59 * MiB, WL_F1 = 67 * MiB, WL_F2 = 111 * MiB, WL_STRIDE = 133 * MiB;
constexpr size_t WS_END = WS_W + DEPTH * WL_STRIDE;
constexpr size_t WS_SLAB = WS_END + 80 * MiB;
constexpr size_t WS_NEED = WS_SLAB + 24 * MiB;
static_assert((size_t)INC * DM * 2 <= WL_BR && (size_t)DM * DM * 2 <= WL_OUT - WL_BR && (size_t)F2 * DM * 2 <= WL_F2 - WL_F1 && (size_t)DM * FHID * 2 <= WL_STRIDE - WL_F2, "weight map");
static_assert(WS_AB + (size_t)4 * MT * 512 * 4 <= WS_H && WS_H + (size_t)MT * DM * 2 <= WS_Z && WS_Z + (size_t)MT * ZC * 2 <= WS_G && WS_G + (size_t)MT * GC * 2 <= WS_BR && WS_FH + (size_t)MT * FHID * 2 <= WS_W, "d_ws map");
constexpr int CW_BAR = 4096;
constexpr int RING_BYTES = 131072;
constexpr int LDSCTL_OFF = RING_BYTES, MISC_OFF = LDSCTL_OFF + 320;
constexpr int LDS_BYTES = 147456;

#define GAS __attribute__((address_space(1)))
#define LAS __attribute__((address_space(3)))
typedef unsigned short bf16;
typedef unsigned v4u __attribute__((ext_vector_type(4)));
typedef unsigned v2u __attribute__((ext_vector_type(2)));
typedef float f32x4 __attribute__((ext_vector_type(4)));
typedef float f32x16 __attribute__((ext_vector_type(16)));
typedef short bf16x8 __attribute__((ext_vector_type(8)));
typedef short s16x4 __attribute__((ext_vector_type(4)));
typedef GAS unsigned gu32;
#define RLX_AGENT __ATOMIC_RELAXED, __HIP_MEMORY_SCOPE_AGENT
#define LDS_WAIT() asm volatile("s_waitcnt lgkmcnt(0)" ::: "memory")
__device__ __forceinline__ unsigned f2bf(float f) { unsigned u = __builtin_bit_cast(unsigned, f); return (u + 0x7fffu + ((u >> 16) & 1u)) >> 16; }
__device__ __forceinline__ unsigned pk2(float lo, float hi) { return f2bf(lo) | (f2bf(hi) << 16); }
__device__ __forceinline__ float bflo(unsigned w) { return __uint_as_float(w << 16); }
__device__ __forceinline__ float bfhi(unsigned w) { return __uint_as_float(w & 0xffff0000u); }
__device__ __forceinline__ float bf1(bf16 b) { return __uint_as_float(((unsigned)b) << 16); }
__device__ __forceinline__ float sigm(float x) { return __builtin_amdgcn_rcpf(1.0f + __expf(-x)); }

#define XB_TMO      128
#define XB_XCNT(j)  (256  + 64 * (j))
#define XB_XSUB(j)  (1280 + 64 * (j))
#define XB_XGEN(j)  (2304 + 64 * (j))
#define XB_TOP      3328
#define XB_TOPGEN   3392
#define XCD_BAR_WORDS 3456
#define XB_SPIN_CAP (1u << 18)

__device__ __forceinline__ unsigned xb_ld(unsigned* p)              { return __hip_atomic_load(p, __ATOMIC_RELAXED, __HIP_MEMORY_SCOPE_AGENT); }
__device__ __forceinline__ unsigned xb_add(unsigned* p, unsigned v) { return __hip_atomic_fetch_add(p, v, __ATOMIC_RELAXED, __HIP_MEMORY_SCOPE_AGENT); }
__device__ __forceinline__ unsigned xb_xcc_id() { return (unsigned)__builtin_amdgcn_s_getreg((3 << 11) | 20) & 0xFu; }
#define XB_SPIN(cond, bar) do { unsigned _sp = 0; while (cond) { __builtin_amdgcn_s_sleep(1); \
    if ((++_sp & 255u) == 0u) { if (xb_ld(&(bar)[XB_TMO])) break; if (_sp > XB_SPIN_CAP) { atomicAdd(&(bar)[XB_TMO], 1u); break; } } } } while (0)

struct XcdBarrier {
    unsigned* bar; unsigned x;
    volatile LAS unsigned* st;
};

__device__ __forceinline__ XcdBarrier xcd_barrier_post(unsigned* bar, volatile LAS unsigned* st) {
    XcdBarrier b; b.bar = bar; b.x = xb_xcc_id(); b.st = st;
    if (threadIdx.x == 0) (void)xb_add(&bar[XB_XCNT(b.x)], 1u);
    return b;
}
__device__ __forceinline__ void xcd_barrier_complete(unsigned* bar, unsigned x, unsigned& nloc, unsigned& nx) {
    const unsigned G = gridDim.x * gridDim.y * gridDim.z;
    unsigned sum, cnt, mine, sp = 0u;
    for (;;) {
        sum = 0u; cnt = 0u; mine = 0u;
#pragma unroll
        for (unsigned j = 0; j < 16; ++j) { const unsigned c = xb_ld(&bar[XB_XCNT(j)]); sum += c; cnt += (c > 0u) ? 1u : 0u; mine = (j == x) ? c : mine; }
        if (sum == G) break;
        __builtin_amdgcn_s_sleep(1);
        if ((++sp & 255u) == 0u) { if (xb_ld(&bar[XB_TMO])) break; if (sp > XB_SPIN_CAP) { atomicAdd(&bar[XB_TMO], 1u); break; } }
    }
    nloc = mine > 0u ? mine : 1u; nx = cnt > 0u ? cnt : 1u;
}

__device__ __forceinline__ void xcd_barrier(const XcdBarrier& b) {
    asm volatile("s_waitcnt vmcnt(0)" ::: "memory");
    __syncthreads();
    if (threadIdx.x == 0) {
        unsigned* bar = b.bar;
        __builtin_amdgcn_s_waitcnt(0);
        unsigned nloc = b.st[0], nx = b.st[1];
        if (nloc == 0u) { xcd_barrier_complete(bar, b.x, nloc, nx); b.st[0] = nloc; b.st[1] = nx; }
        const unsigned old = xb_add(&bar[XB_XSUB(b.x)], 1u);
        const unsigned gen = old / nloc;
        if (old + 1u == (gen + 1u) * nloc) {
            __builtin_amdgcn_fence(__ATOMIC_RELEASE, "agent");
            asm volatile("s_waitcnt vmcnt(0)" ::: "memory");
            const unsigned og = xb_add(&bar[XB_TOP], 1u);
            const unsigned tg = og / nx;
            if (og + 1u == (tg + 1u) * nx) xb_add(&bar[XB_TOPGEN], 1u);
            else XB_SPIN(xb_ld(&bar[XB_TOPGEN]) == tg, bar);
            __builtin_amdgcn_fence(__ATOMIC_ACQUIRE, "agent");
            xb_add(&bar[XB_XGEN(b.x)], 1u);
            asm volatile("s_waitcnt vmcnt(0)" ::: "memory");
        } else {
            XB_SPIN(xb_ld(&bar[XB_XGEN(b.x)]) == gen, bar);
            __builtin_amdgcn_fence(__ATOMIC_ACQUIRE, "agent");
            asm volatile("s_waitcnt vmcnt(0)" ::: "memory");
        }
    }
    __syncthreads();
}

#define KAS __attribute__((address_space(4)))
struct Args { const float* in[25]; float* out; unsigned char* ws; int ph_lo, ph_hi; };
struct Frame {
    LAS unsigned char* lds;
    volatile LAS unsigned* MISC;
    gu32* ctl;
    int tid, lane, wave, G;
    const KAS Args* ka;
    float* out; unsigned char* ws;
};
enum { I_X = 0, I_C, I_CTX, I_CCTX, I_WMOD, I_BMOD, I_NORM1, I_NORM2, I_WIN, I_BGATE, I_ASINK, I_NBBIAS, I_CCONVW, I_CCONVB, I_CWA, I_CBA, I_CWX, I_CBX, I_CLAM, I_DCONVW, I_WBR, I_WOUT, I_WF1, I_WF2, I_FNORM };

__device__ __forceinline__ float wave_sum(float v) {
#pragma unroll
    for (int o = 1; o < 64; o <<= 1) v += __shfl_xor(v, o);
    return v;
}

__device__ __forceinline__ void transpose_item(const float* W, int ldw, int k0, int n0, bf16* dst, int ldt, LAS float* scr, int lane) {
    { f32x4 v[8]; const int c4 = lane & 7;
#pragma unroll
      for (int i = 0; i < 8; ++i) v[i] = *(const f32x4*)(W + (size_t)(k0 + 8 * i + (lane >> 3)) * ldw + n0 + 4 * c4);
#pragma unroll
      for (int i = 0; i < 8; ++i) { LAS float* d = scr + (8 * i + (lane >> 3)) * 33 + 4 * c4; d[0] = v[i][0]; d[1] = v[i][1]; d[2] = v[i][2]; d[3] = v[i][3]; } }
    LDS_WAIT(); asm volatile("" ::: "memory");
    const int c = lane & 7;
#pragma unroll
    for (int j = 0; j < 4; ++j) { const int n = (lane >> 3) + 8 * j; const LAS float* s = scr + (8 * c) * 33 + n;
        v4u o; o.x = pk2(s[0 * 33], s[1 * 33]); o.y = pk2(s[2 * 33], s[3 * 33]); o.z = pk2(s[4 * 33], s[5 * 33]); o.w = pk2(s[6 * 33], s[7 * 33]);
        *(GAS v4u*)(dst + (size_t)n * ldt + 8 * c) = o; }
    LDS_WAIT(); asm volatile("" ::: "memory");
}

__device__ __forceinline__ void convert_layer(Frame& F, int l, int gw, int ngw) {
    LAS float* scr = (LAS float*)(F.lds + F.wave * 16384);
    constexpr int I_IN = (DM / 64) * (INC / 32), I_BR = 4 * (BW / 64) * (DM / 32), I_OUT = (DM / 64) * (DM / 32), I_F1 = (DM / 64) * (F2 / 32), I_F2 = (FHID / 64) * (DM / 32);
    constexpr int PER_L = I_IN + I_BR + I_OUT + I_F1 + I_F2;
    unsigned char* wl = F.ws + WS_W + (size_t)l * WL_STRIDE;
    for (int it = gw; it < PER_L; it += ngw) {
        int r = it;
        if (r < I_IN) { const int nblk = INC / 32, kb = r / nblk, nb = r % nblk;
            transpose_item(F.ka->in[I_WIN] + (size_t)l * DM * INC, INC, 64 * kb, 32 * nb, (bf16*)(wl + WL_IN) + (size_t)(32 * nb) * DM + 64 * kb, DM, scr, F.lane); continue; }
        r -= I_IN;
        if (r < I_BR) { const int per = (BW / 64) * (DM / 32), k = r / per, rr = r % per, nblk = DM / 32, kb = rr / nblk, nb = rr % nblk;
            transpose_item(F.ka->in[I_WBR] + (size_t)(l * 4 + k) * BW * DM, DM, 64 * kb, 32 * nb, (bf16*)(wl + WL_BR) + (size_t)(32 * nb) * DM + k * BW + 64 * kb, DM, scr, F.lane); continue; }
        r -= I_BR;
        if (r < I_OUT) { const int nblk = DM / 32, kb = r / nblk, nb = r % nblk;
            transpose_item(F.ka->in[I_WOUT] + (size_t)l * DM * DM, DM, 64 * kb, 32 * nb, (bf16*)(wl + WL_OUT) + (size_t)(32 * nb) * DM + 64 * kb, DM, scr, F.lane); continue; }
        r -= I_OUT;
        if (r < I_F1) { const int nblk = F2 / 32, kb = r / nblk, nb = r % nblk; const int n0 = 32 * nb;
            const int j = n0 < FHID ? n0 : n0 - FHID; const int drow = (j >> 7) * 256 + (n0 < FHID ? 0 : 128) + (j & 127);
            transpose_item(F.ka->in[I_WF1] + (size_t)l * DM * F2, F2, 64 * kb, n0, (bf16*)(wl + WL_F1) + (size_t)drow * DM + 64 * kb, DM, scr, F.lane); continue; }
        r -= I_F1;
        { const int nblk = DM / 32, kb = r / nblk, nb = r % nblk;
            transpose_item(F.ka->in[I_WF2] + (size_t)l * FHID * DM, DM, 64 * kb, 32 * nb, (bf16*)(wl + WL_F2) + (size_t)(32 * nb) * FHID + 64 * kb, FHID, scr, F.lane); }
    }
}

__device__ __forceinline__ void p0_prologue(Frame& F, int nconv) {
    const int gw = blockIdx.x * NWAVES + F.wave, NGW = F.G * NWAVES;
    const int gt = blockIdx.x * (NWAVES * 64) + F.tid, NGT = F.G * NWAVES * 64;
    if (gt < 2048) {
        const int pos = gt >> 4, i = gt & 15;
        const float freq = exp2f(-(float)i * (13.287712379549449f / 16.0f));
        const float ang = (float)pos * freq;
        const float k = rintf(ang * 0.15915494309189535f);
        float r = fmaf(-k, 6.28125f, ang); r = fmaf(-k, 0.0019353071795864769f, r);
        float* rc = (float*)(F.ws + WS_ROPE);
        rc[gt] = __cosf(r); rc[2048 + gt] = __sinf(r);
    }
    {
        const f32x4* xs = (const f32x4*)F.ka->in[I_X]; f32x4* xd = (f32x4*)F.out;
        for (int i = gt; i < SEQ * DM / 4; i += NGT) xd[i] = xs[i];
        const f32x4* cs = (const f32x4*)F.ka->in[I_CTX]; f32x4* cd = (f32x4*)(F.ws + WS_XC);
        for (int i = gt; i < CTXL * DM / 4; i += NGT) cd[i] = cs[i];
    }
    {
        LAS float* sl = (LAS float*)F.lds;
        LAS float* sc = sl + 2048;
        LAS float* red = sc + 2048;
        for (int i = F.tid; i < 2048; i += NWAVES * 64) { const float a = F.ka->in[I_C][i], b = F.ka->in[I_CCTX][i]; sl[i] = a * sigm(a); sc[i] = b * sigm(b); }
        __syncthreads();
        const int half = F.lane >> 5, c4 = F.lane & 31;
        for (int item = blockIdx.x; item < DEPTH * 96; item += F.G) {
            const int l = item / 96, col0 = (item % 96) * 128;
            const float* W = F.ka->in[I_WMOD] + (size_t)l * DM * NMOD + col0 + 4 * c4;
            f32x4 al = {0.f, 0.f, 0.f, 0.f}, ac = {0.f, 0.f, 0.f, 0.f};
#pragma unroll 8
            for (int i = 0; i < 128; ++i) { const int row = F.wave * 256 + 2 * i + half; const f32x4 v = *(const f32x4*)(W + (size_t)row * NMOD); al += sl[row] * v; ac += sc[row] * v; }
#pragma unroll
            for (int e = 0; e < 4; ++e) { al[e] += __shfl_xor(al[e], 32); ac[e] += __shfl_xor(ac[e], 32); }
            if (half == 0) { *(LAS f32x4*)(red + (F.wave * 2 + 0) * 128 + 4 * c4) = al; *(LAS f32x4*)(red + (F.wave * 2 + 1) * 128 + 4 * c4) = ac; }
            __syncthreads();
            if (F.tid < 256) { const int which = F.tid >> 7, col = F.tid & 127; float s = F.ka->in[I_BMOD][l * NMOD + col0 + col];
#pragma unroll
                for (int w = 0; w < 8; ++w) s += red[(w * 2 + which) * 128 + col];
                ((float*)(F.ws + WS_MOD))[(size_t)(l * 2 + which) * NMOD + col0 + col] = s; }
            __syncthreads();
        }
    }
    __syncthreads();
    {
        LAS float* scr = (LAS float*)(F.lds + F.wave * 16384);
        for (int r = gw; r < 64 * 8; r += NGW) {
            const int mi = r >> 3, sub = r & 7, kb = sub >> 2, nb = sub & 3;
            const int blk = mi & 3, map = (mi >> 2) & 1, ld = mi >> 3;
            const float* W = (map ? F.ka->in[I_CWX] : F.ka->in[I_CWA]) + (size_t)(ld * 4 + blk) * 16384;
            bf16* dst = (bf16*)(F.ws + WS_GW) + (size_t)mi * 16384 + (size_t)(32 * nb) * 128 + 64 * kb;
            transpose_item(W, 128, 64 * kb, 32 * nb, dst, 128, scr, F.lane);
        }
    }
    for (int l = 0; l < nconv; ++l) convert_layer(F, l, gw, NGW);
}

template <int NS> __device__ __forceinline__ void norm_phase(Frame& F, int l, int which, int nrows, bool pend, const float* pgate) {
    const int gw = blockIdx.x * NWAVES + F.wave, NGW = F.G * NWAVES;
    const float* gain = (which ? F.ka->in[I_NORM2] : F.ka->in[I_NORM1]) + l * DM;
    bf16* H = (bf16*)(F.ws + WS_H);
    for (int m = gw; m < nrows; m += NGW) {
        const bool lat = m < SEQ;
        const float* xrow = lat ? F.out + (size_t)m * DM : (const float*)(F.ws + WS_XC) + (size_t)(m - SEQ) * DM;
        const float* mod = (const float*)(F.ws + WS_MOD) + (size_t)(l * 2 + (lat ? 0 : 1)) * NMOD + (which ? 3 * DM : 0);
        f32x4 v[8]; float ss = 0.f;
#pragma unroll
        for (int j = 0; j < 8; ++j) v[j] = *(const f32x4*)(xrow + 4 * F.lane + 256 * j);
        if (!lat && pend) {
            const float* sp = (const float*)(F.ws + WS_SLAB) + (size_t)(m - SEQ) * DM + 4 * F.lane;
#pragma unroll
            for (int j = 0; j < 8; ++j) { f32x4 t[NS];
#pragma unroll
                for (int s = 0; s < NS; ++s) t[s] = *(const f32x4*)(sp + (size_t)s * CTXL * DM + 256 * j);
                f32x4 a = t[0];
#pragma unroll
                for (int s = 1; s < NS; ++s) a += t[s];
                v[j] += *(const f32x4*)(pgate + 4 * F.lane + 256 * j) * a;
                *(f32x4*)((float*)(F.ws + WS_XC) + (size_t)(m - SEQ) * DM + 4 * F.lane + 256 * j) = v[j]; }
        }
#pragma unroll
        for (int j = 0; j < 8; ++j) ss += (v[j][0] * v[j][0] + v[j][1] * v[j][1]) + (v[j][2] * v[j][2] + v[j][3] * v[j][3]);
        const float rstd = 1.0f / sqrtf(wave_sum(ss) * (1.0f / DM) + EPS);
#pragma unroll
        for (int j = 0; j < 8; ++j) { const int c = 4 * F.lane + 256 * j;
            const f32x4 g = *(const f32x4*)(gain + c), sh = *(const f32x4*)(mod + c), scl = *(const f32x4*)(mod + DM + c);
            const f32x4 o = (v[j] * rstd * g) * (1.0f + scl) + sh;
            v2u w; w.x = pk2(o[0], o[1]); w.y = pk2(o[2], o[3]);
            *(v2u*)(H + (size_t)m * DM + c) = w; }
    }
}
__device__ __forceinline__ void final_norm_phase(Frame& F) {
    const int gw = blockIdx.x * NWAVES + F.wave, NGW = F.G * NWAVES;
    const float* gain = F.ka->in[I_FNORM];
    for (int m = gw; m < SEQ; m += NGW) {
        float* xrow = F.out + (size_t)m * DM;
        f32x4 v[8]; float ss = 0.f;
#pragma unroll
        for (int j = 0; j < 8; ++j) { v[j] = *(const f32x4*)(xrow + 4 * F.lane + 256 * j); ss += (v[j][0] * v[j][0] + v[j][1] * v[j][1]) + (v[j][2] * v[j][2] + v[j][3] * v[j][3]); }
        const float rstd = 1.0f / sqrtf(wave_sum(ss) * (1.0f / DM) + EPS);
#pragma unroll
        for (int j = 0; j < 8; ++j) { const int c = 4 * F.lane + 256 * j; const f32x4 g = *(const f32x4*)(gain + c); *(f32x4*)(xrow + c) = (v[j] * rstd) * g; }
    }
}

#define MFMA32(a, b, c) __builtin_amdgcn_mfma_f32_32x32x16_bf16((a), (b), (c), 0, 0, 0)
__device__ __forceinline__ int crow(int reg, int h) { return (reg & 3) + 8 * (reg >> 2) + 4 * h; }
typedef short v4i16_t __attribute__((ext_vector_type(4)));
__device__ __forceinline__ s16x4 tr_read(LAS unsigned char* p) { return __builtin_bit_cast(s16x4, __builtin_amdgcn_ds_read_tr16_b64_v4i16((LAS v4i16_t*)p)); }
__device__ __forceinline__ unsigned cvtpk(float lo, float hi) { return pg8::cvt_pk_bf16(lo, hi); }
#define WG_BAR() do { asm volatile("s_waitcnt lgkmcnt(0)" ::: "memory"); __builtin_amdgcn_s_barrier(); asm volatile("" ::: "memory"); } while (0)

constexpr int KVP = 128;
constexpr int KV_TILE = 64 * KVP, KV_BUF = 2 * KV_TILE;
constexpr int ATT_NB = 6, ATT_D = 4;
constexpr int ATT_TAB_OFF = ATT_NB * KV_BUF;
constexpr float ATT_SCALE = 0.125f;
constexpr float NEG_BIG = -1.0e30f;

struct AttnState { f32x16 o0, o1; float m, l; };
template <class ScoreFn>
__device__ __forceinline__ void attn_step(AttnState& st, const bf16x8 (&qf)[4], LAS unsigned char* kb, LAS unsigned char* vb, int lane, const ScoreFn& sf) {
    const int r = lane & 31, h = lane >> 5;
    f32x16 s0, s1;
#pragma unroll
    for (int i = 0; i < 16; ++i) { s0[i] = 0.f; s1[i] = 0.f; }
    LAS unsigned char* kp = kb + r * KVP; const int kx = (h ^ (r & 7)) << 4;
#pragma unroll
    for (int ds = 0; ds < 4; ++ds) {
        const bf16x8 k0 = *(const LAS bf16x8*)(kp + (kx ^ (ds << 5))), k1 = *(const LAS bf16x8*)(kp + 32 * KVP + (kx ^ (ds << 5)));
        s0 = MFMA32(k0, qf[ds], s0); s1 = MFMA32(k1, qf[ds], s1);
    }
    float mt = NEG_BIG;
    __builtin_amdgcn_sched_barrier(0);
#pragma unroll
    for (int i = 0; i < 16; ++i) { s0[i] = sf(s0[i], crow(i, h), r); mt = fmaxf(mt, s0[i]); if ((i & 7) == 7) __builtin_amdgcn_sched_barrier(0); }
#pragma unroll
    for (int i = 0; i < 16; ++i) { s1[i] = sf(s1[i], 32 + crow(i, h), r); mt = fmaxf(mt, s1[i]); if ((i & 7) == 7) __builtin_amdgcn_sched_barrier(0); }
    mt = fmaxf(mt, __shfl_xor(mt, 32));
    const float mn = fmaxf(st.m, mt), alpha = __builtin_amdgcn_exp2f(st.m - mn);
    float ps = 0.f;
#pragma unroll
    for (int i = 0; i < 16; ++i) { s0[i] = __builtin_amdgcn_exp2f(s0[i] - mn); s1[i] = __builtin_amdgcn_exp2f(s1[i] - mn); ps += s0[i] + s1[i]; }
    st.l = st.l * alpha + ps; st.m = mn;
#pragma unroll
    for (int i = 0; i < 16; ++i) { st.o0[i] *= alpha; st.o1[i] *= alpha; }
    __builtin_amdgcn_sched_barrier(0);
    v4u pw[4];
    pw[0].x = cvtpk(s0[0], s0[1]); pw[0].y = cvtpk(s0[2], s0[3]); pw[0].z = cvtpk(s0[4], s0[5]); pw[0].w = cvtpk(s0[6], s0[7]);
    pw[1].x = cvtpk(s0[8], s0[9]); pw[1].y = cvtpk(s0[10], s0[11]); pw[1].z = cvtpk(s0[12], s0[13]); pw[1].w = cvtpk(s0[14], s0[15]);
    pw[2].x = cvtpk(s1[0], s1[1]); pw[2].y = cvtpk(s1[2], s1[3]); pw[2].z = cvtpk(s1[4], s1[5]); pw[2].w = cvtpk(s1[6], s1[7]);
    pw[3].x = cvtpk(s1[8], s1[9]); pw[3].y = cvtpk(s1[10], s1[11]); pw[3].z = cvtpk(s1[12], s1[13]); pw[3].w = cvtpk(s1[14], s1[15]);
    const int i16 = lane & 15, q = i16 >> 2, p = i16 & 3, dhalf = (lane >> 4) & 1;
    LAS unsigned char* vrow = vb + (4 * h + q) * KVP + (p & 1) * 8;
    LAS unsigned char* vp0 = vrow + (((2 * dhalf + (p >> 1)) ^ (4 * h + q)) << 4); LAS unsigned char* vp1 = vrow + (((4 + 2 * dhalf + (p >> 1)) ^ (4 * h + q)) << 4);
#pragma unroll
    for (int ks = 0; ks < 4; ++ks) {
        const s16x4 l0 = tr_read(vp0 + (16 * ks) * KVP), h0 = tr_read(vp0 + (16 * ks + 8) * KVP);
        const s16x4 l1 = tr_read(vp1 + (16 * ks) * KVP), h1 = tr_read(vp1 + (16 * ks + 8) * KVP);
        const bf16x8 v0 = (bf16x8){l0[0], l0[1], l0[2], l0[3], h0[0], h0[1], h0[2], h0[3]};
        const bf16x8 v1 = (bf16x8){l1[0], l1[1], l1[2], l1[3], h1[0], h1[1], h1[2], h1[3]};
        const bf16x8 pf = __builtin_bit_cast(bf16x8, pw[ks]);
        st.o0 = MFMA32(v0, pf, st.o0); st.o1 = MFMA32(v1, pf, st.o1);
    }
}
__device__ __forceinline__ void attn_store(const AttnState& st, float linv, bf16* Op  , int lane) {
    const int r = lane & 31, h = lane >> 5;
    bf16* rowp = Op + (size_t)r * DM + 4 * h;
#pragma unroll
    for (int g = 0; g < 4; ++g) {
        v2u w0, w1;
        w0.x = cvtpk(st.o0[4 * g] * linv, st.o0[4 * g + 1] * linv); w0.y = cvtpk(st.o0[4 * g + 2] * linv, st.o0[4 * g + 3] * linv);
        w1.x = cvtpk(st.o1[4 * g] * linv, st.o1[4 * g + 1] * linv); w1.y = cvtpk(st.o1[4 * g + 2] * linv, st.o1[4 * g + 3] * linv);
        *(v2u*)(rowp + 8 * g) = w0; *(v2u*)(rowp + 32 + 8 * g) = w1;
    }
}
struct ScorePlain { __device__ __forceinline__ float operator()(float s, int, int) const { return s * (ATT_SCALE * LOG2E); } };
struct ScoreWin {
    int dk;
    __device__ __forceinline__ float operator()(float s, int krow, int qr) const { const int d = dk + krow - qr; return (d >= -128 && d <= 128) ? s * (ATT_SCALE * LOG2E) : NEG_BIG; }
};
struct ScoreNb {
    const LAS float* tab;
    int cq0, dr;
    __device__ __forceinline__ float operator()(float s, int ck, int qr) const {
        const int cq = cq0 + qr; int cs = cq - 8; cs = cs < 0 ? 0 : (cs > 48 ? 48 : cs);
        int dc = ck - cq + 15; dc = dc < 0 ? 0 : (dc > 30 ? 30 : dc);
        const float b = tab[dr * 31 + dc];
        return (ck >= cs && ck < cs + 16) ? (s * ATT_SCALE + b) * LOG2E : NEG_BIG;
    }
};

template <bool ISB>
__device__ __forceinline__ void attn_wg_item(Frame& F, int l, int idx) {
    const int lane = F.lane, w = F.wave, tid = F.tid;
    const bf16* Z = (const bf16*)(F.ws + WS_Z); bf16* BR = (bf16*)(F.ws + WS_BR);
    LAS unsigned char* ring = F.lds;
    LAS float* tab = (LAS float*)(F.lds + ATT_TAB_OFF);
    const bool lat = idx < 256; const int ix = lat ? idx : idx - 256;
    int kcol, vcol, qcol, ocol, qrow0, nloc, krow_base, NS, sink_h = 0;
    int r0 = 0, kmin = 0;
    if (!ISB) {
        const int hk = ix & 1, blk = ix >> 1, g = w >> 1, pt = w & 1, hq = hk * 4 + g; sink_h = hq;
        kcol = ZC_KA + hk * 64; vcol = ZC_VA + hk * 64; qcol = ZC_QA + hq * 64; ocol = hq * 64;
        if (lat) { const int p0 = 64 * blk; int klo = p0 - 128; if (klo < 0) klo = 0; int khi = p0 + 192; if (khi > SEQ) khi = SEQ; krow_base = klo; nloc = (khi - klo) >> 6; qrow0 = p0 + 32 * pt; }
        else { krow_base = 0; nloc = 0; qrow0 = SEQ + 64 * blk + 32 * pt; }
    } else {
        const int hb = lat ? (ix & 7) : ix;
        kcol = ZC_KB + hb * 64; vcol = ZC_VB + hb * 64; qcol = ZC_QB + hb * 64; ocol = 512 + hb * 64;
        if (lat) { const int rg = ix >> 3; r0 = 4 * rg; kmin = r0 - 4; kmin = kmin < 0 ? 0 : (kmin > 120 ? 120 : kmin); int kmax = r0 + 3 - 4; kmax = (kmax < 0 ? 0 : (kmax > 120 ? 120 : kmax)) + 7;
            krow_base = kmin * GRIDW; nloc = kmax - kmin + 1; qrow0 = (r0 + (w >> 1)) * GRIDW + 32 * (w & 1);
            const float* bsrc = F.ka->in[I_NBBIAS] + (size_t)(l * 8 + hb) * 465;
            if (tid < 465) tab[tid] = bsrc[tid]; }
        else { krow_base = 0; nloc = 0; qrow0 = SEQ + 32 * w; }
    }
    NS = nloc + 4;
    bf16x8 qf[4];
    { const bf16* Qp = Z + (size_t)(qrow0 + (lane & 31)) * ZC + qcol + 8 * (lane >> 5);
#pragma unroll
      for (int ds = 0; ds < 4; ++ds) qf[ds] = *(const bf16x8*)(Qp + 16 * ds); }
    const int drow = 8 * w + (lane >> 3), dch = (lane & 7) ^ (lane >> 3);
    const bf16* gk = Z + (size_t)drow * ZC + kcol + 8 * dch; const bf16* gv = Z + (size_t)drow * ZC + vcol + 8 * dch;
    LAS unsigned char* dk0 = ring + w * 1024;
#define TILE_ROW(s) ((s) < nloc ? krow_base + 64 * (s) : SEQ + 64 * ((s) - nloc))
#define ATT_DMA(t) do { const int t_ = (t) < NS ? (t) : NS - 1; const size_t ro_ = (size_t)TILE_ROW(t_) * ZC; LAS unsigned char* d_ = dk0 + ((t) % ATT_NB) * KV_BUF; \
        __builtin_amdgcn_global_load_lds((const unsigned*)(gk + ro_), (LAS unsigned*)d_, 16, 0, 0); __builtin_amdgcn_global_load_lds((const unsigned*)(gv + ro_), (LAS unsigned*)(d_ + KV_TILE), 16, 0, 0); } while (0)
    AttnState st;
#pragma unroll
    for (int i = 0; i < 16; ++i) { st.o0[i] = 0.f; st.o1[i] = 0.f; }
    st.m = NEG_BIG; st.l = 0.f;
#pragma unroll
    for (int t = 0; t < ATT_D; ++t) ATT_DMA(t);
    for (int s = 0; s < NS; ++s) {
        ATT_DMA(s + ATT_D);
        asm volatile("s_waitcnt vmcnt(8)" ::: "memory");
        WG_BAR();
        LAS unsigned char* cur = ring + (s % ATT_NB) * KV_BUF;
        if (s >= nloc) { ScorePlain sf; attn_step(st, qf, cur, cur + KV_TILE, lane, sf); }
        else if (!ISB) { int dkv = krow_base + 64 * s - qrow0; asm volatile("" : "+v"(dkv)); ScoreWin sf{dkv}; attn_step(st, qf, cur, cur + KV_TILE, lane, sf); }
        else { const int gr = r0 + (w >> 1); int kr0 = gr - 4; kr0 = kr0 < 0 ? 0 : (kr0 > 120 ? 120 : kr0); const int kr = kmin + s;
            if (kr >= kr0 && kr < kr0 + 8) { int cq0v = 32 * (w & 1); asm volatile("" : "+v"(cq0v));
                ScoreNb sf{tab, cq0v, kr - gr + 7}; attn_step(st, qf, cur, cur + KV_TILE, lane, sf); } }
    }
    asm volatile("s_waitcnt vmcnt(0)" ::: "memory");
    WG_BAR();
#undef ATT_DMA
#undef TILE_ROW
    float lsum = st.l + __shfl_xor(st.l, 32);
    if (!ISB) lsum += __builtin_amdgcn_exp2f(F.ka->in[I_ASINK][l * 8 + sink_h] * LOG2E - st.m);
    attn_store(st, 1.0f / lsum, BR + (size_t)qrow0 * DM + ocol, lane);
}

__device__ __forceinline__ void dconv_phase(Frame& F, int l, int nrows) {
    const int gt = blockIdx.x * (NWAVES * 64) + F.tid, NGT = F.G * NWAVES * 64;
    const bf16* Z = (const bf16*)(F.ws + WS_Z); bf16* BR = (bf16*)(F.ws + WS_BR);
    const float* w = F.ka->in[I_DCONVW] + (size_t)l * 3 * 512;
    for (int it = gt; it < nrows * 64; it += NGT) {
        const int row = it >> 6, c0 = (it & 63) * 8;
        const int lo = row < SEQ ? 0 : SEQ, hi = row < SEQ ? SEQ : MT;
        float acc[8];
#pragma unroll
        for (int e = 0; e < 8; ++e) acc[e] = 0.f;
#pragma unroll
        for (int j = 0; j < 3; ++j) { const int rr = row + j - 1;
            if (rr >= lo && rr < hi) { const v4u cd = *(const v4u*)(Z + (size_t)rr * ZC + ZC_CD + c0), xd = *(const v4u*)(Z + (size_t)rr * ZC + ZC_XD + c0);
                const f32x4 w0 = *(const f32x4*)(w + j * 512 + c0), w1 = *(const f32x4*)(w + j * 512 + c0 + 4);
#pragma unroll
                for (int e = 0; e < 4; ++e) { acc[2 * e] += (e < 2 ? w0[2 * e] : w1[2 * e - 4]) * (bflo(cd[e]) * bflo(xd[e])); acc[2 * e + 1] += (e < 2 ? w0[2 * e + 1] : w1[2 * e - 3]) * (bfhi(cd[e]) * bfhi(xd[e])); } } }
        const v4u bd = *(const v4u*)(Z + (size_t)row * ZC + ZC_BD + c0);
        v4u o;
#pragma unroll
        for (int e = 0; e < 4; ++e) o[e] = pk2(acc[2 * e] * bflo(bd[e]), acc[2 * e + 1] * bfhi(bd[e]));
        *(v4u*)(BR + (size_t)row * DM + 1536 + c0) = o;
    }
}

__device__ __forceinline__ float gelu_tanh(float x) { const float z = 0.7978845608028654f * (x + 0.044715f * x * x * x); const float e = __expf(2.0f * z); return 0.5f * x * (1.0f + (1.0f - 2.0f * __builtin_amdgcn_rcpf(e + 1.0f))); }
constexpr int UB_PITCH = 1040;
constexpr int SC_U32 = 0, SC_UB = 65536, SC_CARRY = SC_UB + 32 * UB_PITCH;
__device__ __forceinline__ void scan_utile(Frame& F, int l, int row0, int lo, int hi) {
    const bf16* Z = (const bf16*)(F.ws + WS_Z);
    LAS float* U32 = (LAS float*)(F.lds + SC_U32); LAS unsigned char* Ub = F.lds + SC_UB;
    const int ch = F.tid;
    const float* cw = F.ka->in[I_CCONVW] + (size_t)l * 4 * 512; const float w0 = cw[ch], w1 = cw[512 + ch], w2 = cw[1024 + ch], w3 = cw[1536 + ch], cb = F.ka->in[I_CCONVB][l * 512 + ch];
    const bf16* xp = Z + ZC_XR + ch;
    float xv[35];
#pragma unroll
    for (int t = 0; t < 35; ++t) { const int rr = row0 - 2 + t; xv[t] = (rr >= lo && rr < hi) ? bf1(xp[(size_t)rr * ZC]) : 0.f; }
#pragma unroll
    for (int tt = 0; tt < 32; ++tt) { const float u = cb + w0 * xv[tt] + w1 * xv[tt + 1] + w2 * xv[tt + 2] + w3 * xv[tt + 3];
        U32[tt * 512 + ch] = u; *(LAS bf16*)(Ub + tt * UB_PITCH + ch * 2) = (bf16)f2bf(u); }
}
__device__ __forceinline__ void scan_gates(Frame& F, int l, int dir, int n, int g, const bf16x8 (&af)[8], f32x16& a, f32x16& b) {
    const int lane = F.lane, r = lane & 31, h = lane >> 5;
    const LAS float* U32 = (const LAS float*)(F.lds + SC_U32);
    const bf16* GWa = (const bf16*)(F.ws + WS_GW) + (size_t)((((l * 2 + dir) * 2 + 0) * 4 + n)) * 16384; const bf16* GWx = GWa + (size_t)4 * 16384;
    const bf16* wa = GWa + (size_t)(32 * g + r) * 128 + 8 * h; const bf16* wx = GWx + (size_t)(32 * g + r) * 128 + 8 * h;
    f32x16 pa, px;
#pragma unroll
    for (int i = 0; i < 16; ++i) { pa[i] = 0.f; px[i] = 0.f; }
    __builtin_amdgcn_sched_barrier(0);
#pragma unroll
    for (int kk = 0; kk < 8; ++kk) { pa = MFMA32(af[kk], *(const bf16x8*)(wa + 16 * kk), pa); px = MFMA32(af[kk], *(const bf16x8*)(wx + 16 * kk), px); }
    __builtin_amdgcn_sched_barrier(0);
    const int ch = n * 128 + 32 * g + r, pidx = (l * 2 + dir) * 512 + ch;
    const float ba = F.ka->in[I_CBA][pidx], bx = F.ka->in[I_CBX][pidx], lam = F.ka->in[I_CLAM][pidx];
    const float sp = log1pf(__expf(-lam));
#pragma unroll
    for (int i = 0; i < 16; ++i) { const int tt = crow(i, h);
        const float rr = sigm(pa[i] + ba), ii = sigm(px[i] + bx), la = -8.0f * rr * sp;
        const float av = __expf(la); a[i] = av; b[i] = __builtin_amdgcn_sqrtf(fmaxf(fmaf(-av, av, 1.0f), 0.f)) * (ii * U32[tt * 512 + ch]); }
    __builtin_amdgcn_sched_barrier(0);
}
struct TileComp { float fA[4], fB[4], sA[4], sB[4]; };
__device__ __forceinline__ void tile_comp(const f32x16& a, const f32x16& b, int h, bool bwd, TileComp& T) {
#pragma unroll
    for (int q = 0; q < 4; ++q) {
        const float a0 = a[4 * q], a1 = a[4 * q + 1], a2 = a[4 * q + 2], a3 = a[4 * q + 3], b0 = b[4 * q], b1 = b[4 * q + 1], b2 = b[4 * q + 2], b3 = b[4 * q + 3];
        const float GA = (a0 * a1) * (a2 * a3);
        const float GB = bwd ? ((b3 * a2 + b2) * a1 + b1) * a0 + b0 : ((b0 * a1 + b1) * a2 + b2) * a3 + b3;
        const float OA = __shfl_xor(GA, 32), OB = __shfl_xor(GB, 32);
        const bool mine_first = bwd ? (h == 1) : (h == 0);
        T.fA[q] = mine_first ? GA : OA; T.fB[q] = mine_first ? GB : OB; T.sA[q] = mine_first ? OA : GA; T.sB[q] = mine_first ? OB : GB;
    }
}
__device__ __forceinline__ void tile_total(const TileComp& T, bool bwd, float& P, float& S) {
    P = 1.f; S = 0.f;
#pragma unroll
    for (int qq = 0; qq < 4; ++qq) { const int q = bwd ? 3 - qq : qq; S = (S * T.fA[q] + T.fB[q]) * T.sA[q] + T.sB[q]; P = (P * T.fA[q]) * T.sA[q]; }
}
__device__ __forceinline__ void tile_scan(const f32x16& a, const f32x16& b, const TileComp& T, int h, bool bwd, float& hv, f32x16& y) {
    const bool mine_first = bwd ? (h == 1) : (h == 0);
#pragma unroll
    for (int qq = 0; qq < 4; ++qq) { const int q = bwd ? 3 - qq : qq;
        const float mid = T.fA[q] * hv + T.fB[q];
        float x = mine_first ? hv : mid;
#pragma unroll
        for (int ee = 0; ee < 4; ++ee) { const int e = bwd ? 3 - ee : ee; x = a[4 * q + e] * x + b[4 * q + e]; y[4 * q + e] += x; }
        hv = T.sA[q] * mid + T.sB[q];
    }
}
__device__ __forceinline__ void scan_pass1_item(Frame& F, int l, int c) {
    float* PS = (float*)(F.ws + WS_PS);
    float* PSS = PS + (size_t)2 * 132 * 512 * 2;
    LAS unsigned char* Ub = F.lds + SC_UB;
    const int row_c = 64 * c, lo = row_c < SEQ ? 0 : SEQ, hi = row_c < SEQ ? SEQ : MT;
    const int lane = F.lane, r = lane & 31, h = lane >> 5, n = F.wave & 3, gp = F.wave >> 2;
    float cP[2][2], cS[2][2];
#pragma unroll
    for (int sub = 0; sub < 2; ++sub) {
        scan_utile(F, l, row_c + 32 * sub, lo, hi);
        WG_BAR();
        bf16x8 af[8];
#pragma unroll
        for (int kk = 0; kk < 8; ++kk) af[kk] = *(const LAS bf16x8*)(Ub + r * UB_PITCH + (n * 128 + 16 * kk + 8 * h) * 2);
#pragma unroll
        for (int gl = 0; gl < 2; ++gl)
#pragma unroll
            for (int dir = 0; dir < 2; ++dir) {
                f32x16 a, b; scan_gates(F, l, dir, n, 2 * gp + gl, af, a, b);
                TileComp T; tile_comp(a, b, h, dir == 1, T);
                float P, S; tile_total(T, dir == 1, P, S);
                const int ch = n * 128 + 32 * (2 * gp + gl) + r;
                if (h == 0) *(float2*)(PSS + ((size_t)(dir * 264 + 2 * c + sub) * 512 + ch) * 2) = make_float2(P, S);
                if (sub == 0) { cP[gl][dir] = P; cS[gl][dir] = S; }
                else { float Pc, Sc;
                    if (dir == 0) { Pc = cP[gl][dir] * P; Sc = cS[gl][dir] * P + S; } else { Pc = P * cP[gl][dir]; Sc = S * cP[gl][dir] + cS[gl][dir]; }
                    if (h == 0) *(float2*)(PS + ((size_t)(dir * 132 + c) * 512 + ch) * 2) = make_float2(Pc, Sc); }
            }
        WG_BAR();
    }
}
template <class IdxFn> __device__ __forceinline__ float fold_ps(const float* PSd, int ch, int n, const IdxFn& idx) {
    float hv = 0.f;
    for (int k0 = 0; k0 < n; k0 += 48) { float2 t[48];
#pragma unroll
        for (int j = 0; j < 48; ++j) { const int k = (k0 + j < n) ? k0 + j : n - 1; t[j] = *(const float2*)(PSd + ((size_t)idx(k) * 512 + ch) * 2); }
#pragma unroll
        for (int j = 0; j < 48; ++j) if (k0 + j < n) hv = t[j].x * hv + t[j].y;
    }
    return hv;
}
struct IdxFwd { __device__ __forceinline__ int operator()(int k) const { return k < 4 ? 128 + k : k - 4; } };
struct IdxBwd { __device__ __forceinline__ int operator()(int k) const { return k < 4 ? 131 - k : 127 - (k - 4); } };
__device__ __forceinline__ void scan_pass2_item(Frame& F, int l, int c) {
    const bf16* Z = (const bf16*)(F.ws + WS_Z); bf16* BR = (bf16*)(F.ws + WS_BR);
    const float* PS = (const float*)(F.ws + WS_PS); const float* PSS = PS + (size_t)2 * 132 * 512 * 2;
    LAS unsigned char* Ub = F.lds + SC_UB; LAS float* CAR = (LAS float*)(F.lds + SC_CARRY);
    const int row_c = 64 * c, lo = row_c < SEQ ? 0 : SEQ, hi = row_c < SEQ ? SEQ : MT;
    const int lane = F.lane, r = lane & 31, h = lane >> 5, n = F.wave & 3, gp = F.wave >> 2;
    {
        const int ch = F.tid;
        const int nf = c >= 128 ? c - 128 : c + 4, nb = c >= 128 ? 131 - c : 4 + (127 - c);
        CAR[ch] = fold_ps(PS, ch, nf, IdxFwd());
        CAR[512 + ch] = fold_ps(PS + (size_t)132 * 512 * 2, ch, nb, IdxBwd());
    }
    float hvf[2], hvb0[2], hvb1[2];
#pragma unroll
    for (int sub = 0; sub < 2; ++sub) {
        scan_utile(F, l, row_c + 32 * sub, lo, hi);
        WG_BAR();
        if (sub == 0) {
#pragma unroll
            for (int gl = 0; gl < 2; ++gl) { const int ch = n * 128 + 32 * (2 * gp + gl) + r;
                hvf[gl] = CAR[ch]; hvb1[gl] = CAR[512 + ch];
                const float2 t = *(const float2*)(PSS + ((size_t)(1 * 264 + 2 * c + 1) * 512 + ch) * 2);
                hvb0[gl] = t.x * hvb1[gl] + t.y; }
        }
        bf16x8 af[8];
#pragma unroll
        for (int kk = 0; kk < 8; ++kk) af[kk] = *(const LAS bf16x8*)(Ub + r * UB_PITCH + (n * 128 + 16 * kk + 8 * h) * 2);
#pragma unroll
        for (int gl = 0; gl < 2; ++gl) {
            const int ch = n * 128 + 32 * (2 * gp + gl) + r;
            f32x16 y;
#pragma unroll
            for (int i = 0; i < 16; ++i) y[i] = 0.f;
            { f32x16 a, b; scan_gates(F, l, 0, n, 2 * gp + gl, af, a, b); TileComp T; tile_comp(a, b, h, false, T); tile_scan(a, b, T, h, false, hvf[gl], y); }
            { f32x16 a, b; scan_gates(F, l, 1, n, 2 * gp + gl, af, a, b); TileComp T; tile_comp(a, b, h, true, T); float hv = sub == 0 ? hvb0[gl] : hvb1[gl]; tile_scan(a, b, T, h, true, hv, y); }
            const size_t rb = (size_t)(row_c + 32 * sub);
            const bf16* zp = Z + (rb + 4 * h) * ZC + ZC_GR + ch; bf16* bp = BR + (rb + 4 * h) * DM + 1024 + ch;
#pragma unroll
            for (int q4 = 0; q4 < 4; ++q4) {
                __builtin_amdgcn_sched_barrier(0);
#pragma unroll
                for (int e = 0; e < 4; ++e) { const int i = 4 * q4 + e, tt = e + 8 * q4;
                    const float gr = bf1(zp[(size_t)tt * ZC]);
                    bp[(size_t)tt * DM] = (bf16)f2bf(y[i] * gelu_tanh(gr)); }
            }
            __builtin_amdgcn_sched_barrier(0);
        }
        WG_BAR();
    }
}

__global__ void __launch_bounds__(NWAVES * 64, 2) mk_fwd(Args args) {
    extern __shared__ __attribute__((aligned(16))) unsigned char lds[];
    Frame F;
    F.lds = (LAS unsigned char*)lds;
    F.MISC = (volatile LAS unsigned*)(F.lds + MISC_OFF);
    F.tid = threadIdx.x; F.lane = F.tid & 63; F.wave = __builtin_amdgcn_readfirstlane(F.tid >> 6);
    F.G = gridDim.x;
    F.ka = (const KAS Args*)__builtin_amdgcn_kernarg_segment_ptr();
    F.out = args.out; F.ws = args.ws;
    F.ctl = (gu32*)(F.ws + WS_CTL);
    for (int u = F.tid; u < (LDS_BYTES - LDSCTL_OFF) / 4; u += NWAVES * 64) ((LAS unsigned*)(F.lds + LDSCTL_OFF))[u] = 0u;
    __syncthreads();
#if MK_ONE_LAUNCH
    XcdBarrier bar = xcd_barrier_post((unsigned*)(F.ctl + CW_BAR), F.MISC + 8);
#define GRID_BAR() xcd_barrier(bar)
#else
#define GRID_BAR() do { } while (0)
#endif
    const int lo = args.ph_lo, hi = args.ph_hi;
    const bool split_conv = F.G >= 200;
#define IN(k) (lo <= (k) && (k) < hi)
#ifndef PHMASK
#define PHMASK 0x7ff
#endif
#define PHON(b) (((PHMASK) >> (b)) & 1)
#ifndef REPMASK
#define REPMASK 0
#endif
#define REPS(b) ((((REPMASK) >> (b)) & 1) ? 2 : 1)
#define FRESH() do { int t_ = threadIdx.x; asm volatile("" : "+v"(t_)); F.tid = t_; F.lane = t_ & 63; } while (0)
#define SEAM(k) do { if (IN(k) && IN((k) + 1)) GRID_BAR(); } while (0)

    for (int rep_ = 0; rep_ < REPS(0); ++rep_) { if (rep_) GRID_BAR(); if (PHON(0) && IN(0)) { FRESH(); p0_prologue(F, split_conv ? 1 : DEPTH); } }
    SEAM(0);

    for (int l = 0; l < DEPTH; ++l) {
        const int pb = 1 + l * NPL;
        const bool last = (l == DEPTH - 1);
        const int Mg = last ? SEQ : MT;
        unsigned char* wl = F.ws + WS_W + (size_t)l * WL_STRIDE;
        const float* modl = (const float*)(F.ws + WS_MOD) + (size_t)(l * 2) * NMOD; const float* modc = modl + NMOD;

        for (int rep_ = 0; rep_ < REPS(1); ++rep_) { if (rep_) GRID_BAR();
        if (PHON(1) && IN(pb + 0)) { FRESH(); norm_phase<11>(F, l, 0, MT, rep_ == 0 && l > 0, modc - 2 * NMOD + 5 * DM); }
        }
        SEAM(pb + 0);

        for (int rep_ = 0; rep_ < REPS(2); ++rep_) { if (rep_) GRID_BAR();
        if (PHON(2) && IN(pb + 1)) {
            pg8::Gemm g{(const pg8::bf16_t*)(F.ws + WS_H), (const pg8::bf16_t*)(wl + WL_IN), MT, INC, DM, DM}; pg8::StaticOrder S; S.init(MT, INC, F.G, (int)blockIdx.x);
            pg8::EpiIn E{(pg8::bf16_t*)(F.ws + WS_Z), (pg8::bf16_t*)(F.ws + WS_G), F.ka->in[I_BGATE] + (size_t)l * GC, (const float*)(F.ws + WS_ROPE), (const float*)(F.ws + WS_ROPE) + 2048};
            pg8::gemm_phase<pg8::EpiIn, pg8::StaticOrder, true, true>(F.lds, g, S, E);
        }
        }
        SEAM(pb + 1);

        for (int rep_ = 0; rep_ < REPS(3); ++rep_) { if (rep_) GRID_BAR();
        if (PHON(3) && IN(pb + 2)) {
            FRESH(); __syncthreads();
#ifndef SUBREP
#define SUBREP 0
#endif
            for (int q_ = 0; q_ < ((SUBREP & 1) ? 2 : 1); ++q_)
            for (int c = blockIdx.x; c < 132; c += F.G) scan_pass1_item(F, l, c);
            FRESH(); __syncthreads();
            for (int q_ = 0; q_ < ((SUBREP & 2) ? 2 : 1); ++q_)
            for (int k = 0; k < 2; ++k) { const int it = k == 0 ? (int)blockIdx.x : 256 + (F.G - 1 - (int)blockIdx.x); if (k == 1 && (last || it >= 264)) break;
                for (int i2 = it; i2 < (k == 0 ? 256 : 264); i2 += F.G) attn_wg_item<false>(F, l, i2); }
            FRESH();
            for (int q_ = 0; q_ < ((SUBREP & 4) ? 2 : 1); ++q_)
            for (int k = 0; k < 2; ++k) { const int it = k == 0 ? (int)blockIdx.x : 256 + (F.G - 1 - (int)blockIdx.x); if (k == 1 && (last || it >= 264)) break;
                for (int i2 = it; i2 < (k == 0 ? 256 : 264); i2 += F.G) attn_wg_item<true>(F, l, i2); }
            FRESH(); for (int q_ = 0; q_ < ((SUBREP & 8) ? 2 : 1); ++q_) dconv_phase(F, l, last ? SEQ : MT);
        }
        }
        SEAM(pb + 2);

        for (int rep_ = 0; rep_ < REPS(4); ++rep_) { if (rep_) GRID_BAR();
        if (PHON(4) && IN(pb + 3)) {
            FRESH(); __syncthreads();
            const int nch = last ? 128 : 132;
            for (int c = blockIdx.x; c < nch; c += F.G) scan_pass2_item(F, l, c);
            if (split_conv && rep_ == 0 && l + 1 < DEPTH && (int)blockIdx.x >= 132) { FRESH(); convert_layer(F, l + 1, ((int)blockIdx.x - 132) * NWAVES + F.wave, (F.G - 132) * NWAVES); }
        }
        }
        SEAM(pb + 3);

        for (int rep_ = 0; rep_ < REPS(5); ++rep_) { if (rep_) GRID_BAR();
        if (PHON(5) && IN(pb + 4)) {
            __syncthreads();
            pg8::Gemm g{(const pg8::bf16_t*)(F.ws + WS_BR), (const pg8::bf16_t*)(wl + WL_BR), Mg, DM, DM, DM}; pg8::StaticOrder S; S.init(Mg, DM, F.G, (int)blockIdx.x);
            pg8::EpiMerge E{(const pg8::bf16_t*)(F.ws + WS_G), (pg8::bf16_t*)(F.ws + WS_MG)};
            pg8::gemm_phase<pg8::EpiMerge, pg8::StaticOrder, true, true>(F.lds, g, S, E);
        }
        }
        SEAM(pb + 4);

        for (int rep_ = 0; rep_ < REPS(6); ++rep_) { if (rep_) GRID_BAR();
        if (PHON(6) && IN(pb + 5)) {
            pg8::Gemm g{(const pg8::bf16_t*)(F.ws + WS_MG), (const pg8::bf16_t*)(wl + WL_OUT), SEQ, DM, DM, DM}; pg8::StaticOrder S; S.init(SEQ, DM, F.G, (int)blockIdx.x);
            pg8::EpiResid E{rep_ ? (float*)(F.ws + WS_END) : F.out, rep_ ? (float*)(F.ws + WS_END) + (size_t)SEQ * DM : (float*)(F.ws + WS_XC), modl + 2 * DM, modc + 2 * DM};
            pg8::gemm_phase<pg8::EpiResid, pg8::StaticOrder, true, true>(F.lds, g, S, E);
            if (!last) {
                pg8::Gemm gc{(const pg8::bf16_t*)(F.ws + WS_MG), (const pg8::bf16_t*)(wl + WL_OUT), MT, DM, 256, DM}; pg8::SplitKOrder SC{32, DM / 256, 8, 256, F.G, (int)blockIdx.x};
                pg8::EpiSlab EC{(float*)(F.ws + WS_SLAB), 256};
                pg8::gemm_phase<pg8::EpiSlab, pg8::SplitKOrder, true, true>(F.lds, gc, SC, EC);
            }
        }
        }
        SEAM(pb + 5);

        for (int rep_ = 0; rep_ < REPS(7); ++rep_) { if (rep_) GRID_BAR();
        if (PHON(7) && IN(pb + 6)) { FRESH(); norm_phase<8>(F, l, 1, Mg, rep_ == 0 && !last, modc + 2 * DM); }
        }
        SEAM(pb + 6);

        for (int rep_ = 0; rep_ < REPS(8); ++rep_) { if (rep_) GRID_BAR();
        if (PHON(8) && IN(pb + 7)) {
            pg8::Gemm g{(const pg8::bf16_t*)(F.ws + WS_H), (const pg8::bf16_t*)(wl + WL_F1), Mg, F2, DM, DM}; pg8::StaticOrder S; S.init(Mg, F2, F.G, (int)blockIdx.x);
            pg8::EpiSwiglu E{(pg8::bf16_t*)(F.ws + WS_FH)};
            pg8::gemm_phase<pg8::EpiSwiglu, pg8::StaticOrder, true, true>(F.lds, g, S, E);
        }
        }
        SEAM(pb + 7);

        for (int rep_ = 0; rep_ < REPS(9); ++rep_) { if (rep_) GRID_BAR();
        if (PHON(9) && IN(pb + 8)) {
            pg8::Gemm g{(const pg8::bf16_t*)(F.ws + WS_FH), (const pg8::bf16_t*)(wl + WL_F2), SEQ, DM, FHID, FHID}; pg8::StaticOrder S; S.init(SEQ, DM, F.G, (int)blockIdx.x);
            pg8::EpiResid E{rep_ ? (float*)(F.ws + WS_END) : F.out, rep_ ? (float*)(F.ws + WS_END) + (size_t)SEQ * DM : (float*)(F.ws + WS_XC), modl + 5 * DM, modc + 5 * DM};
            pg8::gemm_phase<pg8::EpiResid, pg8::StaticOrder, true, true>(F.lds, g, S, E);
            if (!last) {
                pg8::Gemm gc{(const pg8::bf16_t*)(F.ws + WS_FH), (const pg8::bf16_t*)(wl + WL_F2), MT, DM, 512, FHID}; pg8::SplitKOrder SC{32, DM / 256, 11, 512, F.G, (int)blockIdx.x};
                pg8::EpiSlab EC{(float*)(F.ws + WS_SLAB), 512};
                pg8::gemm_phase<pg8::EpiSlab, pg8::SplitKOrder, true, true>(F.lds, gc, SC, EC);
            }
        }
        }
        SEAM(pb + 8);
    }

    if (PHON(10) && IN(N_PHASES - 1)) { FRESH(); final_norm_phase(F); }
#undef IN
#undef SEAM
}

extern "C" void kernel_launch(void* const* d_in, const int* in_sizes, int n_in, void* d_out, int out_size, void* d_ws, size_t ws_size, hipStream_t stream) {
    static int grid = 0;
    if (grid == 0) {
        if (n_in != 25 || out_size != SEQ * DM || ws_size < WS_NEED) { fprintf(stderr, "kernel_launch: unexpected problem (n_in %d, out %d, ws %zu, need %zu)\n", n_in, out_size, ws_size, (size_t)WS_NEED); grid = -1; return; }
        int dev = 0, cus = 0, per_cu = 0;
        if (hipGetDevice(&dev) != hipSuccess || hipDeviceGetAttribute(&cus, hipDeviceAttributeMultiprocessorCount, dev) != hipSuccess) { grid = -1; return; }
        if (hipFuncSetAttribute((const void*)mk_fwd, hipFuncAttributeMaxDynamicSharedMemorySize, LDS_BYTES) != hipSuccess) { fprintf(stderr, "kernel_launch: hipFuncSetAttribute failed\n"); grid = -1; return; }
        if (hipOccupancyMaxActiveBlocksPerMultiprocessor(&per_cu, (const void*)mk_fwd, NWAVES * 64, LDS_BYTES) != hipSuccess || per_cu < 1) fprintf(stderr, "kernel_launch: occupancy query reports %d\n", per_cu);
        (void)hipGetLastError();
        grid = cus;
    }
    if (grid < 0) return;
    (void)hipMemsetAsync((char*)d_ws + WS_CTL, 0, CTL_ZERO_BYTES, stream);
    Args a{};
    for (int i = 0; i < 25; ++i) a.in[i] = (const float*)d_in[i];
    a.out = (float*)d_out; a.ws = (unsigned char*)d_ws;
#if MK_ONE_LAUNCH
    a.ph_lo = 0; a.ph_hi = N_PHASES;
    hipLaunchKernelGGL(mk_fwd, dim3(grid), dim3(NWAVES * 64), LDS_BYTES, stream, a);
#else
    for (int p = 0; p < N_PHASES; ++p) { a.ph_lo = p; a.ph_hi = p + 1; hipLaunchKernelGGL(mk_fwd, dim3(grid), dim3(NWAVES * 64), LDS_BYTES, stream, a); }
#endif
}
```

```cpp
#include <hip/hip_runtime.h>
#include <cstdio>
#include <cstdint>
namespace pg8 {
#define PG8_LAS __attribute__((address_space(3)))
typedef unsigned short bf16_t;
typedef short bf16x8 __attribute__((ext_vector_type(8)));
typedef float f32x4 __attribute__((ext_vector_type(4)));
typedef unsigned u32x4 __attribute__((ext_vector_type(4)));
constexpr int BM = 256, BK = 64, HALF = 128, HTB = HALF * BK * 2  , STAGE_BYTES = 8 * HTB, NXCD = 8, WGM = 8;

__host__ __device__ __forceinline__ int lds_byte(int r, int c) { const int st = (r >> 4) * 2 + (c >> 5), rr = r & 15, cc = c & 31, ob = rr * 64 + cc * 2; return st * 1024 + (ob ^ (((ob >> 9) & 1) << 5)); }
__host__ __device__ __forceinline__ void stage_rc(int b, int& R, int& C) { const int st = b / 1024, sb = b % 1024, swz = sb ^ (((sb >> 9) & 1) << 5); R = (st >> 1) * 16 + swz / 64; C = (st & 1) * 32 + (swz % 64) / 2; }
__host__ __device__ __forceinline__ int perm32(int rho) { const int n = rho >> 4, i = rho & 15; return 8 * (i >> 2) + 4 * n + (i & 3); }

struct Unit { int pm, pn, ko; };
struct Gemm { const bf16_t* A; const bf16_t* Bt; int M, N, K, ld; };

struct StaticOrder {
    int nM, nN, nwg, G, c;
    __host__ __device__ void init(int M, int N, int G_, int c_) { nM = M / BM; nN = N / BM; nwg = nM * nN; G = G_; c = c_; }
    __host__ __device__ bool next(int i, Unit& u) const {
        const long L = (long)i * G + c; if (L >= nwg) return false;
        int wgid = (int)L; { const int q = nwg / NXCD, r = nwg % NXCD, xcd = wgid % NXCD, off = wgid / NXCD; wgid = (xcd < r ? xcd * (q + 1) : r * (q + 1) + (xcd - r) * q) + off; }
        const int nig = WGM * nN, gid = wgid / nig, fm = gid * WGM, gsz = (nM - fm) < WGM ? (nM - fm) : WGM;
        u.pm = fm + ((wgid % nig) % gsz); u.pn = (wgid % nig) / gsz; u.ko = 0; return true;
    }
    __device__ __forceinline__ void a_ready(const Unit&) const {}
    __device__ __forceinline__ void done(const Unit&) const {}
};
typedef float f32x2 __attribute__((ext_vector_type(2)));
typedef __bf16 bf16x2_t __attribute__((ext_vector_type(2)));
__device__ __forceinline__ unsigned cvt_pk_bf16(float lo, float hi) { f32x2 v = {lo, hi}; bf16x2_t b = __builtin_convertvector(v, bf16x2_t); return __builtin_bit_cast(unsigned, b); }
__device__ __forceinline__ float sigmoidf_fast(float x) { return __builtin_amdgcn_rcpf(1.0f + __expf(-x)); }
__device__ __forceinline__ float bf2f(unsigned short b) { return __uint_as_float(((unsigned)b) << 16); }

struct EpiIn {
    static constexpr bool PERM = true, AFTER_DRAIN = false, HAS_MID = false;
    bf16_t* Z; bf16_t* G; const float* bgate; const float* ropec; const float* ropes;
    __device__ __forceinline__ void operator()(const f32x4 (&acc)[2][2][4][2], const Unit& u, int wr, int wc, int fr, int fq) const {
        const int row0 = u.pm * BM + wr * 64 + fr;
        if (u.pn >= 19) {
            const int col0 = (u.pn - 19) * BM + wc * 32 + 8 * fq;
            f32x4 bv[2][2];
#pragma unroll
            for (int bj = 0; bj < 2; ++bj)
#pragma unroll
                for (int n = 0; n < 2; ++n) bv[bj][n] = *(const f32x4*)(bgate + col0 + bj * HALF + 4 * n);
#pragma unroll
            for (int ai = 0; ai < 2; ++ai)
#pragma unroll
                for (int m = 0; m < 4; ++m) { bf16_t* rowp = G + (size_t)(row0 + ai * HALF + m * 16) * 8192 + col0;
#pragma unroll
                    for (int bj = 0; bj < 2; ++bj) { const f32x4 v0 = acc[ai][bj][m][0] + bv[bj][0], v1 = acc[ai][bj][m][1] + bv[bj][1];
                        u32x4 w; w.x = cvt_pk_bf16(sigmoidf_fast(v0[0]), sigmoidf_fast(v0[1])); w.y = cvt_pk_bf16(sigmoidf_fast(v0[2]), sigmoidf_fast(v0[3]));
                        w.z = cvt_pk_bf16(sigmoidf_fast(v1[0]), sigmoidf_fast(v1[1])); w.w = cvt_pk_bf16(sigmoidf_fast(v1[2]), sigmoidf_fast(v1[3]));
                        *(u32x4*)(rowp + bj * HALF) = w; } }
        } else {
            const int colt = u.pn * BM, col0 = colt + wc * 32 + 8 * fq;
            const bool rope_tile = (u.pn <= 2) && (u.pm < 32);
#pragma unroll
            for (int ai = 0; ai < 2; ++ai)
#pragma unroll
                for (int m = 0; m < 4; ++m) { const int t = row0 + ai * HALF + m * 16; bf16_t* rowp = Z + (size_t)t * 4864 + col0;
#pragma unroll
                    for (int bj = 0; bj < 2; ++bj) { f32x4 v0 = acc[ai][bj][m][0], v1 = acc[ai][bj][m][1];
                        if (rope_tile && (colt + bj * HALF < 640)) {
                            const int pos = (wc & 1) ? (t & 63) : (t >> 6);
                            const float* cp = ropec + pos * 16 + 8 * (fq & 1); const float* sp = ropes + pos * 16 + 8 * (fq & 1);
                            const f32x4 c0 = *(const f32x4*)cp, c1 = *(const f32x4*)(cp + 4), s0 = *(const f32x4*)sp, s1 = *(const f32x4*)(sp + 4);
                            f32x4 p0, p1;
#pragma unroll
                            for (int e = 0; e < 4; ++e) { p0[e] = __shfl_xor(v0[e], 32); p1[e] = __shfl_xor(v1[e], 32); }
                            if (fq < 2) { v0 = v0 * c0 - p0 * s0; v1 = v1 * c1 - p1 * s1; }
                            else        { v0 = p0 * s0 + v0 * c0; v1 = p1 * s1 + v1 * c1; }
                        }
                        u32x4 w; w.x = cvt_pk_bf16(v0[0], v0[1]); w.y = cvt_pk_bf16(v0[2], v0[3]); w.z = cvt_pk_bf16(v1[0], v1[1]); w.w = cvt_pk_bf16(v1[2], v1[3]);
                        *(u32x4*)(rowp + bj * HALF) = w; } }
        }
    }
};

struct EpiMerge {
    static constexpr bool PERM = true, AFTER_DRAIN = false, HAS_MID = true;
    const bf16_t* G; bf16_t* O;
    __device__ __forceinline__ void mid(f32x4 (&acc)[2][2][4][2], const Unit& u, int seg, int wr, int wc, int fr, int fq) const {
        int row0 = u.pm * BM + wr * 64 + fr; asm volatile("" : "+v"(row0));
        const int col0 = u.pn * BM + wc * 32 + 8 * fq;
#pragma unroll
        for (int ai = 0; ai < 2; ++ai) {
            u32x4 ga[4][2], gb[4][2];
#pragma unroll
            for (int m = 0; m < 4; ++m) { const bf16_t* rowp = G + (size_t)(row0 + ai * HALF + m * 16) * 8192 + col0 + seg * 2048;
#pragma unroll
                for (int bj = 0; bj < 2; ++bj) { ga[m][bj] = *(const u32x4*)(rowp + bj * HALF); gb[m][bj] = *(const u32x4*)(rowp + 2048 + bj * HALF); } }
#pragma unroll
            for (int m = 0; m < 4; ++m)
#pragma unroll
                for (int bj = 0; bj < 2; ++bj)
#pragma unroll
                    for (int e = 0; e < 4; ++e) { const unsigned a = ga[m][bj][e], b = gb[m][bj][e];
                        const float a0 = fmaxf(__uint_as_float(a << 16), 1e-30f), a1 = fmaxf(__uint_as_float(a & 0xffff0000u), 1e-30f);
                        const float b0 = fmaxf(__uint_as_float(b << 16), 1e-30f), b1 = fmaxf(__uint_as_float(b & 0xffff0000u), 1e-30f);
                        acc[ai][bj][m][e >> 1][(e & 1) * 2]     *= a0 * __builtin_amdgcn_rcpf(b0);
                        acc[ai][bj][m][e >> 1][(e & 1) * 2 + 1] *= a1 * __builtin_amdgcn_rcpf(b1); }
            asm volatile("" ::: "memory"); }
    }
    __device__ __forceinline__ void operator()(const f32x4 (&acc)[2][2][4][2], const Unit& u, int wr, int wc, int fr, int fq) const {
        const int row0 = u.pm * BM + wr * 64 + fr, col0 = u.pn * BM + wc * 32 + 8 * fq;
#pragma unroll
        for (int ai = 0; ai < 2; ++ai) {
            u32x4 gq[4][2];
#pragma unroll
            for (int m = 0; m < 4; ++m)
#pragma unroll
                for (int bj = 0; bj < 2; ++bj) gq[m][bj] = *(const u32x4*)(G + (size_t)(row0 + ai * HALF + m * 16) * 8192 + col0 + 3 * 2048 + bj * HALF);
#pragma unroll
            for (int m = 0; m < 4; ++m) { bf16_t* op = O + (size_t)(row0 + ai * HALF + m * 16) * 2048 + col0;
#pragma unroll
                for (int bj = 0; bj < 2; ++bj) { const u32x4 g = gq[m][bj]; float gv[8];
#pragma unroll
                    for (int e = 0; e < 4; ++e) { gv[2 * e] = fmaxf(__uint_as_float(g[e] << 16), 1e-30f); gv[2 * e + 1] = fmaxf(__uint_as_float(g[e] & 0xffff0000u), 1e-30f); }
                    const f32x4 v0 = acc[ai][bj][m][0], v1 = acc[ai][bj][m][1];
                    u32x4 w; w.x = cvt_pk_bf16(v0[0] * gv[0], v0[1] * gv[1]); w.y = cvt_pk_bf16(v0[2] * gv[2], v0[3] * gv[3]); w.z = cvt_pk_bf16(v1[0] * gv[4], v1[1] * gv[5]); w.w = cvt_pk_bf16(v1[2] * gv[6], v1[3] * gv[7]);
                    *(u32x4*)(op + bj * HALF) = w; } }
            asm volatile("" ::: "memory"); }
    }
};

struct EpiResid {
    static constexpr bool PERM = false, AFTER_DRAIN = false, HAS_MID = false;
    float* xl; float* xc; const float* gate_l; const float* gate_c;
    __device__ __forceinline__ void operator()(const f32x4 (&acc)[2][2][4][2], const Unit& u, int wr, int wc, int fr, int fq) const {
        const int row0 = u.pm * BM + wr * 64 + fr, col0 = u.pn * BM + wc * 32 + 4 * fq;
        const bool lat = u.pm < 32;
        float* X = lat ? xl : (xc - (size_t)8192 * 2048); const float* gate = lat ? gate_l : gate_c;
        f32x4 gv[2][2];
#pragma unroll
        for (int bj = 0; bj < 2; ++bj)
#pragma unroll
            for (int n = 0; n < 2; ++n) gv[bj][n] = *(const f32x4*)(gate + col0 + bj * HALF + n * 16);
#pragma unroll
        for (int ai = 0; ai < 2; ++ai) {
            f32x4 xo[4][2][2];
#pragma unroll
            for (int m = 0; m < 4; ++m)
#pragma unroll
                for (int bj = 0; bj < 2; ++bj)
#pragma unroll
                    for (int n = 0; n < 2; ++n) xo[m][bj][n] = *(const f32x4*)(X + (size_t)(row0 + ai * HALF + m * 16) * 2048 + col0 + bj * HALF + n * 16);
#pragma unroll
            for (int m = 0; m < 4; ++m)
#pragma unroll
                for (int bj = 0; bj < 2; ++bj)
#pragma unroll
                    for (int n = 0; n < 2; ++n) *(f32x4*)(X + (size_t)(row0 + ai * HALF + m * 16) * 2048 + col0 + bj * HALF + n * 16) = xo[m][bj][n] + gv[bj][n] * acc[ai][bj][m][n];
            asm volatile("" ::: "memory"); }
    }
};

struct EpiSwiglu {
    static constexpr bool PERM = true, AFTER_DRAIN = false, HAS_MID = false;
    bf16_t* O;
    __device__ __forceinline__ void operator()(const f32x4 (&acc)[2][2][4][2], const Unit& u, int wr, int wc, int fr, int fq) const {
        const int row0 = u.pm * BM + wr * 64 + fr, col0 = u.pn * HALF + wc * 32 + 8 * fq;
#pragma unroll
        for (int ai = 0; ai < 2; ++ai)
#pragma unroll
            for (int m = 0; m < 4; ++m) { bf16_t* op = O + (size_t)(row0 + ai * HALF + m * 16) * 5632 + col0; float o[8];
#pragma unroll
                for (int n = 0; n < 2; ++n)
#pragma unroll
                    for (int e = 0; e < 4; ++e) { const float g = acc[ai][0][m][n][e], uu = acc[ai][1][m][n][e]; o[4 * n + e] = g * sigmoidf_fast(g) * uu; }
                u32x4 w; w.x = cvt_pk_bf16(o[0], o[1]); w.y = cvt_pk_bf16(o[2], o[3]); w.z = cvt_pk_bf16(o[4], o[5]); w.w = cvt_pk_bf16(o[6], o[7]);
                *(u32x4*)op = w; }
    }
};


struct SplitKOrder {
    int pm, nN, S, ksub, G, c;
    __host__ __device__ bool next(int i, Unit& u) const { const int L = i * G + (G - 1 - c); if (L >= nN * S) return false; u.pm = pm; u.pn = L % nN; u.ko = (L / nN) * ksub; return true; }
    __device__ __forceinline__ void a_ready(const Unit&) const {}
    __device__ __forceinline__ void done(const Unit&) const {}
};
struct EpiSlab {
    static constexpr bool PERM = false, AFTER_DRAIN = false, HAS_MID = false;
    float* slab; int ksub;
    __device__ __forceinline__ void operator()(const f32x4 (&acc)[2][2][4][2], const Unit& u, int wr, int wc, int fr, int fq) const {
        const int row0 = wr * 64 + fr, col0 = u.pn * BM + wc * 32 + 4 * fq;
        float* base = slab + (size_t)(u.ko / ksub) * 256 * 2048;
#pragma unroll
        for (int ai = 0; ai < 2; ++ai)
#pragma unroll
            for (int m = 0; m < 4; ++m) { float* rowp = base + (size_t)(row0 + ai * HALF + m * 16) * 2048 + col0;
#pragma unroll
                for (int bj = 0; bj < 2; ++bj)
#pragma unroll
                    for (int n = 0; n < 2; ++n) *(f32x4*)(rowp + bj * HALF + n * 16) = acc[ai][bj][m][n]; }
    }
};
template <class Epi, class Sched, bool ALIGN_EPI = false, bool SP2 = false>
__device__ __forceinline__ void gemm_phase(PG8_LAS unsigned char* lds, const Gemm g, const Sched& S, const Epi& E) {
    int tid_ = threadIdx.x; asm volatile("" : "+v"(tid_));
    const int tid = tid_, wid = __builtin_amdgcn_readfirstlane(tid >> 6), lane = tid & 63, wr = wid >> 2, wc = wid & 3, fr = lane & 15, fq = lane >> 4;
    const int K = g.ld, nt = g.K / BK;
    unsigned voffA[2], voffB[2];
#pragma unroll
    for (int i = 0; i < 2; ++i) { int R, C; stage_rc(tid * 16 + i * 8192, R, C); const int Rb = Epi::PERM ? ((R & ~31) + perm32(R & 31)) : R;
        voffA[i] = (unsigned)(R * K + C) * 2u; voffB[i] = (unsigned)(Rb * K + C) * 2u; }
    const size_t kstep = (size_t)(BK * 2);
    const size_t hstep = (size_t)HALF * K * 2;
    const size_t tstep = 2 * hstep;
    const unsigned ldsw = (unsigned)wid * 1024u;
    const int aoff = lds_byte(wr * 64 + fr, fq * 8), boff = lds_byte(wc * 32 + fr, fq * 8);
#define PG8_SA(b, h) (((b) * 2 + (h)) * HTB)
#define PG8_SB(b, h) ((4 + (b) * 2 + (h)) * HTB)
#define PG8_STAGE(bufoff, gbase, voff) do { _Pragma("unroll") for (int _i = 0; _i < 2; ++_i) \
        __builtin_amdgcn_global_load_lds((const unsigned*)((const char*)(gbase) + (voff)[_i]), (PG8_LAS unsigned*)(lds + (bufoff) + ldsw + _i * 8192), 16, 0, 0); } while (0)
#define PG8_LDA(dst, b, h) do { _Pragma("unroll") for (int m = 0; m < 4; ++m) _Pragma("unroll") for (int k = 0; k < 2; ++k) dst[m][k] = *(const PG8_LAS bf16x8*)(lds + PG8_SA(b, h) + aoff + m * 2048 + k * 1024); } while (0)
#define PG8_LDB(dst, b, h) do { _Pragma("unroll") for (int n = 0; n < 2; ++n) _Pragma("unroll") for (int k = 0; k < 2; ++k) dst[n][k] = *(const PG8_LAS bf16x8*)(lds + PG8_SB(b, h) + boff + n * 2048 + k * 1024); } while (0)
#define PG8_MMA(ai, bj, At, Bt) do { __builtin_amdgcn_s_setprio(1); _Pragma("unroll") for (int m = 0; m < 4; ++m) _Pragma("unroll") for (int n = 0; n < 2; ++n) _Pragma("unroll") for (int k = 0; k < 2; ++k) \
        acc[ai][bj][m][n] = __builtin_amdgcn_mfma_f32_16x16x32_bf16(Bt[n][k], At[m][k], acc[ai][bj][m][n], 0, 0, 0); __builtin_amdgcn_s_setprio(0); } while (0)
#define PG8_WAIT_V(n) asm volatile("s_waitcnt vmcnt(" #n ")" ::: "memory")
#define PG8_WAIT_L(n) asm volatile("s_waitcnt lgkmcnt(" #n ")" ::: "memory")
#define PG8_BAR __builtin_amdgcn_s_barrier()
#define PG8_SCHED __builtin_amdgcn_sched_barrier(0)
    Unit cur, nxt; int ui = 0;
    if (!S.next(0, cur)) return;
    f32x4 acc[2][2][4][2];
#pragma unroll
    for (int a = 0; a < 2; ++a)
#pragma unroll
        for (int b = 0; b < 2; ++b)
#pragma unroll
            for (int m = 0; m < 4; ++m)
#pragma unroll
                for (int n = 0; n < 2; ++n) acc[a][b][m][n] = (f32x4){0.f, 0.f, 0.f, 0.f};
    bf16x8 At[4][2], B0[2][2], B1[2][2];
    const char* cA = (const char*)g.A + (size_t)cur.pm * tstep + (size_t)cur.ko * 2; const char* cB = (const char*)g.Bt + (size_t)cur.pn * tstep + (size_t)cur.ko * 2;
    S.a_ready(cur);
    if constexpr (SP2) {
        PG8_STAGE(PG8_SB(0, 0), cB, voffB); PG8_STAGE(PG8_SB(0, 1), cB + hstep, voffB); PG8_STAGE(PG8_SA(0, 0), cA, voffA); PG8_STAGE(PG8_SA(0, 1), cA + hstep, voffA);
        if (wr == 1) PG8_BAR;
        PG8_WAIT_V(2); PG8_BAR;
        PG8_STAGE(PG8_SB(1, 0), cB + kstep, voffB); PG8_STAGE(PG8_SA(1, 0), cA + kstep, voffA); PG8_STAGE(PG8_SB(1, 1), cB + hstep + kstep, voffB);
        PG8_WAIT_V(6); PG8_BAR;
    } else {
        PG8_STAGE(PG8_SB(0, 0), cB, voffB); PG8_STAGE(PG8_SA(0, 0), cA, voffA); PG8_STAGE(PG8_SB(0, 1), cB + hstep, voffB); PG8_STAGE(PG8_SA(0, 1), cA + hstep, voffA);
        if (wr == 1) PG8_BAR;
        PG8_WAIT_V(4); PG8_BAR;
        PG8_STAGE(PG8_SB(1, 0), cB + kstep, voffB); PG8_STAGE(PG8_SA(1, 0), cA + kstep, voffA); PG8_STAGE(PG8_SB(1, 1), cB + hstep + kstep, voffB);
        PG8_WAIT_V(6); PG8_BAR;
    }
    for (;;) {
        const bool has_next = S.next(ui + 1, nxt);
        const char* nA = has_next ? (const char*)g.A + (size_t)nxt.pm * tstep + (size_t)nxt.ko * 2 : cA; const char* nB = has_next ? (const char*)g.Bt + (size_t)nxt.pn * tstep + (size_t)nxt.ko * 2 : cB;
        for (int t = 0; t < nt; t += 2) {
            const bool last = (t == nt - 2);
            const char* a1 = cA + (size_t)(t + 1) * kstep;
            const char* a2 = last ? nA : cA + (size_t)(t + 2) * kstep; const char* b2 = last ? nB : cB + (size_t)(t + 2) * kstep;
            const char* a3 = a2 + kstep; const char* b3 = b2 + kstep;
            if (last && has_next) S.a_ready(nxt);
            if constexpr (SP2) {
            PG8_LDB(B0, 0, 0); PG8_LDB(B1, 0, 1); PG8_SCHED; PG8_LDA(At, 0, 0); PG8_STAGE(PG8_SA(1, 1), a1 + hstep, voffA);
            PG8_WAIT_V(8); PG8_WAIT_L(0); PG8_BAR; PG8_MMA(0, 0, At, B0); PG8_MMA(0, 1, At, B1); PG8_BAR; PG8_SCHED;
            PG8_LDA(At, 0, 1); PG8_STAGE(PG8_SB(0, 0), b2, voffB); PG8_STAGE(PG8_SB(0, 1), b2 + hstep, voffB); PG8_STAGE(PG8_SA(0, 0), a2, voffA);
            PG8_WAIT_V(8); PG8_WAIT_L(0); PG8_BAR; PG8_MMA(1, 0, At, B0); PG8_MMA(1, 1, At, B1); PG8_BAR; PG8_SCHED;
            PG8_LDB(B0, 1, 0); PG8_LDB(B1, 1, 1); PG8_SCHED; PG8_LDA(At, 1, 0); PG8_STAGE(PG8_SA(0, 1), a2 + hstep, voffA);
            PG8_WAIT_V(8); PG8_WAIT_L(0); PG8_BAR; PG8_MMA(0, 0, At, B0); PG8_MMA(0, 1, At, B1); PG8_BAR; PG8_SCHED;
            PG8_LDA(At, 1, 1); PG8_STAGE(PG8_SB(1, 0), b3, voffB); PG8_STAGE(PG8_SB(1, 1), b3 + hstep, voffB); PG8_STAGE(PG8_SA(1, 0), a3, voffA);
            PG8_WAIT_V(8); PG8_WAIT_L(0); PG8_BAR; PG8_MMA(1, 0, At, B0); PG8_MMA(1, 1, At, B1); PG8_BAR; PG8_SCHED;
            } else {
            PG8_LDB(B0, 0, 0); PG8_SCHED; PG8_LDA(At, 0, 0); PG8_STAGE(PG8_SA(1, 1), a1 + hstep, voffA);
            PG8_WAIT_L(8); PG8_BAR; PG8_WAIT_L(0); PG8_MMA(0, 0, At, B0); PG8_BAR; PG8_SCHED;
            PG8_LDB(B1, 0, 1); PG8_STAGE(PG8_SB(0, 0), b2, voffB);
            PG8_BAR; PG8_WAIT_L(0); PG8_MMA(0, 1, At, B1); PG8_BAR;
            PG8_LDA(At, 0, 1); PG8_STAGE(PG8_SA(0, 0), a2, voffA);
            PG8_BAR; PG8_WAIT_L(0); PG8_MMA(1, 0, At, B0); PG8_BAR; PG8_SCHED;
            PG8_STAGE(PG8_SB(0, 1), b2 + hstep, voffB);
            PG8_WAIT_V(6); PG8_BAR; PG8_MMA(1, 1, At, B1); PG8_BAR;
            PG8_LDB(B0, 1, 0); PG8_SCHED; PG8_LDA(At, 1, 0); PG8_STAGE(PG8_SA(0, 1), a2 + hstep, voffA);
            PG8_WAIT_L(8); PG8_BAR; PG8_WAIT_L(0); PG8_MMA(0, 0, At, B0); PG8_BAR; PG8_SCHED;
            PG8_LDB(B1, 1, 1); PG8_STAGE(PG8_SB(1, 0), b3, voffB);
            PG8_BAR; PG8_WAIT_L(0); PG8_MMA(0, 1, At, B1); PG8_BAR;
            PG8_LDA(At, 1, 1); PG8_STAGE(PG8_SA(1, 0), a3, voffA);
            PG8_BAR; PG8_WAIT_L(0); PG8_MMA(1, 0, At, B0); PG8_BAR; PG8_SCHED;
            PG8_STAGE(PG8_SB(1, 1), b3 + hstep, voffB);
            PG8_WAIT_V(6); PG8_BAR; PG8_MMA(1, 1, At, B1); PG8_BAR;
            }
            if constexpr (Epi::HAS_MID) { if ((((t + 2) & 7) == 0) && ((t + 2) < nt)) E.mid(acc, cur, ((t + 2) >> 3) - 1, wr, wc, fr, fq); }
        }
        if constexpr (ALIGN_EPI) { if (wr == 0) PG8_BAR; }
        if constexpr (!Epi::AFTER_DRAIN) { E(acc, cur, wr, wc, fr, fq); S.done(cur); }
        if (!has_next) break;
#pragma unroll
        for (int a = 0; a < 2; ++a)
#pragma unroll
            for (int b = 0; b < 2; ++b)
#pragma unroll
                for (int m = 0; m < 4; ++m)
#pragma unroll
                    for (int n = 0; n < 2; ++n) acc[a][b][m][n] = (f32x4){0.f, 0.f, 0.f, 0.f};
        cur = nxt; cA = nA; cB = nB; ++ui;
        if constexpr (ALIGN_EPI) { if (wr == 1) PG8_BAR; }
    }
    PG8_WAIT_V(0);
    if constexpr (!ALIGN_EPI) { if (wr == 0) PG8_BAR; }
    PG8_BAR;
    if constexpr (Epi::AFTER_DRAIN) { E.fused(acc, cur, wr, wc, fr, fq, lds, wid, lane); S.done(cur); }
#undef PG8_SA
#undef PG8_SB
#undef PG8_STAGE
#undef PG8_LDA
#undef PG8_LDB
#undef PG8_MMA
#undef PG8_WAIT_V
#undef PG8_WAIT_L
#undef PG8_BAR
#undef PG8_SCHED
}
}

constexpr int NWAVES = 8;
constexpr int DM = 2048, SEQ = 8192, CTXL = 256, MT = SEQ + CTXL, DEPTH = 4, GRIDW = 64;
constexpr int INC = 13056, ZC = 4864, GC = 8192, BW = 512, FHID = 5632, F2 = 2 * FHID, NMOD = 6 * DM;
constexpr int ZC_QA = 0, ZC_KA = 512, ZC_VA = 640, ZC_QB = 768, ZC_KB = 1280, ZC_VB = 1792, ZC_XR = 2304, ZC_GR = 2816, ZC_XD = 3328, ZC_BD = 3840, ZC_CD = 4352;
constexpr float EPS = 1e-6f, LOG2E = 1.4426950408889634f;
constexpr int NPL = 9;
constexpr int N_PHASES = 2 + DEPTH * NPL;
#ifndef MK_ONE_LAUNCH
#define MK_ONE_LAUNCH 1
#endif
constexpr size_t MiB = 1u << 20;
constexpr size_t WS_CTL = 0, CTL_ZERO_BYTES = 1 * MiB;
constexpr size_t WS_MOD = 1 * MiB;
constexpr size_t WS_ROPE = 2 * MiB;
constexpr size_t WS_GW = 3 * MiB;
constexpr size_t WS_XC = 5 * MiB;
constexpr size_t WS_PS = 7 * MiB;
constexpr size_t WS_AB = 16 * MiB;
constexpr size_t WS_H = 88 * MiB;
constexpr size_t WS_Z = 124 * MiB;
constexpr size_t WS_G = 204 * MiB;
constexpr size_t WS_BR = 336 * MiB;
constexpr size_t WS_MG = 372 * MiB;
constexpr size_t WS_FH = 408 * MiB;
constexpr size_t WS_W = 512 * MiB;
constexpr size_t WL_IN = 0, WL_BR = 51 * MiB, WL_OUT = 59 * MiB, WL_F1 = 67 * MiB, WL_F2 = 111 * MiB, WL_STRIDE = 133 * MiB;
constexpr size_t WS_END = WS_W + DEPTH * WL_STRIDE;
constexpr size_t WS_SLAB = WS_END + 80 * MiB;
constexpr size_t WS_NEED = WS_SLAB + 24 * MiB;
static_assert((size_t)INC * DM * 2 <= WL_BR && (size_t)DM * DM * 2 <= WL_OUT - WL_BR && (size_t)F2 * DM * 2 <= WL_F2 - WL_F1 && (size_t)DM * FHID * 2 <= WL_STRIDE - WL_F2, "weight map");
static_assert(WS_AB + (size_t)4 * MT * 512 * 4 <= WS_H && WS_H + (size_t)MT * DM * 2 <= WS_Z && WS_Z + (size_t)MT * ZC * 2 <= WS_G && WS_G + (size_t)MT * GC * 2 <= WS_BR && WS_FH + (size_t)MT * FHID * 2 <= WS_W, "d_ws map");
constexpr int CW_BAR = 4096;
constexpr int RING_BYTES = 131072;
constexpr int LDSCTL_OFF = RING_BYTES, MISC_OFF = LDSCTL_OFF + 320;
constexpr int LDS_BYTES = 147456;

#define GAS __attribute__((address_space(1)))
#define LAS __attribute__((address_space(3)))
typedef unsigned short bf16;
typedef unsigned v4u __attribute__((ext_vector_type(4)));
typedef unsigned v2u __attribute__((ext_vector_type(2)));
typedef float f32x4 __attribute__((ext_vector_type(4)));
typedef float f32x16 __attribute__((ext_vector_type(16)));
typedef short bf16x8 __attribute__((ext_vector_type(8)));
typedef short s16x4 __attribute__((ext_vector_type(4)));
typedef GAS unsigned gu32;
#define RLX_AGENT __ATOMIC_RELAXED, __HIP_MEMORY_SCOPE_AGENT
#define LDS_WAIT() asm volatile("s_waitcnt lgkmcnt(0)" ::: "memory")
__device__ __forceinline__ unsigned f2bf(float f) { unsigned u = __builtin_bit_cast(unsigned, f); return (u + 0x7fffu + ((u >> 16) & 1u)) >> 16; }
__device__ __forceinline__ unsigned pk2(float lo, float hi) { return f2bf(lo) | (f2bf(hi) << 16); }
__device__ __forceinline__ float bflo(unsigned w) { return __uint_as_float(w << 16); }
__device__ __forceinline__ float bfhi(unsigned w) { return __uint_as_float(w & 0xffff0000u); }
__device__ __forceinline__ float bf1(bf16 b) { return __uint_as_float(((unsigned)b) << 16); }
__device__ __forceinline__ float sigm(float x) { return __builtin_amdgcn_rcpf(1.0f + __expf(-x)); }

#define XB_TMO      128
#define XB_XCNT(j)  (256  + 64 * (j))
#define XB_XSUB(j)  (1280 + 64 * (j))
#define XB_XGEN(j)  (2304 + 64 * (j))
#define XB_TOP      3328
#define XB_TOPGEN   3392
#define XCD_BAR_WORDS 3456
#define XB_SPIN_CAP (1u << 18)

__device__ __forceinline__ unsigned xb_ld(unsigned* p)              { return __hip_atomic_load(p, __ATOMIC_RELAXED, __HIP_MEMORY_SCOPE_AGENT); }
__device__ __forceinline__ unsigned xb_add(unsigned* p, unsigned v) { return __hip_atomic_fetch_add(p, v, __ATOMIC_RELAXED, __HIP_MEMORY_SCOPE_AGENT); }
__device__ __forceinline__ unsigned xb_xcc_id() { return (unsigned)__builtin_amdgcn_s_getreg((3 << 11) | 20) & 0xFu; }
#define XB_SPIN(cond, bar) do { unsigned _sp = 0; while (cond) { __builtin_amdgcn_s_sleep(1); \
    if ((++_sp & 255u) == 0u) { if (xb_ld(&(bar)[XB_TMO])) break; if (_sp > XB_SPIN_CAP) { atomicAdd(&(bar)[XB_TMO], 1u); break; } } } } while (0)

struct XcdBarrier {
    unsigned* bar; unsigned x;
    volatile LAS unsigned* st;
};

__device__ __forceinline__ XcdBarrier xcd_barrier_post(unsigned* bar, volatile LAS unsigned* st) {
    XcdBarrier b; b.bar = bar; b.x = xb_xcc_id(); b.st = st;
    if (threadIdx.x == 0) (void)xb_add(&bar[XB_XCNT(b.x)], 1u);
    return b;
}
__device__ __forceinline__ void xcd_barrier_complete(unsigned* bar, unsigned x, unsigned& nloc, unsigned& nx) {
    const unsigned G = gridDim.x * gridDim.y * gridDim.z;
    unsigned sum, cnt, mine, sp = 0u;
    for (;;) {
        sum = 0u; cnt = 0u; mine = 0u;
#pragma unroll
        for (unsigned j = 0; j < 16; ++j) { const unsigned c = xb_ld(&bar[XB_XCNT(j)]); sum += c; cnt += (c > 0u) ? 1u : 0u; mine = (j == x) ? c : mine; }
        if (sum == G) break;
        __builtin_amdgcn_s_sleep(1);
        if ((++sp & 255u) == 0u) { if (xb_ld(&bar[XB_TMO])) break; if (sp > XB_SPIN_CAP) { atomicAdd(&bar[XB_TMO], 1u); break; } }
    }
    nloc = mine > 0u ? mine : 1u; nx = cnt > 0u ? cnt : 1u;
}

__device__ __forceinline__ void xcd_barrier(const XcdBarrier& b) {
    asm volatile("s_waitcnt vmcnt(0)" ::: "memory");
    __syncthreads();
    if (threadIdx.x == 0) {
        unsigned* bar = b.bar;
        __builtin_amdgcn_s_waitcnt(0);
        unsigned nloc = b.st[0], nx = b.st[1];
        if (nloc == 0u) { xcd_barrier_complete(bar, b.x, nloc, nx); b.st[0] = nloc; b.st[1] = nx; }
        const unsigned old = xb_add(&bar[XB_XSUB(b.x)], 1u);
        const unsigned gen = old / nloc;
        if (old + 1u == (gen + 1u) * nloc) {
            __builtin_amdgcn_fence(__ATOMIC_RELEASE, "agent");
            asm volatile("s_waitcnt vmcnt(0)" ::: "memory");
            const unsigned og = xb_add(&bar[XB_TOP], 1u);
            const unsigned tg = og / nx;
            if (og + 1u == (tg + 1u) * nx) xb_add(&bar[XB_TOPGEN], 1u);
            else XB_SPIN(xb_ld(&bar[XB_TOPGEN]) == tg, bar);
            __builtin_amdgcn_fence(__ATOMIC_ACQUIRE, "agent");
            xb_add(&bar[XB_XGEN(b.x)], 1u);
            asm volatile("s_waitcnt vmcnt(0)" ::: "memory");
        } else {
            XB_SPIN(xb_ld(&bar[XB_XGEN(b.x)]) == gen, bar);
            __builtin_amdgcn_fence(__ATOMIC_ACQUIRE, "agent");
            asm volatile("s_waitcnt vmcnt(0)" ::: "memory");
        }
    }
    __syncthreads();
}

#define KAS __attribute__((address_space(4)))
struct Args { const float* in[25]; float* out; unsigned char* ws; int ph_lo, ph_hi; };
struct Frame {
    LAS unsigned char* lds;
    volatile LAS unsigned* MISC;
    gu32* ctl;
    int tid, lane, wave, G;
    const KAS Args* ka;
    float* out; unsigned char* ws;
};
enum { I_X = 0, I_C, I_CTX, I_CCTX, I_WMOD, I_BMOD, I_NORM1, I_NORM2, I_WIN, I_BGATE, I_ASINK, I_NBBIAS, I_CCONVW, I_CCONVB, I_CWA, I_CBA, I_CWX, I_CBX, I_CLAM, I_DCONVW, I_WBR, I_WOUT, I_WF1, I_WF2, I_FNORM };

__device__ __forceinline__ float wave_sum(float v) {
#pragma unroll
    for (int o = 1; o < 64; o <<= 1) v += __shfl_xor(v, o);
    return v;
}

__device__ __forceinline__ void transpose_item(const float* W, int ldw, int k0, int n0, bf16* dst, int ldt, LAS float* scr, int lane) {
    { f32x4 v[8]; const int c4 = lane & 7;
#pragma unroll
      for (int i = 0; i < 8; ++i) v[i] = *(const f32x4*)(W + (size_t)(k0 + 8 * i + (lane >> 3)) * ldw + n0 + 4 * c4);
#pragma unroll
      for (int i = 0; i < 8; ++i) { LAS float* d = scr + (8 * i + (lane >> 3)) * 33 + 4 * c4; d[0] = v[i][0]; d[1] = v[i][1]; d[2] = v[i][2]; d[3] = v[i][3]; } }
    LDS_WAIT(); asm volatile("" ::: "memory");
    const int c = lane & 7;
#pragma unroll
    for (int j = 0; j < 4; ++j) { const int n = (lane >> 3) + 8 * j; const LAS float* s = scr + (8 * c) * 33 + n;
        v4u o; o.x = pk2(s[0 * 33], s[1 * 33]); o.y = pk2(s[2 * 33], s[3 * 33]); o.z = pk2(s[4 * 33], s[5 * 33]); o.w = pk2(s[6 * 33], s[7 * 33]);
        *(GAS v4u*)(dst + (size_t)n * ldt + 8 * c) = o; }
    LDS_WAIT(); asm volatile("" ::: "memory");
}

__device__ __forceinline__ void convert_layer(Frame& F, int l, int gw, int ngw, int it_lo = 0, int it_hi = 1 << 30) {
    LAS float* scr = (LAS float*)(F.lds + F.wave * 16384);
    constexpr int I_IN = (DM / 64) * (INC / 32), I_BR = 4 * (BW / 64) * (DM / 32), I_OUT = (DM / 64) * (DM / 32), I_F1 = (DM / 64) * (F2 / 32), I_F2 = (FHID / 64) * (DM / 32);
    constexpr int PER_L = I_IN + I_BR + I_OUT + I_F1 + I_F2;
    unsigned char* wl = F.ws + WS_W + (size_t)l * WL_STRIDE;
    if (it_hi > PER_L) it_hi = PER_L;
    for (int it = it_lo + gw; it < it_hi; it += ngw) {
        int r = it;
        if (r < I_IN) { const int nblk = INC / 32, kb = r / nblk, nb = r % nblk;
            transpose_item(F.ka->in[I_WIN] + (size_t)l * DM * INC, INC, 64 * kb, 32 * nb, (bf16*)(wl + WL_IN) + (size_t)(32 * nb) * DM + 64 * kb, DM, scr, F.lane); continue; }
        r -= I_IN;
        if (r < I_BR) { const int per = (BW / 64) * (DM / 32), k = r / per, rr = r % per, nblk = DM / 32, kb = rr / nblk, nb = rr % nblk;
            transpose_item(F.ka->in[I_WBR] + (size_t)(l * 4 + k) * BW * DM, DM, 64 * kb, 32 * nb, (bf16*)(wl + WL_BR) + (size_t)(32 * nb) * DM + k * BW + 64 * kb, DM, scr, F.lane); continue; }
        r -= I_BR;
        if (r < I_OUT) { const int nblk = DM / 32, kb = r / nblk, nb = r % nblk;
            transpose_item(F.ka->in[I_WOUT] + (size_t)l * DM * DM, DM, 64 * kb, 32 * nb, (bf16*)(wl + WL_OUT) + (size_t)(32 * nb) * DM + 64 * kb, DM, scr, F.lane); continue; }
        r -= I_OUT;
        if (r < I_F1) { const int nblk = F2 / 32, kb = r / nblk, nb = r % nblk; const int n0 = 32 * nb;
            const int j = n0 < FHID ? n0 : n0 - FHID; const int drow = (j >> 7) * 256 + (n0 < FHID ? 0 : 128) + (j & 127);
            transpose_item(F.ka->in[I_WF1] + (size_t)l * DM * F2, F2, 64 * kb, n0, (bf16*)(wl + WL_F1) + (size_t)drow * DM + 64 * kb, DM, scr, F.lane); continue; }
        r -= I_F1;
        { const int nblk = DM / 32, kb = r / nblk, nb = r % nblk;
            transpose_item(F.ka->in[I_WF2] + (size_t)l * FHID * DM, DM, 64 * kb, 32 * nb, (bf16*)(wl + WL_F2) + (size_t)(32 * nb) * FHID + 64 * kb, FHID, scr, F.lane); }
    }
}

__device__ __forceinline__ void p0_prologue(Frame& F, int nconv) {
    const int gw = blockIdx.x * NWAVES + F.wave, NGW = F.G * NWAVES;
    const int gt = blockIdx.x * (NWAVES * 64) + F.tid, NGT = F.G * NWAVES * 64;
    if (gt < 2048) {
        const int pos = gt >> 4, i = gt & 15;
        const float freq = exp2f(-(float)i * (13.287712379549449f / 16.0f));
        const float ang = (float)pos * freq;
        const float k = rintf(ang * 0.15915494309189535f);
        float r = fmaf(-k, 6.28125f, ang); r = fmaf(-k, 0.0019353071795864769f, r);
        float* rc = (float*)(F.ws + WS_ROPE);
        rc[gt] = __cosf(r); rc[2048 + gt] = __sinf(r);
    }
    {
        const f32x4* xs = (const f32x4*)F.ka->in[I_X]; f32x4* xd = (f32x4*)F.out;
        for (int i = gt; i < SEQ * DM / 4; i += NGT) xd[i] = xs[i];
        const f32x4* cs = (const f32x4*)F.ka->in[I_CTX]; f32x4* cd = (f32x4*)(F.ws + WS_XC);
        for (int i = gt; i < CTXL * DM / 4; i += NGT) cd[i] = cs[i];
    }
    {
        LAS float* sl = (LAS float*)F.lds;
        LAS float* sc = sl + 2048;
        LAS float* red = sc + 2048;
        for (int i = F.tid; i < 2048; i += NWAVES * 64) { const float a = F.ka->in[I_C][i], b = F.ka->in[I_CCTX][i]; sl[i] = a * sigm(a); sc[i] = b * sigm(b); }
        __syncthreads();
        const int half = F.lane >> 5, c4 = F.lane & 31;
        for (int item = blockIdx.x; item < DEPTH * 96; item += F.G) {
            const int l = item / 96, col0 = (item % 96) * 128;
            const float* W = F.ka->in[I_WMOD] + (size_t)l * DM * NMOD + col0 + 4 * c4;
            f32x4 al = {0.f, 0.f, 0.f, 0.f}, ac = {0.f, 0.f, 0.f, 0.f};
#pragma unroll 8
            for (int i = 0; i < 128; ++i) { const int row = F.wave * 256 + 2 * i + half; const f32x4 v = *(const f32x4*)(W + (size_t)row * NMOD); al += sl[row] * v; ac += sc[row] * v; }
#pragma unroll
            for (int e = 0; e < 4; ++e) { al[e] += __shfl_xor(al[e], 32); ac[e] += __shfl_xor(ac[e], 32); }
            if (half == 0) { *(LAS f32x4*)(red + (F.wave * 2 + 0) * 128 + 4 * c4) = al; *(LAS f32x4*)(red + (F.wave * 2 + 1) * 128 + 4 * c4) = ac; }
            __syncthreads();
            if (F.tid < 256) { const int which = F.tid >> 7, col = F.tid & 127; float s = F.ka->in[I_BMOD][l * NMOD + col0 + col];
#pragma unroll
                for (int w = 0; w < 8; ++w) s += red[(w * 2 + which) * 128 + col];
                ((float*)(F.ws + WS_MOD))[(size_t)(l * 2 + which) * NMOD + col0 + col] = s; }
            __syncthreads();
        }
    }
    __syncthreads();
    {
        LAS float* scr = (LAS float*)(F.lds + F.wave * 16384);
        for (int r = gw; r < 64 * 8; r += NGW) {
            const int mi = r >> 3, sub = r & 7, kb = sub >> 2, nb = sub & 3;
            const int blk = mi & 3, map = (mi >> 2) & 1, ld = mi >> 3;
            const float* W = (map ? F.ka->in[I_CWX] : F.ka->in[I_CWA]) + (size_t)(ld * 4 + blk) * 16384;
            bf16* dst = (bf16*)(F.ws + WS_GW) + (size_t)mi * 16384 + (size_t)(32 * nb) * 128 + 64 * kb;
            transpose_item(W, 128, 64 * kb, 32 * nb, dst, 128, scr, F.lane);
        }
    }
    for (int l = 0; l < nconv; ++l) convert_layer(F, l, gw, NGW);
}

template <int NS> __device__ __forceinline__ void norm_phase(Frame& F, int l, int which, int nrows, bool pend, const float* pgate) {
    const int gw = blockIdx.x * NWAVES + F.wave, NGW = F.G * NWAVES;
    const float* gain = (which ? F.ka->in[I_NORM2] : F.ka->in[I_NORM1]) + l * DM;
    bf16* H = (bf16*)(F.ws + WS_H);
    for (int m = gw; m < nrows; m += NGW) {
        const bool lat = m < SEQ;
        const float* xrow = lat ? F.out + (size_t)m * DM : (const float*)(F.ws + WS_XC) + (size_t)(m - SEQ) * DM;
        const float* mod = (const float*)(F.ws + WS_MOD) + (size_t)(l * 2 + (lat ? 0 : 1)) * NMOD + (which ? 3 * DM : 0);
        f32x4 v[8]; float ss = 0.f;
#pragma unroll
        for (int j = 0; j < 8; ++j) v[j] = *(const f32x4*)(xrow + 4 * F.lane + 256 * j);
        if (!lat && pend) {
            const float* sp = (const float*)(F.ws + WS_SLAB) + (size_t)(m - SEQ) * DM + 4 * F.lane;
#pragma unroll
            for (int j = 0; j < 8; ++j) { f32x4 t[NS];
#pragma unroll
                for (int s = 0; s < NS; ++s) t[s] = *(const f32x4*)(sp + (size_t)s * CTXL * DM + 256 * j);
                f32x4 a = t[0];
#pragma unroll
                for (int s = 1; s < NS; ++s) a += t[s];
                v[j] += *(const f32x4*)(pgate + 4 * F.lane + 256 * j) * a;
                *(f32x4*)((float*)(F.ws + WS_XC) + (size_t)(m - SEQ) * DM + 4 * F.lane + 256 * j) = v[j]; }
        }
#pragma unroll
        for (int j = 0; j < 8; ++j) ss += (v[j][0] * v[j][0] + v[j][1] * v[j][1]) + (v[j][2] * v[j][2] + v[j][3] * v[j][3]);
        const float rstd = 1.0f / sqrtf(wave_sum(ss) * (1.0f / DM) + EPS);
#pragma unroll
        for (int j = 0; j < 8; ++j) { const int c = 4 * F.lane + 256 * j;
            const f32x4 g = *(const f32x4*)(gain + c), sh = *(const f32x4*)(mod + c), scl = *(const f32x4*)(mod + DM + c);
            const f32x4 o = (v[j] * rstd * g) * (1.0f + scl) + sh;
            v2u w; w.x = pk2(o[0], o[1]); w.y = pk2(o[2], o[3]);
            *(v2u*)(H + (size_t)m * DM + c) = w; }
    }
}
__device__ __forceinline__ void final_norm_phase(Frame& F) {
    const int gw = blockIdx.x * NWAVES + F.wave, NGW = F.G * NWAVES;
    const float* gain = F.ka->in[I_FNORM];
    for (int m = gw; m < SEQ; m += NGW) {
        float* xrow = F.out + (size_t)m * DM;
        f32x4 v[8]; float ss = 0.f;
#pragma unroll
        for (int j = 0; j < 8; ++j) { v[j] = *(const f32x4*)(xrow + 4 * F.lane + 256 * j); ss += (v[j][0] * v[j][0] + v[j][1] * v[j][1]) + (v[j][2] * v[j][2] + v[j][3] * v[j][3]); }
        const float rstd = 1.0f / sqrtf(wave_sum(ss) * (1.0f / DM) + EPS);
#pragma unroll
        for (int j = 0; j < 8; ++j) { const int c = 4 * F.lane + 256 * j; const f32x4 g = *(const f32x4*)(gain + c); *(f32x4*)(xrow + c) = (v[j] * rstd) * g; }
    }
}

#define MFMA32(a, b, c) __builtin_amdgcn_mfma_f32_32x32x16_bf16((a), (b), (c), 0, 0, 0)
__device__ __forceinline__ int crow(int reg, int h) { return (reg & 3) + 8 * (reg >> 2) + 4 * h; }
typedef short v4i16_t __attribute__((ext_vector_type(4)));
__device__ __forceinline__ s16x4 tr_read(LAS unsigned char* p) { return __builtin_bit_cast(s16x4, __builtin_amdgcn_ds_read_tr16_b64_v4i16((LAS v4i16_t*)p)); }
__device__ __forceinline__ unsigned cvtpk(float lo, float hi) { return pg8::cvt_pk_bf16(lo, hi); }
#define WG_BAR() do { asm volatile("s_waitcnt lgkmcnt(0)" ::: "memory"); __builtin_amdgcn_s_barrier(); asm volatile("" ::: "memory"); } while (0)

constexpr int KVP = 128;
constexpr int KV_TILE = 64 * KVP, KV_BUF = 2 * KV_TILE;
constexpr int ATT_NB = 6, ATT_D = 4;
constexpr int ATT_TAB_OFF = ATT_NB * KV_BUF;
constexpr float ATT_SCALE = 0.125f;
constexpr float NEG_BIG = -1.0e30f;

struct AttnState { f32x16 o0, o1; float m, l; };
template <class ScoreFn>
__device__ __forceinline__ void attn_step(AttnState& st, const bf16x8 (&qf)[4], LAS unsigned char* kb, LAS unsigned char* vb, int lane, const ScoreFn& sf) {
    const int r = lane & 31, h = lane >> 5;
    f32x16 s0, s1;
#pragma unroll
    for (int i = 0; i < 16; ++i) { s0[i] = 0.f; s1[i] = 0.f; }
    LAS unsigned char* kp = kb + r * KVP; const int kx = (h ^ (r & 7)) << 4;
#pragma unroll
    for (int ds = 0; ds < 4; ++ds) {
        const bf16x8 k0 = *(const LAS bf16x8*)(kp + (kx ^ (ds << 5))), k1 = *(const LAS bf16x8*)(kp + 32 * KVP + (kx ^ (ds << 5)));
        s0 = MFMA32(k0, qf[ds], s0); s1 = MFMA32(k1, qf[ds], s1);
    }
    float mt = NEG_BIG;
    __builtin_amdgcn_sched_barrier(0);
#pragma unroll
    for (int i = 0; i < 16; ++i) { s0[i] = sf(s0[i], crow(i, h), r); mt = fmaxf(mt, s0[i]); if ((i & 7) == 7) __builtin_amdgcn_sched_barrier(0); }
#pragma unroll
    for (int i = 0; i < 16; ++i) { s1[i] = sf(s1[i], 32 + crow(i, h), r); mt = fmaxf(mt, s1[i]); if ((i & 7) == 7) __builtin_amdgcn_sched_barrier(0); }
    mt = fmaxf(mt, __shfl_xor(mt, 32));
    const float mn = fmaxf(st.m, mt), alpha = __builtin_amdgcn_exp2f(st.m - mn);
    float ps = 0.f;
#pragma unroll
    for (int i = 0; i < 16; ++i) { s0[i] = __builtin_amdgcn_exp2f(s0[i] - mn); s1[i] = __builtin_amdgcn_exp2f(s1[i] - mn); ps += s0[i] + s1[i]; }
    st.l = st.l * alpha + ps; st.m = mn;
#pragma unroll
    for (int i = 0; i < 16; ++i) { st.o0[i] *= alpha; st.o1[i] *= alpha; }
    __builtin_amdgcn_sched_barrier(0);
    v4u pw[4];
    pw[0].x = cvtpk(s0[0], s0[1]); pw[0].y = cvtpk(s0[2], s0[3]); pw[0].z = cvtpk(s0[4], s0[5]); pw[0].w = cvtpk(s0[6], s0[7]);
    pw[1].x = cvtpk(s0[8], s0[9]); pw[1].y = cvtpk(s0[10], s0[11]); pw[1].z = cvtpk(s0[12], s0[13]); pw[1].w = cvtpk(s0[14], s0[15]);
    pw[2].x = cvtpk(s1[0], s1[1]); pw[2].y = cvtpk(s1[2], s1[3]); pw[2].z = cvtpk(s1[4], s1[5]); pw[2].w = cvtpk(s1[6], s1[7]);
    pw[3].x = cvtpk(s1[8], s1[9]); pw[3].y = cvtpk(s1[10], s1[11]); pw[3].z = cvtpk(s1[12], s1[13]); pw[3].w = cvtpk(s1[14], s1[15]);
    const int i16 = lane & 15, q = i16 >> 2, p = i16 & 3, dhalf = (lane >> 4) & 1;
    LAS unsigned char* vrow = vb + (4 * h + q) * KVP + (p & 1) * 8;
    LAS unsigned char* vp0 = vrow + (((2 * dhalf + (p >> 1)) ^ (4 * h + q)) << 4); LAS unsigned char* vp1 = vrow + (((4 + 2 * dhalf + (p >> 1)) ^ (4 * h + q)) << 4);
#pragma unroll
    for (int ks = 0; ks < 4; ++ks) {
        const s16x4 l0 = tr_read(vp0 + (16 * ks) * KVP), h0 = tr_read(vp0 + (16 * ks + 8) * KVP);
        const s16x4 l1 = tr_read(vp1 + (16 * ks) * KVP), h1 = tr_read(vp1 + (16 * ks + 8) * KVP);
        const bf16x8 v0 = (bf16x8){l0[0], l0[1], l0[2], l0[3], h0[0], h0[1], h0[2], h0[3]};
        const bf16x8 v1 = (bf16x8){l1[0], l1[1], l1[2], l1[3], h1[0], h1[1], h1[2], h1[3]};
        const bf16x8 pf = __builtin_bit_cast(bf16x8, pw[ks]);
        st.o0 = MFMA32(v0, pf, st.o0); st.o1 = MFMA32(v1, pf, st.o1);
    }
}
__device__ __forceinline__ void attn_store(const AttnState& st, float linv, bf16* Op  , int lane) {
    const int r = lane & 31, h = lane >> 5;
    bf16* rowp = Op + (size_t)r * DM + 4 * h;
#pragma unroll
    for (int g = 0; g < 4; ++g) {
        v2u w0, w1;
        w0.x = cvtpk(st.o0[4 * g] * linv, st.o0[4 * g + 1] * linv); w0.y = cvtpk(st.o0[4 * g + 2] * linv, st.o0[4 * g + 3] * linv);
        w1.x = cvtpk(st.o1[4 * g] * linv, st.o1[4 * g + 1] * linv); w1.y = cvtpk(st.o1[4 * g + 2] * linv, st.o1[4 * g + 3] * linv);
        *(v2u*)(rowp + 8 * g) = w0; *(v2u*)(rowp + 32 + 8 * g) = w1;
    }
}
struct ScorePlain { __device__ __forceinline__ float operator()(float s, int, int) const { return s * (ATT_SCALE * LOG2E); } };
struct ScoreWin {
    int dk;
    __device__ __forceinline__ float operator()(float s, int krow, int qr) const { const int d = dk + krow - qr; return (d >= -128 && d <= 128) ? s * (ATT_SCALE * LOG2E) : NEG_BIG; }
};
struct ScoreNb {
    const LAS float* tab;
    int cq0, dr;
    __device__ __forceinline__ float operator()(float s, int ck, int qr) const {
        const int cq = cq0 + qr; int cs = cq - 8; cs = cs < 0 ? 0 : (cs > 48 ? 48 : cs);
        int dc = ck - cq + 15; dc = dc < 0 ? 0 : (dc > 30 ? 30 : dc);
        const float b = tab[dr * 31 + dc];
        return (ck >= cs && ck < cs + 16) ? (s * ATT_SCALE + b) * LOG2E : NEG_BIG;
    }
};

template <bool ISB>
__device__ __forceinline__ void attn_wg_item(Frame& F, int l, int idx) {
    const int lane = F.lane, w = F.wave, tid = F.tid;
    const bf16* Z = (const bf16*)(F.ws + WS_Z); bf16* BR = (bf16*)(F.ws + WS_BR);
    LAS unsigned char* ring = F.lds;
    LAS float* tab = (LAS float*)(F.lds + ATT_TAB_OFF);
    const bool lat = idx < 256; const int ix = lat ? idx : idx - 256;
    int kcol, vcol, qcol, ocol, qrow0, nloc, krow_base, NS, sink_h = 0;
    int r0 = 0, kmin = 0;
    if (!ISB) {
        const int hk = ix & 1, blk = ix >> 1, g = w >> 1, pt = w & 1, hq = hk * 4 + g; sink_h = hq;
        kcol = ZC_KA + hk * 64; vcol = ZC_VA + hk * 64; qcol = ZC_QA + hq * 64; ocol = hq * 64;
        if (lat) { const int p0 = 64 * blk; int klo = p0 - 128; if (klo < 0) klo = 0; int khi = p0 + 192; if (khi > SEQ) khi = SEQ; krow_base = klo; nloc = (khi - klo) >> 6; qrow0 = p0 + 32 * pt; }
        else { krow_base = 0; nloc = 0; qrow0 = SEQ + 64 * blk + 32 * pt; }
    } else {
        const int hb = lat ? (ix & 7) : ix;
        kcol = ZC_KB + hb * 64; vcol = ZC_VB + hb * 64; qcol = ZC_QB + hb * 64; ocol = 512 + hb * 64;
        if (lat) { const int rg = ix >> 3; r0 = 4 * rg; kmin = r0 - 4; kmin = kmin < 0 ? 0 : (kmin > 120 ? 120 : kmin); int kmax = r0 + 3 - 4; kmax = (kmax < 0 ? 0 : (kmax > 120 ? 120 : kmax)) + 7;
            krow_base = kmin * GRIDW; nloc = kmax - kmin + 1; qrow0 = (r0 + (w >> 1)) * GRIDW + 32 * (w & 1);
            const float* bsrc = F.ka->in[I_NBBIAS] + (size_t)(l * 8 + hb) * 465;
            if (tid < 465) tab[tid] = bsrc[tid]; }
        else { krow_base = 0; nloc = 0; qrow0 = SEQ + 32 * w; }
    }
    NS = nloc + 4;
    bf16x8 qf[4];
    { const bf16* Qp = Z + (size_t)(qrow0 + (lane & 31)) * ZC + qcol + 8 * (lane >> 5);
#pragma unroll
      for (int ds = 0; ds < 4; ++ds) qf[ds] = *(const bf16x8*)(Qp + 16 * ds); }
    const int drow = 8 * w + (lane >> 3), dch = (lane & 7) ^ (lane >> 3);
    const bf16* gk = Z + (size_t)drow * ZC + kcol + 8 * dch; const bf16* gv = Z + (size_t)drow * ZC + vcol + 8 * dch;
    LAS unsigned char* dk0 = ring + w * 1024;
#define TILE_ROW(s) ((s) < nloc ? krow_base + 64 * (s) : SEQ + 64 * ((s) - nloc))
#define ATT_DMA(t) do { const int t_ = (t) < NS ? (t) : NS - 1; const size_t ro_ = (size_t)TILE_ROW(t_) * ZC; LAS unsigned char* d_ = dk0 + ((t) % ATT_NB) * KV_BUF; \
        __builtin_amdgcn_global_load_lds((const unsigned*)(gk + ro_), (LAS unsigned*)d_, 16, 0, 0); __builtin_amdgcn_global_load_lds((const unsigned*)(gv + ro_), (LAS unsigned*)(d_ + KV_TILE), 16, 0, 0); } while (0)
    AttnState st;
#pragma unroll
    for (int i = 0; i < 16; ++i) { st.o0[i] = 0.f; st.o1[i] = 0.f; }
    st.m = NEG_BIG; st.l = 0.f;
#pragma unroll
    for (int t = 0; t < ATT_D; ++t) ATT_DMA(t);
    for (int s = 0; s < NS; ++s) {
        ATT_DMA(s + ATT_D);
        asm volatile("s_waitcnt vmcnt(8)" ::: "memory");
        WG_BAR();
        LAS unsigned char* cur = ring + (s % ATT_NB) * KV_BUF;
        if (s >= nloc) { ScorePlain sf; attn_step(st, qf, cur, cur + KV_TILE, lane, sf); }
        else if (!ISB) { int dkv = krow_base + 64 * s - qrow0; asm volatile("" : "+v"(dkv)); ScoreWin sf{dkv}; attn_step(st, qf, cur, cur + KV_TILE, lane, sf); }
        else { const int gr = r0 + (w >> 1); int kr0 = gr - 4; kr0 = kr0 < 0 ? 0 : (kr0 > 120 ? 120 : kr0); const int kr = kmin + s;
            if (kr >= kr0 && kr < kr0 + 8) { int cq0v = 32 * (w & 1); asm volatile("" : "+v"(cq0v));
                ScoreNb sf{tab, cq0v, kr - gr + 7}; attn_step(st, qf, cur, cur + KV_TILE, lane, sf); } }
    }
    asm volatile("s_waitcnt vmcnt(0)" ::: "memory");
    WG_BAR();
#undef ATT_DMA
#undef TILE_ROW
    float lsum = st.l + __shfl_xor(st.l, 32);
    if (!ISB) lsum += __builtin_amdgcn_exp2f(F.ka->in[I_ASINK][l * 8 + sink_h] * LOG2E - st.m);
    attn_store(st, 1.0f / lsum, BR + (size_t)qrow0 * DM + ocol, lane);
}

__device__ __forceinline__ void dconv_phase(Frame& F, int l, int nrows) {
    const int gt = blockIdx.x * (NWAVES * 64) + F.tid, NGT = F.G * NWAVES * 64;
    const bf16* Z = (const bf16*)(F.ws + WS_Z); bf16* BR = (bf16*)(F.ws + WS_BR);
    const float* w = F.ka->in[I_DCONVW] + (size_t)l * 3 * 512;
    for (int it = gt; it < nrows * 64; it += NGT) {
        const int row = it >> 6, c0 = (it & 63) * 8;
        const int lo = row < SEQ ? 0 : SEQ, hi = row < SEQ ? SEQ : MT;
        float acc[8];
#pragma unroll
        for (int e = 0; e < 8; ++e) acc[e] = 0.f;
#pragma unroll
        for (int j = 0; j < 3; ++j) { const int rr = row + j - 1;
            if (rr >= lo && rr < hi) { const v4u cd = *(const v4u*)(Z + (size_t)rr * ZC + ZC_CD + c0), xd = *(const v4u*)(Z + (size_t)rr * ZC + ZC_XD + c0);
                const f32x4 w0 = *(const f32x4*)(w + j * 512 + c0), w1 = *(const f32x4*)(w + j * 512 + c0 + 4);
#pragma unroll
                for (int e = 0; e < 4; ++e) { acc[2 * e] += (e < 2 ? w0[2 * e] : w1[2 * e - 4]) * (bflo(cd[e]) * bflo(xd[e])); acc[2 * e + 1] += (e < 2 ? w0[2 * e + 1] : w1[2 * e - 3]) * (bfhi(cd[e]) * bfhi(xd[e])); } } }
        const v4u bd = *(const v4u*)(Z + (size_t)row * ZC + ZC_BD + c0);
        v4u o;
#pragma unroll
        for (int e = 0; e < 4; ++e) o[e] = pk2(acc[2 * e] * bflo(bd[e]), acc[2 * e + 1] * bfhi(bd[e]));
        *(v4u*)(BR + (size_t)row * DM + 1536 + c0) = o;
    }
}

__device__ __forceinline__ float gelu_tanh(float x) { const float z = 0.7978845608028654f * (x + 0.044715f * x * x * x); const float e = __expf(2.0f * z); return 0.5f * x * (1.0f + (1.0f - 2.0f * __builtin_amdgcn_rcpf(e + 1.0f))); }
constexpr int UB_PITCH = 1040;
constexpr int SC_UB = 0, SC_CARRY = 64 * UB_PITCH;
__device__ __forceinline__ void scan_xload(Frame& F, int row_c, int lo, int hi, float (&xv)[67]) {
    const bf16* xp = (const bf16*)(F.ws + WS_Z) + ZC_XR + F.tid;
#pragma unroll
    for (int t = 0; t < 67; ++t) { const int rr = row_c - 2 + t; xv[t] = (rr >= lo && rr < hi) ? bf1(xp[(size_t)rr * ZC]) : 0.f; }
}
__device__ __forceinline__ void scan_utile(Frame& F, int l, const float (&xv)[67]) {
    LAS unsigned char* Ub = F.lds + SC_UB;
    const int ch = F.tid;
    const float* cw = F.ka->in[I_CCONVW] + (size_t)l * 4 * 512; const float w0 = cw[ch], w1 = cw[512 + ch], w2 = cw[1024 + ch], w3 = cw[1536 + ch], cb = F.ka->in[I_CCONVB][l * 512 + ch];
#pragma unroll
    for (int tt = 0; tt < 64; ++tt) { const float u = cb + w0 * xv[tt] + w1 * xv[tt + 1] + w2 * xv[tt + 2] + w3 * xv[tt + 3];
        *(LAS bf16*)(Ub + tt * UB_PITCH + ch * 2) = (bf16)f2bf(u); }
}
struct GateW { bf16x8 a[8], x[8]; float ba, bx, sp; };
__device__ __forceinline__ void scan_loadw(Frame& F, int l, int dir, int n, int g, GateW& W) {
    const int lane = F.lane, r = lane & 31, h = lane >> 5;
    const bf16* GWa = (const bf16*)(F.ws + WS_GW) + (size_t)((((l * 2 + dir) * 2 + 0) * 4 + n)) * 16384; const bf16* GWx = GWa + (size_t)4 * 16384;
    const bf16* wa = GWa + (size_t)(32 * g + r) * 128 + 8 * h; const bf16* wx = GWx + (size_t)(32 * g + r) * 128 + 8 * h;
#pragma unroll
    for (int kk = 0; kk < 8; ++kk) { W.a[kk] = *(const bf16x8*)(wa + 16 * kk); W.x[kk] = *(const bf16x8*)(wx + 16 * kk); }
    const int pidx = (l * 2 + dir) * 512 + n * 128 + 32 * g + r;
    W.ba = F.ka->in[I_CBA][pidx]; W.bx = F.ka->in[I_CBX][pidx]; W.sp = log1pf(__expf(-F.ka->in[I_CLAM][pidx]));
}
__device__ __forceinline__ void scan_gates(Frame& F, const GateW& W, int sub, int n, int ch, f32x16& a, f32x16& b) {
    const int lane = F.lane, r = lane & 31, h = lane >> 5;
    LAS unsigned char* Ub = F.lds + SC_UB + (32 * sub) * UB_PITCH;
    f32x16 pa, px;
#pragma unroll
    for (int i = 0; i < 16; ++i) { pa[i] = 0.f; px[i] = 0.f; }
#pragma unroll
    for (int kk = 0; kk < 8; ++kk) { const bf16x8 af = *(const LAS bf16x8*)(Ub + r * UB_PITCH + (n * 128 + 16 * kk + 8 * h) * 2); pa = MFMA32(af, W.a[kk], pa); px = MFMA32(af, W.x[kk], px); }
#pragma unroll
    for (int i = 0; i < 16; ++i) { const int tt = crow(i, h);
        const float u = bf1(*(const LAS bf16*)(Ub + tt * UB_PITCH + ch * 2));
        const float rr = sigm(pa[i] + W.ba), ii = sigm(px[i] + W.bx), la = -8.0f * rr * W.sp;
        const float av = __expf(la); a[i] = av; b[i] = __builtin_amdgcn_sqrtf(fmaxf(fmaf(-av, av, 1.0f), 0.f)) * (ii * u); }
}
struct TileComp { float fA[4], fB[4], sA[4], sB[4]; };
__device__ __forceinline__ void tile_comp(const f32x16& a, const f32x16& b, int h, bool bwd, TileComp& T) {
#pragma unroll
    for (int q = 0; q < 4; ++q) {
        const float a0 = a[4 * q], a1 = a[4 * q + 1], a2 = a[4 * q + 2], a3 = a[4 * q + 3], b0 = b[4 * q], b1 = b[4 * q + 1], b2 = b[4 * q + 2], b3 = b[4 * q + 3];
        const float GA = (a0 * a1) * (a2 * a3);
        const float GB = bwd ? ((b3 * a2 + b2) * a1 + b1) * a0 + b0 : ((b0 * a1 + b1) * a2 + b2) * a3 + b3;
        const float OA = __shfl_xor(GA, 32), OB = __shfl_xor(GB, 32);
        const bool mine_first = bwd ? (h == 1) : (h == 0);
        T.fA[q] = mine_first ? GA : OA; T.fB[q] = mine_first ? GB : OB; T.sA[q] = mine_first ? OA : GA; T.sB[q] = mine_first ? OB : GB;
    }
}
__device__ __forceinline__ void tile_total(const TileComp& T, bool bwd, float& P, float& S) {
#pragma unroll
    for (int qq = 0; qq < 4; ++qq) { const int q = bwd ? 3 - qq : qq; S = (S * T.fA[q] + T.fB[q]) * T.sA[q] + T.sB[q]; P = (P * T.fA[q]) * T.sA[q]; }
}
__device__ __forceinline__ void tile_scan(const f32x16& a, const f32x16& b, const TileComp& T, int h, bool bwd, float& hv, f32x16& y) {
    const bool mine_first = bwd ? (h == 1) : (h == 0);
#pragma unroll
    for (int qq = 0; qq < 4; ++qq) { const int q = bwd ? 3 - qq : qq;
        const float mid = T.fA[q] * hv + T.fB[q];
        float x = mine_first ? hv : mid;
#pragma unroll
        for (int ee = 0; ee < 4; ++ee) { const int e = bwd ? 3 - ee : ee; x = a[4 * q + e] * x + b[4 * q + e]; y[4 * q + e] += x; }
        hv = T.sA[q] * mid + T.sB[q];
    }
}
__device__ __forceinline__ void scan_pass1_item(Frame& F, int l, int c) {
    float* PS = (float*)(F.ws + WS_PS);
    const int row_c = 64 * c, lo = row_c < SEQ ? 0 : SEQ, hi = row_c < SEQ ? SEQ : MT;
    const int lane = F.lane, r = lane & 31, h = lane >> 5, n = F.wave & 3, gp = F.wave >> 2;
    { float xv[67]; scan_xload(F, row_c, lo, hi, xv); scan_utile(F, l, xv); }
    WG_BAR();
#pragma unroll 1
    for (int gl = 0; gl < 2; ++gl)
#pragma unroll
        for (int dir = 0; dir < 2; ++dir) {
            const int g = 2 * gp + gl, ch = n * 128 + 32 * g + r;
            __builtin_amdgcn_sched_barrier(0);
            GateW W; scan_loadw(F, l, dir, n, g, W);
            float P = 1.f, S = 0.f;
#pragma unroll
            for (int si = 0; si < 2; ++si) { const int sub = dir == 0 ? si : 1 - si;
                f32x16 a, b; scan_gates(F, W, sub, n, ch, a, b);
                TileComp T; tile_comp(a, b, h, dir == 1, T); tile_total(T, dir == 1, P, S); }
            if (h == 0) *(float2*)(PS + ((size_t)(dir * 132 + c) * 512 + ch) * 2) = make_float2(P, S);
        }
    WG_BAR();
}
template <class IdxFn> __device__ __forceinline__ float fold_ps(const float* PSd, int ch, int n, const IdxFn& idx) {
    float hv = 0.f;
    for (int k0 = 0; k0 < n; k0 += 32) { float2 t[32];
#pragma unroll
        for (int j = 0; j < 32; ++j) { const int k = (k0 + j < n) ? k0 + j : n - 1; t[j] = *(const float2*)((const char*)PSd + (unsigned)((idx(k) * 512 + ch) * 8)); }
#pragma unroll
        for (int j = 0; j < 32; ++j) if (k0 + j < n) hv = t[j].x * hv + t[j].y;
    }
    return hv;
}
struct IdxFwd { __device__ __forceinline__ int operator()(int k) const { return k < 4 ? 128 + k : k - 4; } };
struct IdxBwd { __device__ __forceinline__ int operator()(int k) const { return k < 4 ? 131 - k : 127 - (k - 4); } };
__device__ __forceinline__ void scan_pass2_item(Frame& F, int l, int c) {
    const bf16* Z = (const bf16*)(F.ws + WS_Z); bf16* BR = (bf16*)(F.ws + WS_BR);
    const float* PS = (const float*)(F.ws + WS_PS);
    LAS float* CAR = (LAS float*)(F.lds + SC_CARRY);
    const int row_c = 64 * c, lo = row_c < SEQ ? 0 : SEQ, hi = row_c < SEQ ? SEQ : MT;
    const int lane = F.lane, r = lane & 31, h = lane >> 5, n = F.wave & 3, gp = F.wave >> 2;
    {
        const int ch = F.tid, nf = c >= 128 ? c - 128 : c + 4, nb = c >= 128 ? 131 - c : 4 + (127 - c);
        CAR[ch] = fold_ps(PS, ch, nf, IdxFwd());
        CAR[512 + ch] = fold_ps(PS + (size_t)132 * 512 * 2, ch, nb, IdxBwd());
        __builtin_amdgcn_sched_barrier(0);
        float xv[67]; scan_xload(F, row_c, lo, hi, xv);
        scan_utile(F, l, xv);
    }
    WG_BAR();
#pragma unroll 1
    for (int gl = 0; gl < 2; ++gl) {
        const int g = 2 * gp + gl, ch = n * 128 + 32 * g + r;
        const bf16* zp = Z + ((size_t)row_c + 4 * h) * ZC + ZC_GR + ch; bf16* bp = BR + ((size_t)row_c + 4 * h) * DM + 1024 + ch;
        f32x16 y[2];
#pragma unroll
        for (int i = 0; i < 16; ++i) { y[0][i] = 0.f; y[1][i] = 0.f; }
#pragma unroll
        for (int dir = 0; dir < 2; ++dir) {
            __builtin_amdgcn_sched_barrier(0);
            GateW W; scan_loadw(F, l, dir, n, g, W);
            float hv = CAR[dir * 512 + ch];
#pragma unroll
            for (int si = 0; si < 2; ++si) { const int sub = dir == 0 ? si : 1 - si;
                f32x16 a, b; scan_gates(F, W, sub, n, ch, a, b);
                TileComp T; tile_comp(a, b, h, dir == 1, T); tile_scan(a, b, T, h, dir == 1, hv, y[sub]); }
        }
        __builtin_amdgcn_sched_barrier(0);
#pragma unroll
        for (int sub = 0; sub < 2; ++sub) {
            bf16 grv[16];
#pragma unroll
            for (int i = 0; i < 16; ++i) grv[i] = zp[(size_t)(32 * sub + (i & 3) + 8 * (i >> 2)) * ZC];
#pragma unroll
            for (int i = 0; i < 16; ++i) bp[(size_t)(32 * sub + (i & 3) + 8 * (i >> 2)) * DM] = (bf16)f2bf(y[sub][i] * gelu_tanh(bf1(grv[i])));
            __builtin_amdgcn_sched_barrier(0);
        }
    }
    WG_BAR();
}

__global__ void __launch_bounds__(NWAVES * 64, 2) mk_fwd(Args args) {
    extern __shared__ __attribute__((aligned(16))) unsigned char lds[];
    Frame F;
    F.lds = (LAS unsigned char*)lds;
    F.MISC = (volatile LAS unsigned*)(F.lds + MISC_OFF);
    F.tid = threadIdx.x; F.lane = F.tid & 63; F.wave = __builtin_amdgcn_readfirstlane(F.tid >> 6);
    F.G = gridDim.x;
    F.ka = (const KAS Args*)__builtin_amdgcn_kernarg_segment_ptr();
    F.out = args.out; F.ws = args.ws;
    F.ctl = (gu32*)(F.ws + WS_CTL);
    for (int u = F.tid; u < (LDS_BYTES - LDSCTL_OFF) / 4; u += NWAVES * 64) ((LAS unsigned*)(F.lds + LDSCTL_OFF))[u] = 0u;
    __syncthreads();
#if MK_ONE_LAUNCH
    XcdBarrier bar = xcd_barrier_post((unsigned*)(F.ctl + CW_BAR), F.MISC + 8);
#define GRID_BAR() xcd_barrier(bar)
#else
#define GRID_BAR() do { } while (0)
#endif
    const int lo = args.ph_lo, hi = args.ph_hi;
    constexpr int CONV_Q1 = 0;
    const bool split_conv = F.G >= 200;
#define IN(k) (lo <= (k) && (k) < hi)
#ifndef PHMASK
#define PHMASK 0x7ff
#endif
#define PHON(b) (((PHMASK) >> (b)) & 1)
#ifndef REPMASK
#define REPMASK 0
#endif
#define REPS(b) ((((REPMASK) >> (b)) & 1) ? 2 : 1)
#define FRESH() do { int t_ = threadIdx.x; asm volatile("" : "+v"(t_)); F.tid = t_; F.lane = t_ & 63; } while (0)
#define SEAM(k) do { if (IN(k) && IN((k) + 1)) GRID_BAR(); } while (0)

    for (int rep_ = 0; rep_ < REPS(0); ++rep_) { if (rep_) GRID_BAR(); if (PHON(0) && IN(0)) { FRESH(); p0_prologue(F, split_conv ? 1 : DEPTH); } }
    SEAM(0);

    for (int l = 0; l < DEPTH; ++l) {
        const int pb = 1 + l * NPL;
        const bool last = (l == DEPTH - 1);
        const int Mg = last ? SEQ : MT;
        unsigned char* wl = F.ws + WS_W + (size_t)l * WL_STRIDE;
        const float* modl = (const float*)(F.ws + WS_MOD) + (size_t)(l * 2) * NMOD; const float* modc = modl + NMOD;

        for (int rep_ = 0; rep_ < REPS(1); ++rep_) { if (rep_) GRID_BAR();
        if (PHON(1) && IN(pb + 0)) { FRESH(); norm_phase<11>(F, l, 0, MT, rep_ == 0 && l > 0, modc - 2 * NMOD + 5 * DM); }
        }
        SEAM(pb + 0);

        for (int rep_ = 0; rep_ < REPS(2); ++rep_) { if (rep_) GRID_BAR();
        if (PHON(2) && IN(pb + 1)) {
            pg8::Gemm g{(const pg8::bf16_t*)(F.ws + WS_H), (const pg8::bf16_t*)(wl + WL_IN), MT, INC, DM, DM}; pg8::StaticOrder S; S.init(MT, INC, F.G, (int)blockIdx.x);
            pg8::EpiIn E{(pg8::bf16_t*)(F.ws + WS_Z), (pg8::bf16_t*)(F.ws + WS_G), F.ka->in[I_BGATE] + (size_t)l * GC, (const float*)(F.ws + WS_ROPE), (const float*)(F.ws + WS_ROPE) + 2048};
            pg8::gemm_phase<pg8::EpiIn, pg8::StaticOrder, true, true>(F.lds, g, S, E);
        }
        }
        SEAM(pb + 1);

        for (int rep_ = 0; rep_ < REPS(3); ++rep_) { if (rep_) GRID_BAR();
        if (PHON(3) && IN(pb + 2)) {
            FRESH(); __syncthreads();
#ifndef SUBREP
#define SUBREP 0
#endif
            for (int q_ = 0; q_ < ((SUBREP & 1) ? 2 : 1); ++q_)
            for (int c = blockIdx.x; c < 132; c += F.G) scan_pass1_item(F, l, c);
            FRESH(); __syncthreads();
            for (int q_ = 0; q_ < ((SUBREP & 2) ? 2 : 1); ++q_)
            for (int k = 0; k < 2; ++k) { const int it = k == 0 ? (int)blockIdx.x : 256 + (F.G - 1 - (int)blockIdx.x); if (k == 1 && (last || it >= 264)) break;
                for (int i2 = it; i2 < (k == 0 ? 256 : 264); i2 += F.G) attn_wg_item<false>(F, l, i2); }
            FRESH();
            for (int q_ = 0; q_ < ((SUBREP & 4) ? 2 : 1); ++q_)
            for (int k = 0; k < 2; ++k) { const int it = k == 0 ? (int)blockIdx.x : 256 + (F.G - 1 - (int)blockIdx.x); if (k == 1 && (last || it >= 264)) break;
                for (int i2 = it; i2 < (k == 0 ? 256 : 264); i2 += F.G) attn_wg_item<true>(F, l, i2); }
            FRESH(); for (int q_ = 0; q_ < ((SUBREP & 8) ? 2 : 1); ++q_) dconv_phase(F, l, last ? SEQ : MT);
        }
        }
        SEAM(pb + 2);

        for (int rep_ = 0; rep_ < REPS(4); ++rep_) { if (rep_) GRID_BAR();
        if (PHON(4) && IN(pb + 3)) {
            FRESH(); __syncthreads();
            const int nch = last ? 128 : 132;
            for (int c = blockIdx.x; c < nch; c += F.G) scan_pass2_item(F, l, c);
            if (split_conv && rep_ == 0 && l + 1 < DEPTH && (int)blockIdx.x >= 132) { FRESH(); convert_layer(F, l + 1, ((int)blockIdx.x - 132) * NWAVES + F.wave, (F.G - 132) * NWAVES, CONV_Q1); }
        }
        }
        SEAM(pb + 3);

        for (int rep_ = 0; rep_ < REPS(5); ++rep_) { if (rep_) GRID_BAR();
        if (PHON(5) && IN(pb + 4)) {
            __syncthreads();
            pg8::Gemm g{(const pg8::bf16_t*)(F.ws + WS_BR), (const pg8::bf16_t*)(wl + WL_BR), Mg, DM, DM, DM}; pg8::StaticOrder S; S.init(Mg, DM, F.G, (int)blockIdx.x);
            pg8::EpiMerge E{(const pg8::bf16_t*)(F.ws + WS_G), (pg8::bf16_t*)(F.ws + WS_MG)};
            pg8::gemm_phase<pg8::EpiMerge, pg8::StaticOrder, true, true>(F.lds, g, S, E);
            if (split_conv && rep_ == 0 && l + 1 < DEPTH && (int)blockIdx.x >= 8) { FRESH(); convert_layer(F, l + 1, ((int)blockIdx.x - 8) * NWAVES + F.wave, (F.G - 8) * NWAVES, 0, CONV_Q1); }
        }
        }
        SEAM(pb + 4);

        for (int rep_ = 0; rep_ < REPS(6); ++rep_) { if (rep_) GRID_BAR();
        if (PHON(6) && IN(pb + 5)) {
            pg8::Gemm g{(const pg8::bf16_t*)(F.ws + WS_MG), (const pg8::bf16_t*)(wl + WL_OUT), SEQ, DM, DM, DM}; pg8::StaticOrder S; S.init(SEQ, DM, F.G, (int)blockIdx.x);
            pg8::EpiResid E{rep_ ? (float*)(F.ws + WS_END) : F.out, rep_ ? (float*)(F.ws + WS_END) + (size_t)SEQ * DM : (float*)(F.ws + WS_XC), modl + 2 * DM, modc + 2 * DM};
            pg8::gemm_phase<pg8::EpiResid, pg8::StaticOrder, true, true>(F.lds, g, S, E);
            if (!last) {
                pg8::Gemm gc{(const pg8::bf16_t*)(F.ws + WS_MG), (const pg8::bf16_t*)(wl + WL_OUT), MT, DM, 256, DM}; pg8::SplitKOrder SC{32, DM / 256, 8, 256, F.G, (int)blockIdx.x};
                pg8::EpiSlab EC{(float*)(F.ws + WS_SLAB), 256};
                pg8::gemm_phase<pg8::EpiSlab, pg8::SplitKOrder, true, true>(F.lds, gc, SC, EC);
            }
        }
        }
        SEAM(pb + 5);

        for (int rep_ = 0; rep_ < REPS(7); ++rep_) { if (rep_) GRID_BAR();
        if (PHON(7) && IN(pb + 6)) { FRESH(); norm_phase<8>(F, l, 1, Mg, rep_ == 0 && !last, modc + 2 * DM); }
        }
        SEAM(pb + 6);

        for (int rep_ = 0; rep_ < REPS(8); ++rep_) { if (rep_) GRID_BAR();
        if (PHON(8) && IN(pb + 7)) {
            pg8::Gemm g{(const pg8::bf16_t*)(F.ws + WS_H), (const pg8::bf16_t*)(wl + WL_F1), Mg, F2, DM, DM}; pg8::StaticOrder S; S.init(Mg, F2, F.G, (int)blockIdx.x);
            pg8::EpiSwiglu E{(pg8::bf16_t*)(F.ws + WS_FH)};
            pg8::gemm_phase<pg8::EpiSwiglu, pg8::StaticOrder, true, true>(F.lds, g, S, E);
        }
        }
        SEAM(pb + 7);

        for (int rep_ = 0; rep_ < REPS(9); ++rep_) { if (rep_) GRID_BAR();
        if (PHON(9) && IN(pb + 8)) {
            pg8::Gemm g{(const pg8::bf16_t*)(F.ws + WS_FH), (const pg8::bf16_t*)(wl + WL_F2), SEQ, DM, FHID, FHID}; pg8::StaticOrder S; S.init(SEQ, DM, F.G, (int)blockIdx.x);
            pg8::EpiResid E{rep_ ? (float*)(F.ws + WS_END) : F.out, rep_ ? (float*)(F.ws + WS_END) + (size_t)SEQ * DM : (float*)(F.ws + WS_XC), modl + 5 * DM, modc + 5 * DM};
            pg8::gemm_phase<pg8::EpiResid, pg8::StaticOrder, true, true>(F.lds, g, S, E);
            if (!last) {
                pg8::Gemm gc{(const pg8::bf16_t*)(F.ws + WS_FH), (const pg8::bf16_t*)(wl + WL_F2), MT, DM, 512, FHID}; pg8::SplitKOrder SC{32, DM / 256, 11, 512, F.G, (int)blockIdx.x};
                pg8::EpiSlab EC{(float*)(F.ws + WS_SLAB), 512};
                pg8::gemm_phase<pg8::EpiSlab, pg8::SplitKOrder, true, true>(F.lds, gc, SC, EC);
            }
        }
        }
        SEAM(pb + 8);
    }

    if (PHON(10) && IN(N_PHASES - 1)) { FRESH(); final_norm_phase(F); }
#undef IN
#undef SEAM
}

extern "C" void kernel_launch(void* const* d_in, const int* in_sizes, int n_in, void* d_out, int out_size, void* d_ws, size_t ws_size, hipStream_t stream) {
    static int grid = 0;
    if (grid == 0) {
        if (n_in != 25 || out_size != SEQ * DM || ws_size < WS_NEED) { fprintf(stderr, "kernel_launch: unexpected problem (n_in %d, out %d, ws %zu, need %zu)\n", n_in, out_size, ws_size, (size_t)WS_NEED); grid = -1; return; }
        int dev = 0, cus = 0, per_cu = 0;
        if (hipGetDevice(&dev) != hipSuccess || hipDeviceGetAttribute(&cus, hipDeviceAttributeMultiprocessorCount, dev) != hipSuccess) { grid = -1; return; }
        if (hipFuncSetAttribute((const void*)mk_fwd, hipFuncAttributeMaxDynamicSharedMemorySize, LDS_BYTES) != hipSuccess) { fprintf(stderr, "kernel_launch: hipFuncSetAttribute failed\n"); grid = -1; return; }
        if (hipOccupancyMaxActiveBlocksPerMultiprocessor(&per_cu, (const void*)mk_fwd, NWAVES * 64, LDS_BYTES) != hipSuccess || per_cu < 1) fprintf(stderr, "kernel_launch: occupancy query reports %d\n", per_cu);
        (void)hipGetLastError();
        grid = cus;
    }
    if (grid < 0) return;
    (void)hipMemsetAsync((char*)d_ws + WS_CTL, 0, CTL_ZERO_BYTES, stream);
    Args a{};
    for (int i = 0; i < 25; ++i) a.in[i] = (const float*)d_in[i];
    a.out = (float*)d_out; a.ws = (unsigned char*)d_ws;
#if MK_ONE_LAUNCH
    a.ph_lo = 0; a.ph_hi = N_PHASES;
    hipLaunchKernelGGL(mk_fwd, dim3(grid), dim3(NWAVES * 64), LDS_BYTES, stream, a);
#else
    for (int p = 0; p < N_PHASES; ++p) { a.ph_lo = p; a.ph_hi = p + 1; hipLaunchKernelGGL(mk_fwd, dim3(grid), dim3(NWAVES * 64), LDS_BYTES, stream, a); }
#endif
}
```
